# Optimizing an MI355X kernel written in HIP

```python
import math
import jax, jax.numpy as jnp
from jax import lax
import numpy as np

D_MODEL = 1024
BATCH = 16
SEQ = 2048
DEPTH = 1

D_MIX = D_MODEL
ATTN_WIDTH = D_MIX // 2
HGRN_WIDTH = D_MIX - ATTN_WIDTH
ATTN_HEAD_DIM = 64
N_Q_HEADS = ATTN_WIDTH // ATTN_HEAD_DIM
N_KV_HEADS = 2
KV_WIDTH = N_KV_HEADS * ATTN_HEAD_DIM
WINDOW = 128
ATTN_BLOCK = 128
HGRN_HEAD_DIM = 128
N_HGRN_HEADS = HGRN_WIDTH // HGRN_HEAD_DIM
HGRN_CHUNK = 64
N_EXPERTS = 32
TOP_K = 4
D_EXPERT = D_MODEL
SWIGLU_LIMIT = 7.0
SWIGLU_ALPHA = 1.702
LN_EPS = 1e-5
RMS_EPS = 1e-6
DEEPNORM_ALPHA = (2.0 * DEPTH) ** 0.25
DEEPNORM_BETA = (8.0 * DEPTH) ** -0.25
IN_WIDTHS = (ATTN_WIDTH, KV_WIDTH, KV_WIDTH, HGRN_WIDTH, HGRN_WIDTH, HGRN_WIDTH, HGRN_WIDTH, HGRN_WIDTH)
IN_COLS = sum(IN_WIDTHS)
IN_SPLITS = tuple(int(c) for c in np.cumsum(IN_WIDTHS)[:-1])

kernel_name = 'hymba_swa_hgrn2_moe_encoder'


def layer_norm(x, g, b):
    xf = x.astype(jnp.float32)
    mu = jnp.mean(xf, axis=-1, keepdims=True)
    var = jnp.mean(jnp.square(xf - mu), axis=-1, keepdims=True)
    y = (xf - mu) * lax.rsqrt(var + LN_EPS) * g.astype(jnp.float32) + b.astype(jnp.float32)
    return y.astype(x.dtype)


def alibi_slopes(n):
    return jnp.asarray([2.0 ** (-8.0 * (h + 1) / n) for h in range(n)], jnp.float32)


def windowed_gqa(q, k, v, sink):
    b, s = q.shape[0], q.shape[1]
    nb = s // ATTN_BLOCK
    g, r = N_KV_HEADS, N_Q_HEADS // N_KV_HEADS
    qb = q.reshape(b, nb, ATTN_BLOCK, g, r, ATTN_HEAD_DIM)
    pad = ((0, 0), (ATTN_BLOCK, ATTN_BLOCK), (0, 0), (0, 0))

    def band(t):
        tp = jnp.pad(t, pad).reshape(b, nb + 2, ATTN_BLOCK, g, ATTN_HEAD_DIM)
        return jnp.concatenate([tp[:, :-2], tp[:, 1:-1], tp[:, 2:]], axis=2)

    kb, vb = band(k), band(v)
    scores = jnp.einsum('bnqgrd,bnkgd->bgrnqk', qb, kb).astype(jnp.float32) * (1.0 / math.sqrt(ATTN_HEAD_DIM))
    qpos = jnp.arange(nb)[:, None, None] * ATTN_BLOCK + jnp.arange(ATTN_BLOCK)[None, :, None]
    kpos = jnp.arange(nb)[:, None, None] * ATTN_BLOCK - ATTN_BLOCK + jnp.arange(3 * ATTN_BLOCK)[None, None, :]
    dist = jnp.abs(kpos - qpos)
    valid = (dist <= WINDOW) & (kpos >= 0) & (kpos < s)
    slopes = alibi_slopes(N_Q_HEADS).reshape(g, r)[:, :, None, None, None]
    scores = jnp.where(valid, scores - slopes * dist.astype(jnp.float32), -jnp.inf)
    sink_l = sink.astype(jnp.float32).reshape(g, r)[None, :, :, None, None, None]
    m = jnp.maximum(jnp.max(scores, axis=-1, keepdims=True), sink_l)
    e = jnp.exp(scores - m)
    p = e / (jnp.sum(e, axis=-1, keepdims=True) + jnp.exp(sink_l - m))
    out = jnp.einsum('bgrnqk,bnkgd->bnqgrd', p.astype(vb.dtype), vb)
    return out.reshape(b, s, N_Q_HEADS * ATTN_HEAD_DIM)


def gated_linear_scan(q, k, v, log_f):
    b, s, h, dk = q.shape
    dv = v.shape[-1]
    c = HGRN_CHUNK
    n = s // c
    rs = lambda t: t.reshape(b, n, c, h, t.shape[-1])
    q, k, v, log_f = rs(q), rs(k), rs(v), rs(log_f)
    cum = jnp.cumsum(log_f, axis=2)
    last = cum[:, :, -1]
    ref = cum[:, :, c // 2][:, :, None]
    q_rel = q * jnp.exp(cum - ref)
    k_rel = k * jnp.exp(ref - cum)
    lower = jnp.tril(jnp.ones((c, c), dtype=bool))
    a = jnp.einsum('bnthd,bnshd->bnhts', q_rel, k_rel)
    a = jnp.where(lower, a, 0.0)
    o_intra = jnp.einsum('bnhts,bnshv->bnthv', a, v)
    chunk_kv = jnp.einsum('bnshd,bnshv->bnhdv', k * jnp.exp(last[:, :, None] - cum), v)
    decay = jnp.exp(last)

    def step(state, inp):
        dec, kv = inp
        return dec[..., None] * state + kv, state

    init = jnp.zeros((b, h, dk, dv), jnp.float32)
    _, s_prev = lax.scan(step, init, (jnp.swapaxes(decay, 0, 1), jnp.swapaxes(chunk_kv, 0, 1)))
    s_prev = jnp.swapaxes(s_prev, 0, 1)
    o_inter = jnp.einsum('bnthd,bnhdv->bnthv', q * jnp.exp(cum), s_prev)
    return (o_intra + o_inter).reshape(b, s, h, dv)


def hgrn2_bidirectional(q, i, zf_fwd, zf_bwd, z_g, lb, norm_g):
    b, s = q.shape[0], q.shape[1]
    heads = lambda t: t.astype(jnp.float32).reshape(b, s, N_HGRN_HEADS, HGRN_HEAD_DIM)
    qh, vh = heads(q), heads(i)

    def gate(zf, lb_d):
        f = lb_d + (1.0 - lb_d) * jax.nn.sigmoid(zf.astype(jnp.float32))
        f = heads(f)
        return jnp.log(f), 1.0 - f

    log_ff, k_f = gate(zf_fwd, lb[0])
    log_fb, k_b = gate(zf_bwd, lb[1])
    flip = lambda t: jnp.flip(t, axis=1)
    o_f = gated_linear_scan(qh, k_f, vh, log_ff)
    o_b = flip(gated_linear_scan(flip(qh), flip(k_b), flip(vh), flip(log_fb)))
    o = o_f + o_b
    o = o * lax.rsqrt(jnp.mean(jnp.square(o), axis=-1, keepdims=True) + RMS_EPS)
    o = o.reshape(b, s, HGRN_WIDTH) * norm_g.astype(jnp.float32) * jax.nn.silu(z_g.astype(jnp.float32))
    return o.astype(q.dtype)


def hybrid_mixer(h, w_in, sink, lb, norm_g, w_out):
    b, s, _ = h.shape
    proj = h @ w_in
    q_a, k_a, v_a, q_h, i_h, zf_fwd, zf_bwd, z_g = jnp.split(proj, IN_SPLITS, axis=-1)
    attn = windowed_gqa(q_a.reshape(b, s, N_Q_HEADS, ATTN_HEAD_DIM),
                        k_a.reshape(b, s, N_KV_HEADS, ATTN_HEAD_DIM),
                        v_a.reshape(b, s, N_KV_HEADS, ATTN_HEAD_DIM), sink)
    rec = hgrn2_bidirectional(q_h, i_h, zf_fwd, zf_bwd, z_g, lb, norm_g)
    return jnp.concatenate([attn.astype(h.dtype), rec], axis=-1) @ w_out


def moe_ffn(x, w_router, b_router, w_up, b_up, w_down, b_down):
    logits = (x @ w_router + b_router).astype(jnp.float32)
    top_v, top_i = lax.top_k(logits, TOP_K)
    gates = jax.nn.softmax(top_v, axis=-1)
    gate_full = jnp.sum(jax.nn.one_hot(top_i, N_EXPERTS, dtype=jnp.float32) * gates[..., None], axis=1)
    gate_full = gate_full.astype(x.dtype)
    out = jnp.zeros_like(x)
    for e in range(N_EXPERTS):
        hid = x @ w_up[e] + b_up[e]
        x_glu = jnp.minimum(hid[..., ::2], SWIGLU_LIMIT)
        x_lin = jnp.clip(hid[..., 1::2], -SWIGLU_LIMIT, SWIGLU_LIMIT)
        act = x_glu * jax.nn.sigmoid(SWIGLU_ALPHA * x_glu) * (x_lin + 1.0)
        out = out + gate_full[:, e:e + 1] * (act @ w_down[e] + b_down[e])
    return out


def setup_inputs(seed: int = 0) -> dict:
    key = jax.random.key(seed)
    ks = jax.random.split(key, 20)
    f32 = jnp.float32
    nrm = lambda k, shape, sc: jax.random.normal(k, shape, f32) * sc
    col_scale = jnp.concatenate([
        jnp.full((w,), sc, f32) for w, sc in zip(
            IN_WIDTHS, (1.0, 1.0, DEEPNORM_BETA, 1.0, DEEPNORM_BETA, 1.0, 1.0, 1.0))])
    return {
        'x': nrm(ks[0], (BATCH, SEQ, D_MODEL), 1.0),
        'emb_ln_g': 1.0 + nrm(ks[1], (D_MODEL,), 0.02),
        'emb_ln_b': nrm(ks[2], (D_MODEL,), 0.02),
        'w_in': nrm(ks[3], (DEPTH, D_MODEL, IN_COLS), D_MODEL ** -0.5) * col_scale,
        'attn_sink': nrm(ks[4], (DEPTH, N_Q_HEADS), 0.5),
        'hgrn_lb_logits': nrm(ks[5], (2, DEPTH + 1, HGRN_WIDTH), 0.1),
        'hgrn_norm_g': 1.0 + nrm(ks[6], (DEPTH, HGRN_WIDTH), 0.02),
        'w_out': nrm(ks[7], (DEPTH, D_MIX, D_MODEL), D_MIX ** -0.5 * DEEPNORM_BETA),
        'ln1_g': 1.0 + nrm(ks[8], (DEPTH, D_MODEL), 0.02),
        'ln1_b': nrm(ks[9], (DEPTH, D_MODEL), 0.02),
        'w_router': nrm(ks[10], (DEPTH, D_MODEL, N_EXPERTS), D_MODEL ** -0.5),
        'b_router': nrm(ks[11], (DEPTH, N_EXPERTS), 0.01),
        'w_up': nrm(ks[12], (DEPTH, N_EXPERTS, D_MODEL, 2 * D_EXPERT), D_MODEL ** -0.5),
        'b_up': nrm(ks[13], (DEPTH, N_EXPERTS, 2 * D_EXPERT), 0.01),
        'w_down': nrm(ks[14], (DEPTH, N_EXPERTS, D_EXPERT, D_MODEL), D_EXPERT ** -0.5 * DEEPNORM_BETA),
        'b_down': nrm(ks[15], (DEPTH, N_EXPERTS, D_MODEL), 0.01),
        'ln2_g': 1.0 + nrm(ks[16], (DEPTH, D_MODEL), 0.02),
        'ln2_b': nrm(ks[17], (DEPTH, D_MODEL), 0.02),
    }


def reference(x, emb_ln_g, emb_ln_b, w_in, attn_sink, hgrn_lb_logits, hgrn_norm_g, w_out,
              ln1_g, ln1_b, w_router, b_router, w_up, b_up, w_down, b_down, ln2_g, ln2_b):
    h = layer_norm(x, emb_ln_g, emb_ln_b)
    lb_all = jnp.cumsum(jax.nn.softmax(hgrn_lb_logits.astype(jnp.float32), axis=1), axis=1)
    for l in range(DEPTH):
        mix = hybrid_mixer(h, w_in[l], attn_sink[l], lb_all[:, l], hgrn_norm_g[l], w_out[l])
        h = layer_norm(DEEPNORM_ALPHA * h + mix, ln1_g[l], ln1_b[l])
        ffn = moe_ffn(h.reshape(-1, D_MODEL), w_router[l], b_router[l], w_up[l], b_up[l],
                      w_down[l], b_down[l]).reshape(h.shape)
        h = layer_norm(DEEPNORM_ALPHA * h + ffn, ln2_g[l], ln2_b[l])
    return h
```

```cpp
#include <hip/hip_runtime.h>
#include <cstdio>
#include <cstdint>
#ifndef MK_N_LAUNCHES
#define MK_N_LAUNCHES 10
#endif
namespace pg8 {
#define PG8_LAS __attribute__((address_space(3)))
typedef unsigned short bf16_t;
typedef short bf16x8 __attribute__((ext_vector_type(8)));
typedef float f32x4 __attribute__((ext_vector_type(4)));
typedef unsigned u32x4 __attribute__((ext_vector_type(4)));
constexpr int BM = 256, BK = 64, HALF = 128, HTB = HALF * BK * 2  , STAGE_BYTES = 8 * HTB, NXCD = 8, WGM = 8;

__host__ __device__ __forceinline__ int lds_byte(int r, int c) { const int st = (r >> 4) * 2 + (c >> 5), rr = r & 15, cc = c & 31, ob = rr * 64 + cc * 2; return st * 1024 + (ob ^ (((ob >> 9) & 1) << 5)); }
__host__ __device__ __forceinline__ void stage_rc(int b, int& R, int& C) { const int st = b / 1024, sb = b % 1024, swz = sb ^ (((sb >> 9) & 1) << 5); R = (st >> 1) * 16 + swz / 64; C = (st & 1) * 32 + (swz % 64) / 2; }
__host__ __device__ __forceinline__ int perm32(int rho) { const int n = rho >> 4, i = rho & 15; return 8 * (i >> 2) + 4 * n + (i & 3); }

struct Unit { int pm, pn; };
struct Gemm { const bf16_t* A; const bf16_t* Bt; int M, N, K; };

struct StaticOrder {
    int nM, nN, nwg, G, c;
    __host__ __device__ void init(int M, int N, int G_, int c_) { nM = M / BM; nN = N / BM; nwg = nM * nN; G = G_; c = c_; }
    __host__ __device__ bool next(int i, Unit& u) const {
        const long L = (long)i * G + c; if (L >= nwg) return false;
        int wgid = (int)L; { const int q = nwg / NXCD, r = nwg % NXCD, xcd = wgid % NXCD, off = wgid / NXCD; wgid = (xcd < r ? xcd * (q + 1) : r * (q + 1) + (xcd - r) * q) + off; }
        const int nig = WGM * nN, gid = wgid / nig, fm = gid * WGM, gsz = (nM - fm) < WGM ? (nM - fm) : WGM;
        u.pm = fm + ((wgid % nig) % gsz); u.pn = (wgid % nig) / gsz; return true;
    }
    __device__ __forceinline__ void a_ready(const Unit&) const {}
    __device__ __forceinline__ void done(const Unit&) const {}
};

__device__ __forceinline__ unsigned cvt_pk_bf16(float lo, float hi) { unsigned r; asm volatile("v_cvt_pk_bf16_f32 %0, %1, %2" : "=v"(r) : "v"(lo), "v"(hi)); return r; }
typedef float f32x2 __attribute__((ext_vector_type(2)));
__device__ __forceinline__ f32x2 gelu_pk(f32x2 v) {
    const f32x2 av = __builtin_elementwise_abs(v), d = av * 0.2316418882f + 1.0f;
    f32x2 t; t.x = __builtin_amdgcn_rcpf(d.x); t.y = __builtin_amdgcn_rcpf(d.y);
    f32x2 q = t * 0.5307027145f + (-0.7265760135f); q = q * t + 0.7107068705f; q = q * t + (-0.142248368f); q = q * t + 0.127414796f; q = q * t;
    const f32x2 s = (v * v) * (-0.72134752044f);
    f32x2 e; e.x = __builtin_amdgcn_exp2f(s.x); e.y = __builtin_amdgcn_exp2f(s.y);
    const f32x2 m = v * (q * e), r = v - m;
    f32x2 o; o.x = v.x < 0.f ? m.x : r.x; o.y = v.y < 0.f ? m.y : r.y; return o;
}

template <int ACT  > struct EpiBf16 {
    static constexpr bool PERM = true, AFTER_DRAIN = false; static_assert(ACT == 0 || ACT == 1, "EpiBf16: ACT is 0 (none) or 1 (gelu_pk)");
    bf16_t* O; int ldc; const float* bias; int split_cols; size_t split_stride; float scale0;
    __device__ __forceinline__ void operator()(const f32x4 (&acc)[2][2][4][2], const Unit& u, int wr, int wc, int fr, int fq) const {
        const int row0 = u.pm * BM + wr * 64 + fr; int colt = u.pn * BM; bf16_t* base = O;
        float sc = 1.f; if (split_cols) { const int t = colt / split_cols; base += (size_t)t * split_stride; colt -= t * split_cols; if (t == 0) sc = scale0; }
        const int col0 = colt + wc * 32 + 8 * fq, bcol0 = u.pn * BM + wc * 32 + 8 * fq;
        f32x4 bv[2][2];
#pragma unroll
        for (int bj = 0; bj < 2; ++bj)
#pragma unroll
            for (int n = 0; n < 2; ++n) bv[bj][n] = bias ? *(const f32x4*)(bias + bcol0 + bj * HALF + 4 * n) : (f32x4){0.f, 0.f, 0.f, 0.f};
#pragma unroll
        for (int ai = 0; ai < 2; ++ai)
#pragma unroll
            for (int m = 0; m < 4; ++m) { bf16_t* rowp = base + (size_t)(row0 + ai * HALF + m * 16) * ldc + col0;
#pragma unroll
                for (int bj = 0; bj < 2; ++bj) { f32x4 v0 = acc[ai][bj][m][0] + bv[bj][0], v1 = acc[ai][bj][m][1] + bv[bj][1];
                    if (ACT == 1) { f32x2 a = gelu_pk((f32x2){v0[0], v0[1]}), b = gelu_pk((f32x2){v0[2], v0[3]}), c = gelu_pk((f32x2){v1[0], v1[1]}), d = gelu_pk((f32x2){v1[2], v1[3]});
                        v0 = (f32x4){a.x, a.y, b.x, b.y}; v1 = (f32x4){c.x, c.y, d.x, d.y}; }
                    v0 = v0 * sc; v1 = v1 * sc; u32x4 w; w.x = cvt_pk_bf16(v0[0], v0[1]); w.y = cvt_pk_bf16(v0[2], v0[3]); w.z = cvt_pk_bf16(v1[0], v1[1]); w.w = cvt_pk_bf16(v1[2], v1[3]);
                    *(u32x4*)(rowp + bj * HALF) = w; } }
    }
};
template <class Epi, class Sched, bool ALIGN_EPI = false, bool SP2 = false>
__device__ __forceinline__ void gemm_phase(PG8_LAS unsigned char* lds, const Gemm g, const Sched& S, const Epi& E) {
    const int tid = threadIdx.x, wid = __builtin_amdgcn_readfirstlane(tid >> 6), lane = tid & 63, wr = wid >> 2, wc = wid & 3, fr = lane & 15, fq = lane >> 4;
    const int K = g.K, nt = K / BK;
    unsigned voffA[2], voffB[2];
#pragma unroll
    for (int i = 0; i < 2; ++i) { int R, C; stage_rc(tid * 16 + i * 8192, R, C); const int Rb = Epi::PERM ? ((R & ~31) + perm32(R & 31)) : R;
        voffA[i] = (unsigned)(R * K + C) * 2u; voffB[i] = (unsigned)(Rb * K + C) * 2u; }
    const size_t kstep = (size_t)(BK * 2);
    const size_t hstep = (size_t)HALF * K * 2;
    const size_t tstep = 2 * hstep;
    const unsigned ldsw = (unsigned)wid * 1024u;
    const int aoff = lds_byte(wr * 64 + fr, fq * 8), boff = lds_byte(wc * 32 + fr, fq * 8);
#define PG8_SA(b, h) (((b) * 2 + (h)) * HTB)
#define PG8_SB(b, h) ((4 + (b) * 2 + (h)) * HTB)
#define PG8_STAGE(bufoff, gbase, voff) do { _Pragma("unroll") for (int _i = 0; _i < 2; ++_i) \
        __builtin_amdgcn_global_load_lds((const unsigned*)((const char*)(gbase) + (voff)[_i]), (PG8_LAS unsigned*)(lds + (bufoff) + ldsw + _i * 8192), 16, 0, 0); } while (0)
#define PG8_LDA(dst, b, h) do { _Pragma("unroll") for (int m = 0; m < 4; ++m) _Pragma("unroll") for (int k = 0; k < 2; ++k) dst[m][k] = *(const PG8_LAS bf16x8*)(lds + PG8_SA(b, h) + aoff + m * 2048 + k * 1024); } while (0)
#define PG8_LDB(dst, b, h) do { _Pragma("unroll") for (int n = 0; n < 2; ++n) _Pragma("unroll") for (int k = 0; k < 2; ++k) dst[n][k] = *(const PG8_LAS bf16x8*)(lds + PG8_SB(b, h) + boff + n * 2048 + k * 1024); } while (0)
#define PG8_MMA(ai, bj, At, Bt) do { __builtin_amdgcn_s_setprio(1); _Pragma("unroll") for (int m = 0; m < 4; ++m) _Pragma("unroll") for (int n = 0; n < 2; ++n) _Pragma("unroll") for (int k = 0; k < 2; ++k) \
        acc[ai][bj][m][n] = __builtin_amdgcn_mfma_f32_16x16x32_bf16(Bt[n][k], At[m][k], acc[ai][bj][m][n], 0, 0, 0); __builtin_amdgcn_s_setprio(0); } while (0)
#define PG8_WAIT_V(n) asm volatile("s_waitcnt vmcnt(" #n ")" ::: "memory")
#define PG8_WAIT_L(n) asm volatile("s_waitcnt lgkmcnt(" #n ")" ::: "memory")
#define PG8_BAR __builtin_amdgcn_s_barrier()
#define PG8_SCHED __builtin_amdgcn_sched_barrier(0)
    Unit cur, nxt; int ui = 0;
    if (!S.next(0, cur)) return;
    f32x4 acc[2][2][4][2];
#pragma unroll
    for (int a = 0; a < 2; ++a)
#pragma unroll
        for (int b = 0; b < 2; ++b)
#pragma unroll
            for (int m = 0; m < 4; ++m)
#pragma unroll
                for (int n = 0; n < 2; ++n) acc[a][b][m][n] = (f32x4){0.f, 0.f, 0.f, 0.f};
    bf16x8 At[4][2], B0[2][2], B1[2][2];
    const char* cA = (const char*)g.A + (size_t)cur.pm * tstep; const char* cB = (const char*)g.Bt + (size_t)cur.pn * tstep;
    S.a_ready(cur);
    if constexpr (SP2) {
        PG8_STAGE(PG8_SB(0, 0), cB, voffB); PG8_STAGE(PG8_SB(0, 1), cB + hstep, voffB); PG8_STAGE(PG8_SA(0, 0), cA, voffA); PG8_STAGE(PG8_SA(0, 1), cA + hstep, voffA);
        if (wr == 1) PG8_BAR;
        PG8_WAIT_V(2); PG8_BAR;
        PG8_STAGE(PG8_SB(1, 0), cB + kstep, voffB); PG8_STAGE(PG8_SA(1, 0), cA + kstep, voffA); PG8_STAGE(PG8_SB(1, 1), cB + hstep + kstep, voffB);
        PG8_WAIT_V(6); PG8_BAR;
    } else {
        PG8_STAGE(PG8_SB(0, 0), cB, voffB); PG8_STAGE(PG8_SA(0, 0), cA, voffA); PG8_STAGE(PG8_SB(0, 1), cB + hstep, voffB); PG8_STAGE(PG8_SA(0, 1), cA + hstep, voffA);
        if (wr == 1) PG8_BAR;
        PG8_WAIT_V(4); PG8_BAR;
        PG8_STAGE(PG8_SB(1, 0), cB + kstep, voffB); PG8_STAGE(PG8_SA(1, 0), cA + kstep, voffA); PG8_STAGE(PG8_SB(1, 1), cB + hstep + kstep, voffB);
        PG8_WAIT_V(6); PG8_BAR;
    }
    for (;;) {
        const bool has_next = S.next(ui + 1, nxt);
        const char* nA = has_next ? (const char*)g.A + (size_t)nxt.pm * tstep : cA; const char* nB = has_next ? (const char*)g.Bt + (size_t)nxt.pn * tstep : cB;
        for (int t = 0; t < nt; t += 2) {
            const bool last = (t == nt - 2);
            const char* a1 = cA + (size_t)(t + 1) * kstep;
            const char* a2 = last ? nA : cA + (size_t)(t + 2) * kstep; const char* b2 = last ? nB : cB + (size_t)(t + 2) * kstep;
            const char* a3 = a2 + kstep; const char* b3 = b2 + kstep;
            if (last && has_next) S.a_ready(nxt);
            if constexpr (SP2) {
            PG8_LDB(B0, 0, 0); PG8_LDB(B1, 0, 1); PG8_SCHED; PG8_LDA(At, 0, 0); PG8_STAGE(PG8_SA(1, 1), a1 + hstep, voffA);
            PG8_WAIT_V(8); PG8_WAIT_L(0); PG8_BAR; PG8_MMA(0, 0, At, B0); PG8_MMA(0, 1, At, B1); PG8_BAR; PG8_SCHED;
            PG8_LDA(At, 0, 1); PG8_STAGE(PG8_SB(0, 0), b2, voffB); PG8_STAGE(PG8_SB(0, 1), b2 + hstep, voffB); PG8_STAGE(PG8_SA(0, 0), a2, voffA);
            PG8_WAIT_V(8); PG8_WAIT_L(0); PG8_BAR; PG8_MMA(1, 0, At, B0); PG8_MMA(1, 1, At, B1); PG8_BAR; PG8_SCHED;
            PG8_LDB(B0, 1, 0); PG8_LDB(B1, 1, 1); PG8_SCHED; PG8_LDA(At, 1, 0); PG8_STAGE(PG8_SA(0, 1), a2 + hstep, voffA);
            PG8_WAIT_V(8); PG8_WAIT_L(0); PG8_BAR; PG8_MMA(0, 0, At, B0); PG8_MMA(0, 1, At, B1); PG8_BAR; PG8_SCHED;
            PG8_LDA(At, 1, 1); PG8_STAGE(PG8_SB(1, 0), b3, voffB); PG8_STAGE(PG8_SB(1, 1), b3 + hstep, voffB); PG8_STAGE(PG8_SA(1, 0), a3, voffA);
            PG8_WAIT_V(8); PG8_WAIT_L(0); PG8_BAR; PG8_MMA(1, 0, At, B0); PG8_MMA(1, 1, At, B1); PG8_BAR; PG8_SCHED;
            } else {
            PG8_LDB(B0, 0, 0); PG8_SCHED; PG8_LDA(At, 0, 0); PG8_STAGE(PG8_SA(1, 1), a1 + hstep, voffA);
            PG8_WAIT_L(8); PG8_BAR; PG8_WAIT_L(0); PG8_MMA(0, 0, At, B0); PG8_BAR; PG8_SCHED;
            PG8_LDB(B1, 0, 1); PG8_STAGE(PG8_SB(0, 0), b2, voffB);
            PG8_BAR; PG8_WAIT_L(0); PG8_MMA(0, 1, At, B1); PG8_BAR;
            PG8_LDA(At, 0, 1); PG8_STAGE(PG8_SA(0, 0), a2, voffA);
            PG8_BAR; PG8_WAIT_L(0); PG8_MMA(1, 0, At, B0); PG8_BAR; PG8_SCHED;
            PG8_STAGE(PG8_SB(0, 1), b2 + hstep, voffB);
            PG8_WAIT_V(6); PG8_BAR; PG8_MMA(1, 1, At, B1); PG8_BAR;
            PG8_LDB(B0, 1, 0); PG8_SCHED; PG8_LDA(At, 1, 0); PG8_STAGE(PG8_SA(0, 1), a2 + hstep, voffA);
            PG8_WAIT_L(8); PG8_BAR; PG8_WAIT_L(0); PG8_MMA(0, 0, At, B0); PG8_BAR; PG8_SCHED;
            PG8_LDB(B1, 1, 1); PG8_STAGE(PG8_SB(1, 0), b3, voffB);
            PG8_BAR; PG8_WAIT_L(0); PG8_MMA(0, 1, At, B1); PG8_BAR;
            PG8_LDA(At, 1, 1); PG8_STAGE(PG8_SA(1, 0), a3, voffA);
            PG8_BAR; PG8_WAIT_L(0); PG8_MMA(1, 0, At, B0); PG8_BAR; PG8_SCHED;
            PG8_STAGE(PG8_SB(1, 1), b3 + hstep, voffB);
            PG8_WAIT_V(6); PG8_BAR; PG8_MMA(1, 1, At, B1); PG8_BAR;
            }
        }
        if constexpr (ALIGN_EPI) { if (wr == 0) PG8_BAR; }
        if constexpr (!Epi::AFTER_DRAIN) { E(acc, cur, wr, wc, fr, fq); S.done(cur); }
        if (!has_next) break;
#pragma unroll
        for (int a = 0; a < 2; ++a)
#pragma unroll
            for (int b = 0; b < 2; ++b)
#pragma unroll
                for (int m = 0; m < 4; ++m)
#pragma unroll
                    for (int n = 0; n < 2; ++n) acc[a][b][m][n] = (f32x4){0.f, 0.f, 0.f, 0.f};
        cur = nxt; cA = nA; cB = nB; ++ui;
        if constexpr (ALIGN_EPI) { if (wr == 1) PG8_BAR; }
    }
    PG8_WAIT_V(0);
    if constexpr (!ALIGN_EPI) { if (wr == 0) PG8_BAR; }
    PG8_BAR;
    if constexpr (Epi::AFTER_DRAIN) { E.fused(acc, cur, wr, wc, fr, fq, lds, wid, lane); S.done(cur); }
#undef PG8_SA
#undef PG8_SB
#undef PG8_STAGE
#undef PG8_LDA
#undef PG8_LDB
#undef PG8_MMA
#undef PG8_WAIT_V
#undef PG8_WAIT_L
#undef PG8_BAR
#undef PG8_SCHED
}
}

constexpr int NWAVES = 8;
#ifndef MK_N_LAUNCHES
#define MK_N_LAUNCHES 1
#endif
constexpr int PER_PHASE = 10;
constexpr int N_LAUNCHES = MK_N_LAUNCHES;

constexpr int NB = 16, SEQ = 2048, T = NB * SEQ, D = 1024, NIN = 3328, NE = 32, TOPK = 4, DFF = 2048;
constexpr int MAXTILES = T * TOPK / 256 + NE;
constexpr int MAXSLOTS = MAXTILES * 256;
constexpr int NCHUNK = 256, CHUNK_TOK = T / NCHUNK;
constexpr float LN_EPS = 1e-5f, RMS_EPS = 1e-6f, DN_ALPHA = 1.18920711500272f, SWIGLU_LIMIT = 7.0f, SWIGLU_ALPHA = 1.702f;

constexpr size_t MiB = 1u << 20;
constexpr size_t WS_CTL = 0, CTL_ZERO_BYTES = 1 * MiB;
constexpr size_t WS_TAB = 1 * MiB;
constexpr size_t WS_WIN = 2 * MiB, WS_WOUT = 9 * MiB, WS_WUP = 11 * MiB, WS_WD = 139 * MiB;
constexpr size_t WS_H1 = 203 * MiB;
constexpr size_t WS_TOPI = 267 * MiB, WS_TOPG = 268 * MiB, WS_SLOT = 269 * MiB, WS_ROWTOK = 270 * MiB, WS_GATES = 271 * MiB;
constexpr size_t WS_H0 = 272 * MiB, WS_QA = 336 * MiB, WS_KA = 368 * MiB, WS_VA = 376 * MiB, WS_QH = 384 * MiB, WS_IH = 416 * MiB, WS_LF = 448 * MiB, WS_LB = 512 * MiB,
                 WS_ZG = 576 * MiB, WS_OF = 608 * MiB, WS_OB = 672 * MiB, WS_MIX = 736 * MiB, WS_U = 800 * MiB;
constexpr size_t WS_XG = 272 * MiB, WS_ACT = 544 * MiB, WS_Y = 272 * MiB, WS_END = 928 * MiB;
constexpr int CW_TMO = 0, CW_CODE = 1, CW_BAR = 4096;

constexpr int RING_OFF = 0, RING_BYTES = 131072;
constexpr int LDSCTL_OFF = RING_BYTES, MISC_OFF = LDSCTL_OFF + 320;
constexpr int TAB_OFF = 132096;
constexpr int HIST_OFF = 134400;
constexpr int LDS_BYTES = 147456;
static_assert(TAB_OFF + MAXTILES * 4 <= HIST_OFF && HIST_OFF + 128 <= LDS_BYTES, "LDS map");
#define GAS __attribute__((address_space(1)))
#define LAS __attribute__((address_space(3)))
typedef unsigned short bf16;
typedef unsigned v4u __attribute__((ext_vector_type(4)));
typedef float f32x4 __attribute__((ext_vector_type(4)));
typedef short bf16x8 __attribute__((ext_vector_type(8)));
typedef GAS unsigned gu32;
typedef GAS unsigned long long gu64;
#define RLX_AGENT __ATOMIC_RELAXED, __HIP_MEMORY_SCOPE_AGENT
#define LDS_WAIT() asm volatile("s_waitcnt lgkmcnt(0)" ::: "memory")
#define VM_WAIT() asm volatile("s_waitcnt vmcnt(0)" ::: "memory")
__device__ __forceinline__ unsigned long long rt() { return __builtin_amdgcn_s_memrealtime(); }
__device__ __forceinline__ unsigned f2bf(float f) { unsigned u = __builtin_bit_cast(unsigned, f); return (u + 0x7fffu + ((u >> 16) & 1u)) >> 16; }
__device__ __forceinline__ unsigned pk2(float lo, float hi) { return f2bf(lo) | (f2bf(hi) << 16); }
#define XB_TMO      128
#define XB_XCNT(j)  (256  + 64 * (j))
#define XB_XSUB(j)  (1280 + 64 * (j))
#define XB_XGEN(j)  (2304 + 64 * (j))
#define XB_TOP      3328
#define XB_TOPGEN   3392
#define XCD_BAR_WORDS 3456
#define XB_SPIN_CAP (1u << 18)

__device__ __forceinline__ unsigned xb_ld(unsigned* p)              { return __hip_atomic_load(p, __ATOMIC_RELAXED, __HIP_MEMORY_SCOPE_AGENT); }
__device__ __forceinline__ unsigned xb_add(unsigned* p, unsigned v) { return __hip_atomic_fetch_add(p, v, __ATOMIC_RELAXED, __HIP_MEMORY_SCOPE_AGENT); }
__device__ __forceinline__ unsigned xb_xcc_id() { return (unsigned)__builtin_amdgcn_s_getreg((3 << 11) | 20) & 0xFu; }
#define XB_SPIN(cond, bar) do { unsigned _sp = 0; while (cond) { __builtin_amdgcn_s_sleep(1); \
    if ((++_sp & 255u) == 0u) { if (xb_ld(&(bar)[XB_TMO])) break; if (_sp > XB_SPIN_CAP) { atomicAdd(&(bar)[XB_TMO], 1u); break; } } } } while (0)

struct XcdBarrier {
    unsigned* bar; unsigned x;
    volatile LAS unsigned* st;
};

__device__ __forceinline__ XcdBarrier xcd_barrier_post(unsigned* bar, volatile LAS unsigned* st) {
    XcdBarrier b; b.bar = bar; b.x = xb_xcc_id(); b.st = st;
    if (threadIdx.x == 0) (void)xb_add(&bar[XB_XCNT(b.x)], 1u);
    return b;
}
__device__ __forceinline__ void xcd_barrier_complete(unsigned* bar, unsigned x, unsigned& nloc, unsigned& nx) {
    const unsigned G = gridDim.x * gridDim.y * gridDim.z;
    unsigned sum, cnt, mine, sp = 0u;
    for (;;) {
        sum = 0u; cnt = 0u; mine = 0u;
#pragma unroll
        for (unsigned j = 0; j < 16; ++j) { const unsigned c = xb_ld(&bar[XB_XCNT(j)]); sum += c; cnt += (c > 0u) ? 1u : 0u; mine = (j == x) ? c : mine; }
        if (sum == G) break;
        __builtin_amdgcn_s_sleep(1);
        if ((++sp & 255u) == 0u) { if (xb_ld(&bar[XB_TMO])) break; if (sp > XB_SPIN_CAP) { atomicAdd(&bar[XB_TMO], 1u); break; } }
    }
    nloc = mine > 0u ? mine : 1u; nx = cnt > 0u ? cnt : 1u;
}

__device__ __forceinline__ void xcd_barrier(const XcdBarrier& b) {
    asm volatile("s_waitcnt vmcnt(0)" ::: "memory");
    __syncthreads();
    if (threadIdx.x == 0) {
        unsigned* bar = b.bar;
        __builtin_amdgcn_s_waitcnt(0);
        unsigned nloc = b.st[0], nx = b.st[1];
        if (nloc == 0u) { xcd_barrier_complete(bar, b.x, nloc, nx); b.st[0] = nloc; b.st[1] = nx; }
        const unsigned old = xb_add(&bar[XB_XSUB(b.x)], 1u);
        const unsigned gen = old / nloc;
        if (old + 1u == (gen + 1u) * nloc) {
            __builtin_amdgcn_fence(__ATOMIC_RELEASE, "agent");
            asm volatile("s_waitcnt vmcnt(0)" ::: "memory");
            const unsigned og = xb_add(&bar[XB_TOP], 1u);
            const unsigned tg = og / nx;
            if (og + 1u == (tg + 1u) * nx) xb_add(&bar[XB_TOPGEN], 1u);
            else XB_SPIN(xb_ld(&bar[XB_TOPGEN]) == tg, bar);
            __builtin_amdgcn_fence(__ATOMIC_ACQUIRE, "agent");
            xb_add(&bar[XB_XGEN(b.x)], 1u);
            asm volatile("s_waitcnt vmcnt(0)" ::: "memory");
        } else {
            XB_SPIN(xb_ld(&bar[XB_XGEN(b.x)]) == gen, bar);
            __builtin_amdgcn_fence(__ATOMIC_ACQUIRE, "agent");
            asm volatile("s_waitcnt vmcnt(0)" ::: "memory");
        }
    }
    __syncthreads();
}

typedef unsigned u32x2 __attribute__((ext_vector_type(2)));
__device__ __forceinline__ float bflo(unsigned w) { return __uint_as_float(w << 16); }
__device__ __forceinline__ float bfhi(unsigned w) { return __uint_as_float(w & 0xffff0000u); }
__device__ __forceinline__ float fsigmoid(float z) { return __builtin_amdgcn_rcpf(1.0f + __expf(-z)); }
__device__ __forceinline__ v4u pack8(const f32x4 a, const f32x4 b) { v4u w; w.x = pg8::cvt_pk_bf16(a[0], a[1]); w.y = pg8::cvt_pk_bf16(a[2], a[3]); w.z = pg8::cvt_pk_bf16(b[0], b[1]); w.w = pg8::cvt_pk_bf16(b[2], b[3]); return w; }
__device__ __forceinline__ float wave_sum(float v) {
#pragma unroll
    for (int o = 1; o < 64; o <<= 1) v += __shfl_xor(v, o);
    return v;
}

struct EpiInProj {
    static constexpr bool PERM = true, AFTER_DRAIN = false;
    bf16 *QA, *KA, *VA, *QH, *IH, *ZG; float *LF, *LB; const float *lbl, *normg;
    __device__ __forceinline__ void operator()(const f32x4 (&acc)[2][2][4][2], const pg8::Unit& u, int wr, int wc, int fr, int fq) const {
        const int row0 = u.pm * 256 + wr * 64 + fr, cl = wc * 32 + 8 * fq, pn = u.pn;
        if (pn == 2) {
#pragma unroll
            for (int ai = 0; ai < 2; ++ai)
#pragma unroll
                for (int m = 0; m < 4; ++m) { const size_t r = (size_t)(row0 + ai * 128 + m * 16);
                    *(v4u*)(KA + r * 128 + cl) = pack8(acc[ai][0][m][0], acc[ai][0][m][1]);
                    *(v4u*)(VA + r * 128 + cl) = pack8(acc[ai][1][m][0], acc[ai][1][m][1]); }
        } else if (pn < 7) {
            bf16* base = pn < 2 ? QA + pn * 256 : (pn < 5 ? QH + (pn - 3) * 256 : IH + (pn - 5) * 256);
#pragma unroll
            for (int ai = 0; ai < 2; ++ai)
#pragma unroll
                for (int m = 0; m < 4; ++m) { bf16* rowp = base + (size_t)(row0 + ai * 128 + m * 16) * 512 + cl;
#pragma unroll
                    for (int bj = 0; bj < 2; ++bj) *(v4u*)(rowp + bj * 128) = pack8(acc[ai][bj][m][0], acc[ai][bj][m][1]); }
        } else if (pn < 11) {
            const int dir = pn >= 9 ? 1 : 0, cb = (pn - (dir ? 9 : 7)) * 256; float* base = (dir ? LB : LF) + cb;
#pragma unroll
            for (int bj = 0; bj < 2; ++bj) {
                float lb[8];
#pragma unroll
                for (int j = 0; j < 8; ++j) { const int col = cb + bj * 128 + cl + j; const float a0 = lbl[dir * 1024 + col], a1 = lbl[dir * 1024 + 512 + col]; lb[j] = 1.0f / (1.0f + __expf(a1 - a0)); }
#pragma unroll
                for (int ai = 0; ai < 2; ++ai)
#pragma unroll
                    for (int m = 0; m < 4; ++m) { float* rowp = base + (size_t)(row0 + ai * 128 + m * 16) * 512 + bj * 128 + cl;
                        f32x4 o0, o1, z0 = acc[ai][bj][m][0], z1 = acc[ai][bj][m][1];
                        asm volatile("" : "+v"(z0), "+v"(z1) :: "memory");
#pragma unroll
                        for (int j = 0; j < 4; ++j) { o0[j] = __logf(lb[j] + (1.0f - lb[j]) * fsigmoid(z0[j])); o1[j] = __logf(lb[4 + j] + (1.0f - lb[4 + j]) * fsigmoid(z1[j])); }
                        *(f32x4*)rowp = o0; *(f32x4*)(rowp + 4) = o1; }
            }
        } else {
            const int cb = (pn - 11) * 256;
#pragma unroll
            for (int bj = 0; bj < 2; ++bj) {
                const f32x4 g0 = *(const f32x4*)(normg + cb + bj * 128 + cl), g1 = *(const f32x4*)(normg + cb + bj * 128 + cl + 4);
#pragma unroll
                for (int ai = 0; ai < 2; ++ai)
#pragma unroll
                    for (int m = 0; m < 4; ++m) { bf16* rowp = ZG + (size_t)(row0 + ai * 128 + m * 16) * 512 + cb + bj * 128 + cl;
                        f32x4 o0, o1, y0 = acc[ai][bj][m][0], y1 = acc[ai][bj][m][1];
                        asm volatile("" : "+v"(y0), "+v"(y1) :: "memory");
#pragma unroll
                        for (int j = 0; j < 4; ++j) { const float z0 = y0[j], z1 = y1[j]; o0[j] = g0[j] * z0 * fsigmoid(z0); o1[j] = g1[j] * z1 * fsigmoid(z1); }
                        *(v4u*)rowp = pack8(o0, o1); }
            }
        }
    }
};
struct EpiOutProj {
    static constexpr bool PERM = false, AFTER_DRAIN = false;
    const bf16* H0; float* U;
    __device__ __forceinline__ void operator()(const f32x4 (&acc)[2][2][4][2], const pg8::Unit& u, int wr, int wc, int fr, int fq) const {
        const int row0 = u.pm * 256 + wr * 64 + fr, col0 = u.pn * 256 + wc * 32 + 4 * fq;
#pragma unroll
        for (int ai = 0; ai < 2; ++ai)
#pragma unroll
            for (int m = 0; m < 4; ++m) { const size_t off = (size_t)(row0 + ai * 128 + m * 16) * D + col0;
#pragma unroll
                for (int bj = 0; bj < 2; ++bj)
#pragma unroll
                    for (int n = 0; n < 2; ++n) { const u32x2 hb = *(const u32x2*)(H0 + off + bj * 128 + n * 16);
                        f32x4 h; h[0] = bflo(hb.x); h[1] = bfhi(hb.x); h[2] = bflo(hb.y); h[3] = bfhi(hb.y);
                        *(f32x4*)(U + off + bj * 128 + n * 16) = acc[ai][bj][m][n] + DN_ALPHA * h; } }
    }
};
struct EpiUp {
    static constexpr bool PERM = false, AFTER_DRAIN = false;
    bf16* ACT; const float* b_up;
    __device__ __forceinline__ void operator()(const f32x4 (&acc)[2][2][4][2], const pg8::Unit& u, int wr, int wc, int fr, int fq) const {
        const int e = u.pn >> 3, p = u.pn & 7, row0 = u.pm * 256 + wr * 64 + fr, a0 = 128 * p + 32 * wc + 8 * fq;
        f32x4 bg[2], bl[2];
#pragma unroll
        for (int bj = 0; bj < 2; ++bj) { const f32x4 x = *(const f32x4*)(b_up + e * DFF + 2 * (a0 + 4 * bj)), y = *(const f32x4*)(b_up + e * DFF + 2 * (a0 + 4 * bj) + 4);
            bg[bj] = (f32x4){x[0], x[2], y[0], y[2]}; bl[bj] = (f32x4){x[1], x[3], y[1], y[3]}; }
#pragma unroll
        for (int ai = 0; ai < 2; ++ai)
#pragma unroll
            for (int m = 0; m < 4; ++m) { f32x4 o[2], zg[2] = {acc[ai][0][m][0], acc[ai][1][m][0]}, zl[2] = {acc[ai][0][m][1], acc[ai][1][m][1]};
                asm volatile("" : "+v"(zg[0]), "+v"(zg[1]), "+v"(zl[0]), "+v"(zl[1]) :: "memory");
#pragma unroll
                for (int bj = 0; bj < 2; ++bj)
#pragma unroll
                    for (int j = 0; j < 4; ++j) { const float g = fminf(zg[bj][j] + bg[bj][j], SWIGLU_LIMIT); float l = zl[bj][j] + bl[bj][j]; l = fminf(fmaxf(l, -SWIGLU_LIMIT), SWIGLU_LIMIT);
                        o[bj][j] = g * fsigmoid(SWIGLU_ALPHA * g) * (l + 1.0f); }
                *(v4u*)(ACT + (size_t)(row0 + ai * 128 + m * 16) * D + a0) = pack8(o[0], o[1]); }
    }
};
struct EpiDown {
    static constexpr bool PERM = true, AFTER_DRAIN = false;
    bf16* Y; const int* rowTok; const float* gates; const float* b_down;
    __device__ __forceinline__ void operator()(const f32x4 (&acc)[2][2][4][2], const pg8::Unit& u, int wr, int wc, int fr, int fq) const {
        const int e = u.pn >> 2, colt = (u.pn & 3) * 256 + wc * 32 + 8 * fq, slot0 = u.pm * 256 + wr * 64 + fr;
        f32x4 bv[2][2];
#pragma unroll
        for (int bj = 0; bj < 2; ++bj)
#pragma unroll
            for (int n = 0; n < 2; ++n) bv[bj][n] = *(const f32x4*)(b_down + e * D + colt + bj * 128 + 4 * n);
#pragma unroll
        for (int ai = 0; ai < 2; ++ai)
#pragma unroll
            for (int m = 0; m < 4; ++m) { const int slot = slot0 + ai * 128 + m * 16; const int dest = rowTok[slot]; const float g = gates[slot];
                if (dest >= 0) { bf16* rowp = Y + (size_t)dest * D + colt;
#pragma unroll
                    for (int bj = 0; bj < 2; ++bj) *(v4u*)(rowp + bj * 128) = pack8((acc[ai][bj][m][0] + bv[bj][0]) * g, (acc[ai][bj][m][1] + bv[bj][1]) * g); } }
    }
};
struct MoeOrder {
    const LAS int* tileExpert; int nunits, nN, G, c;
    __device__ __forceinline__ bool next(int i, pg8::Unit& u) const {
        const int L = i * G + c; if (L >= nunits) return false;
        const int tile = L / nN, n = L - tile * nN; u.pm = tile; u.pn = tileExpert[tile] * nN + n; return true;
    }
    __device__ __forceinline__ void a_ready(const pg8::Unit&) const {}
    __device__ __forceinline__ void done(const pg8::Unit&) const {}
};

struct Frame {
    LAS unsigned char* lds;
    volatile LAS unsigned* MISC;
    gu32* ctl;
    int tid, lane, wave;
    int vcu, G;
    const float* in[18]; float* out; unsigned char* ws;
};

__device__ __forceinline__ int up_srccol(int dn) { const int p = dn >> 8, rho = dn & 255, bj = rho >> 7, wc = (rho >> 5) & 3, n = (rho >> 4) & 1, fq = (rho >> 2) & 3, j = rho & 3;
    return 2 * (128 * p + 32 * wc + 8 * fq + 4 * bj + j) + n; }
template <bool UPPERM>
__device__ __forceinline__ void p0_transpose_item(const float* W, int K, int N, bf16* WT, LAS float* scr, int item, int lane) {
    const int nblk = N / 32, kb = item / nblk, nb = item % nblk, k0 = 64 * kb, n0 = 32 * nb;
    const int sc = UPPERM ? up_srccol(n0 + (lane & 31)) : n0 + (lane & 31);
#pragma unroll 8
    for (int i = 0; i < 32; ++i) { const int kk = 2 * i + (lane >> 5); scr[kk * 33 + (lane & 31)] = W[(size_t)(k0 + kk) * N + sc]; }
    LDS_WAIT(); asm volatile("" ::: "memory");
    const int c = lane & 7;
#pragma unroll
    for (int j = 0; j < 4; ++j) { const int n = (lane >> 3) + 8 * j; const LAS float* s = scr + (8 * c) * 33 + n;
        v4u o; o.x = pk2(s[0 * 33], s[1 * 33]); o.y = pk2(s[2 * 33], s[3 * 33]); o.z = pk2(s[4 * 33], s[5 * 33]); o.w = pk2(s[6 * 33], s[7 * 33]);
        *(GAS v4u*)(WT + (size_t)(n0 + n) * K + k0 + 8 * c) = o; }
    LDS_WAIT(); asm volatile("" ::: "memory");
}
__device__ __forceinline__ void p0_prologue(Frame& F) {
    LAS float* scr = (LAS float*)(F.lds + RING_OFF + F.wave * 16384);
    const int gw = F.vcu * NWAVES + F.wave, NGW = F.G * NWAVES;
    constexpr int I_IN = (D / 64) * (NIN / 32), I_OUT = (D / 64) * (D / 32), I_UP1 = (D / 64) * (DFF / 32), I_DN1 = (D / 64) * (D / 32);
    constexpr int NITEMS = I_IN + I_OUT + NE * I_UP1 + NE * I_DN1;
    bf16* WinT = (bf16*)(F.ws + WS_WIN); bf16* WoutT = (bf16*)(F.ws + WS_WOUT); bf16* WupT = (bf16*)(F.ws + WS_WUP); bf16* WdT = (bf16*)(F.ws + WS_WD);
    for (int it = gw; it < NITEMS; it += NGW) {
        int r = it;
        if (r < I_IN) { p0_transpose_item<false>(F.in[3], D, NIN, WinT, scr, r, F.lane); continue; } r -= I_IN;
        if (r < I_OUT) { p0_transpose_item<false>(F.in[7], D, D, WoutT, scr, r, F.lane); continue; } r -= I_OUT;
        if (r < NE * I_UP1) { const int e = r / I_UP1; p0_transpose_item<true>(F.in[12] + (size_t)e * D * DFF, D, DFF, WupT + (size_t)e * DFF * D, scr, r % I_UP1, F.lane); continue; } r -= NE * I_UP1;
        { const int e = r / I_DN1; p0_transpose_item<false>(F.in[14] + (size_t)e * D * D, D, D, WdT + (size_t)e * D * D, scr, r % I_DN1, F.lane); }
    }
    const float* x = F.in[0]; bf16* H0 = (bf16*)(F.ws + WS_H0);
    f32x4 gg[4], bb[4];
#pragma unroll
    for (int j = 0; j < 4; ++j) { gg[j] = ((const f32x4*)F.in[1])[F.lane + 64 * j]; bb[j] = ((const f32x4*)F.in[2])[F.lane + 64 * j]; }
    for (int m = gw; m < T; m += NGW) {
        const GAS f32x4* xr = (const GAS f32x4*)(x + (size_t)m * D) + F.lane;
        f32x4 v[4]; float s = 0.f;
#pragma unroll
        for (int j = 0; j < 4; ++j) { v[j] = xr[64 * j]; s += (v[j].x + v[j].y) + (v[j].z + v[j].w); }
        const float mean = wave_sum(s) * (1.f / D); float s2 = 0.f;
#pragma unroll
        for (int j = 0; j < 4; ++j) { v[j] = v[j] - mean; s2 += (v[j].x * v[j].x + v[j].y * v[j].y) + (v[j].z * v[j].z + v[j].w * v[j].w); }
        const float rstd = 1.f / sqrtf(wave_sum(s2) * (1.f / D) + LN_EPS);
        GAS u32x2* o8 = (GAS u32x2*)(H0 + (size_t)m * D) + F.lane;
#pragma unroll
        for (int j = 0; j < 4; ++j) { const f32x4 y = v[j] * rstd * gg[j] + bb[j]; u32x2 w; w.x = pg8::cvt_pk_bf16(y[0], y[1]); w.y = pg8::cvt_pk_bf16(y[2], y[3]); o8[64 * j] = w; }
    }
}

__device__ __forceinline__ void p2_attn_simple(Frame& F) {
    const bf16* QA = (const bf16*)(F.ws + WS_QA); const bf16* KA = (const bf16*)(F.ws + WS_KA); const bf16* VA = (const bf16*)(F.ws + WS_VA); bf16* MIX = (bf16*)(F.ws + WS_MIX);
    const float* sink = F.in[4];
    const int gw = F.vcu * NWAVES + F.wave, NGW = F.G * NWAVES;
    for (int task = gw; task < NB * 8 * (SEQ / 64); task += NGW) {
        const int qb = task & 31, hq = (task >> 5) & 7, b = task >> 8, g = hq >> 2;
        const int t = qb * 64 + F.lane; const size_t row = (size_t)b * SEQ + t;
        float q[64], o[64];
        { const v4u* qp = (const v4u*)(QA + row * 512 + hq * 64);
#pragma unroll
          for (int i = 0; i < 8; ++i) { const v4u w = qp[i]; q[8 * i] = bflo(w.x); q[8 * i + 1] = bfhi(w.x); q[8 * i + 2] = bflo(w.y); q[8 * i + 3] = bfhi(w.y); q[8 * i + 4] = bflo(w.z); q[8 * i + 5] = bfhi(w.z); q[8 * i + 6] = bflo(w.w); q[8 * i + 7] = bfhi(w.w); } }
#pragma unroll
        for (int i = 0; i < 64; ++i) o[i] = 0.f;
        float m = sink[hq], l = 1.0f; const float slope = exp2f(-(float)(hq + 1));
        const int lo = (qb * 64 - 128) < 0 ? 0 : qb * 64 - 128, hi = (qb * 64 + 63 + 128) > SEQ - 1 ? SEQ - 1 : qb * 64 + 63 + 128;
        for (int s = lo; s <= hi; ++s) {
            const v4u* kp = (const v4u*)(KA + ((size_t)b * SEQ + s) * 128 + g * 64); const v4u* vp = (const v4u*)(VA + ((size_t)b * SEQ + s) * 128 + g * 64);
            float dot = 0.f;
#pragma unroll
            for (int i = 0; i < 8; ++i) { const v4u w = kp[i]; dot += q[8 * i] * bflo(w.x) + q[8 * i + 1] * bfhi(w.x) + q[8 * i + 2] * bflo(w.y) + q[8 * i + 3] * bfhi(w.y) + q[8 * i + 4] * bflo(w.z) + q[8 * i + 5] * bfhi(w.z) + q[8 * i + 6] * bflo(w.w) + q[8 * i + 7] * bfhi(w.w); }
            const int dist = t > s ? t - s : s - t; const bool valid = dist <= 128;
            const float sc = dot * 0.125f - slope * (float)dist;
            const float mn = valid ? fmaxf(m, sc) : m; const float a = __expf(m - mn), p = valid ? __expf(sc - mn) : 0.f;
            l = l * a + p; m = mn;
#pragma unroll
            for (int i = 0; i < 8; ++i) { const v4u w = vp[i];
                o[8 * i] = o[8 * i] * a + p * bflo(w.x); o[8 * i + 1] = o[8 * i + 1] * a + p * bfhi(w.x); o[8 * i + 2] = o[8 * i + 2] * a + p * bflo(w.y); o[8 * i + 3] = o[8 * i + 3] * a + p * bfhi(w.y);
                o[8 * i + 4] = o[8 * i + 4] * a + p * bflo(w.z); o[8 * i + 5] = o[8 * i + 5] * a + p * bfhi(w.z); o[8 * i + 6] = o[8 * i + 6] * a + p * bflo(w.w); o[8 * i + 7] = o[8 * i + 7] * a + p * bfhi(w.w); }
        }
        const float inv = 1.0f / l; v4u* op = (v4u*)(MIX + row * D + hq * 64);
#pragma unroll
        for (int i = 0; i < 8; ++i) { v4u w; w.x = pg8::cvt_pk_bf16(o[8 * i] * inv, o[8 * i + 1] * inv); w.y = pg8::cvt_pk_bf16(o[8 * i + 2] * inv, o[8 * i + 3] * inv); w.z = pg8::cvt_pk_bf16(o[8 * i + 4] * inv, o[8 * i + 5] * inv); w.w = pg8::cvt_pk_bf16(o[8 * i + 6] * inv, o[8 * i + 7] * inv); op[i] = w; }
    }
}
__device__ __forceinline__ void p2_hgrn_simple(Frame& F) {
    const bf16* QH = (const bf16*)(F.ws + WS_QH); const bf16* IH = (const bf16*)(F.ws + WS_IH);
    LAS float* Qs = (LAS float*)(F.lds + RING_OFF); LAS float* Fs = Qs + 32 * 128; LAS float* Vs = Fs + 32 * 128;
    const int vidx = F.tid >> 2, dq = F.tid & 3;
    for (int unit = F.vcu; unit < NB * 4 * 2; unit += F.G) {
        const int dir = unit & 1, h = (unit >> 1) & 3, b = unit >> 3;
        const float* LG = (const float*)(F.ws + (dir ? WS_LB : WS_LF)); float* OUT = (float*)(F.ws + (dir ? WS_OB : WS_OF));
        float S[32];
#pragma unroll
        for (int i = 0; i < 32; ++i) S[i] = 0.f;
        for (int tile = 0; tile < SEQ / 32; ++tile) {
            __syncthreads();
#pragma unroll
            for (int i = 0; i < 8; ++i) { const int idx = F.tid + 512 * i, tt = idx >> 7, d = idx & 127; const int t = dir ? SEQ - 1 - (tile * 32 + tt) : tile * 32 + tt;
                const size_t g = ((size_t)b * SEQ + t) * 512 + h * 128 + d;
                Qs[idx] = __uint_as_float(((unsigned)QH[g]) << 16); Vs[idx] = __uint_as_float(((unsigned)IH[g]) << 16); Fs[idx] = __expf(LG[g]); }
            __syncthreads();
            for (int tt = 0; tt < 32; ++tt) {
                const float v = Vs[tt * 128 + vidx]; float o = 0.f;
#pragma unroll
                for (int dd = 0; dd < 32; dd += 4) { const f32x4 f = *(const LAS f32x4*)(Fs + tt * 128 + dq * 32 + dd), qq = *(const LAS f32x4*)(Qs + tt * 128 + dq * 32 + dd);
#pragma unroll
                    for (int j = 0; j < 4; ++j) { S[dd + j] = f[j] * (S[dd + j] - v) + v; o += S[dd + j] * qq[j]; } }
                o += __shfl_xor(o, 1); o += __shfl_xor(o, 2);
                const int t = dir ? SEQ - 1 - (tile * 32 + tt) : tile * 32 + tt;
                if (dq == 0) OUT[((size_t)b * SEQ + t) * 512 + h * 128 + vidx] = o;
            }
        }
    }
}
__device__ __forceinline__ void p3_finalize(Frame& F) {
    const float* OFp = (const float*)(F.ws + WS_OF); const float* OBp = (const float*)(F.ws + WS_OB); const bf16* ZG = (const bf16*)(F.ws + WS_ZG); bf16* MIX = (bf16*)(F.ws + WS_MIX);
    const int gw = F.vcu * NWAVES + F.wave, NGW = F.G * NWAVES;
    for (int it = gw; it < T * 4; it += NGW) {
        const int tok = it >> 2, h = it & 3; const size_t g = (size_t)tok * 512 + h * 128 + 2 * F.lane;
        const float2 a = *(const float2*)(OFp + g), c = *(const float2*)(OBp + g); const float o0 = a.x + c.x, o1 = a.y + c.y;
        const float ss = wave_sum(o0 * o0 + o1 * o1); const float r = 1.0f / sqrtf(ss * (1.0f / 128.0f) + RMS_EPS);
        const unsigned zg = *(const unsigned*)(ZG + g);
        *(unsigned*)(MIX + (size_t)tok * D + 512 + h * 128 + 2 * F.lane) = pg8::cvt_pk_bf16(o0 * r * bflo(zg), o1 * r * bfhi(zg));
    }
}

__device__ __forceinline__ void p5_router(Frame& F) {
    const float* U = (const float*)(F.ws + WS_U); bf16* H1 = (bf16*)(F.ws + WS_H1); int* TOPI = (int*)(F.ws + WS_TOPI); float* TOPG = (float*)(F.ws + WS_TOPG); int* cntTab = (int*)(F.ws + WS_TAB);
    const float* Wr = F.in[10]; const float* br = F.in[11];
    LAS float* WrT = (LAS float*)(F.lds + RING_OFF);
    LAS int* hist = (LAS int*)(F.lds + HIST_OFF);
    __syncthreads();
    for (int i = F.tid; i < NE * D; i += NWAVES * 64) { const int e = i >> 10, k = i & 1023; WrT[i] = Wr[k * NE + e]; }
    f32x4 gg[4], bb[4];
#pragma unroll
    for (int j = 0; j < 4; ++j) { gg[j] = ((const f32x4*)F.in[8])[F.lane + 64 * j]; bb[j] = ((const f32x4*)F.in[9])[F.lane + 64 * j]; }
    const float mybias = br[F.lane & 31];
    for (int chunk = F.vcu; chunk < NCHUNK; chunk += F.G) {
        if (F.tid < NE) hist[F.tid] = 0;
        __syncthreads();
        for (int ti = 0; ti < CHUNK_TOK / NWAVES; ++ti) {
            const int tok = chunk * CHUNK_TOK + F.wave * (CHUNK_TOK / NWAVES) + ti;
            const GAS f32x4* ur = (const GAS f32x4*)(U + (size_t)tok * D) + F.lane;
            f32x4 v[4]; float s = 0.f;
#pragma unroll
            for (int j = 0; j < 4; ++j) { v[j] = ur[64 * j]; s += (v[j].x + v[j].y) + (v[j].z + v[j].w); }
            const float mean = wave_sum(s) * (1.f / D); float s2 = 0.f;
#pragma unroll
            for (int j = 0; j < 4; ++j) { v[j] = v[j] - mean; s2 += (v[j].x * v[j].x + v[j].y * v[j].y) + (v[j].z * v[j].z + v[j].w * v[j].w); }
            const float rstd = 1.f / sqrtf(wave_sum(s2) * (1.f / D) + LN_EPS);
            GAS u32x2* o8 = (GAS u32x2*)(H1 + (size_t)tok * D) + F.lane;
#pragma unroll
            for (int j = 0; j < 4; ++j) { v[j] = v[j] * rstd * gg[j] + bb[j]; u32x2 w; w.x = pg8::cvt_pk_bf16(v[j][0], v[j][1]); w.y = pg8::cvt_pk_bf16(v[j][2], v[j][3]); o8[64 * j] = w; }
            float mylogit = -3.0e38f;
#pragma unroll 4
            for (int e = 0; e < NE; ++e) {
                float p = 0.f;
#pragma unroll
                for (int j = 0; j < 4; ++j) { const f32x4 w = *(const LAS f32x4*)(WrT + e * D + 256 * j + 4 * F.lane); p += (v[j][0] * w[0] + v[j][1] * w[1]) + (v[j][2] * w[2] + v[j][3] * w[3]); }
                p = wave_sum(p);
                mylogit = (F.lane == e) ? p + mybias : mylogit;
            }
            float tv[4]; int tix[4];
#pragma unroll
            for (int k = 0; k < 4; ++k) {
                float bv = mylogit; int bi = F.lane;
#pragma unroll
                for (int o = 1; o < 64; o <<= 1) { const float ov = __shfl_xor(bv, o); const int oi = __shfl_xor(bi, o); const bool take = (ov > bv) || (ov == bv && oi < bi); bv = take ? ov : bv; bi = take ? oi : bi; }
                tv[k] = bv; tix[k] = bi; if (F.lane == bi) mylogit = -3.0e38f;
            }
            const float e1 = __expf(tv[1] - tv[0]), e2 = __expf(tv[2] - tv[0]), e3 = __expf(tv[3] - tv[0]); const float inv = 1.0f / (1.0f + e1 + e2 + e3);
            if (F.lane == 0) {
                *(int4*)(TOPI + (size_t)tok * 4) = make_int4(tix[0], tix[1], tix[2], tix[3]);
                *(float4*)(TOPG + (size_t)tok * 4) = make_float4(inv, e1 * inv, e2 * inv, e3 * inv);
                atomicAdd((int*)&hist[tix[0]], 1); atomicAdd((int*)&hist[tix[1]], 1); atomicAdd((int*)&hist[tix[2]], 1); atomicAdd((int*)&hist[tix[3]], 1);
            }
        }
        __syncthreads();
        if (F.tid < NE) cntTab[chunk * NE + F.tid] = hist[F.tid];
        __syncthreads();
    }
}

__device__ __forceinline__ void p6_dispatch(Frame& F) {
    const int* cntTab = (const int*)(F.ws + WS_TAB); int* tileExpertG = (int*)(F.ws + WS_TAB + 65536); int* ntilesG = (int*)(F.ws + WS_TAB + 98304);
    const int* TOPI = (const int*)(F.ws + WS_TOPI); const float* TOPG = (const float*)(F.ws + WS_TOPG); int* ROWTOK = (int*)(F.ws + WS_ROWTOK); float* GATES = (float*)(F.ws + WS_GATES);
    const bf16* H1 = (const bf16*)(F.ws + WS_H1); bf16* XG = (bf16*)(F.ws + WS_XG);
    LAS int* ptot = (LAS int*)(F.lds + RING_OFF);
    LAS int* ppre = ptot + 512;
    LAS int* tot = ppre + 512;
    LAS int* base = tot + 32;
    LAS int* myoff = base + 36;
    LAS int* ent = myoff + 32;
    LAS int* slotl = ent + 512;
    for (int chunk = F.vcu; chunk < NCHUNK; chunk += F.G) {
        __syncthreads();
        { const int e = F.tid & 31, part = F.tid >> 5; int st = 0, sp = 0;
          for (int w = part * 16; w < part * 16 + 16; ++w) { const int c = cntTab[w * NE + e]; st += c; sp += (w < chunk) ? c : 0; }
          ptot[part * 32 + e] = st; ppre[part * 32 + e] = sp; }
        ent[F.tid] = TOPI[(size_t)chunk * CHUNK_TOK * 4 + F.tid];
        __syncthreads();
        if (F.tid < NE) { int st = 0, sp = 0; for (int p = 0; p < 16; ++p) { st += ptot[p * 32 + F.tid]; sp += ppre[p * 32 + F.tid]; } tot[F.tid] = st; myoff[F.tid] = sp; }
        __syncthreads();
        if (F.tid == 0) { int acc = 0; for (int e = 0; e < NE; ++e) { base[e] = acc; acc += (tot[e] + 255) & ~255; } base[NE] = acc; }
        __syncthreads();
        if (F.tid < NE) { int pos = base[F.tid] + myoff[F.tid]; for (int i = 0; i < 512; ++i) if (ent[i] == F.tid) slotl[i] = pos++; }
        __syncthreads();
        { const int slot = slotl[F.tid]; const size_t ge = (size_t)chunk * CHUNK_TOK * 4 + F.tid; ROWTOK[slot] = (int)ge; GATES[slot] = TOPG[ge]; }
        if (chunk == 0) {
            if (F.tid < NE) { const int e = F.tid; for (int tl = base[e] >> 8; tl < (base[e + 1] >> 8); ++tl) tileExpertG[tl] = e; for (int s = base[e] + tot[e]; s < base[e + 1]; ++s) { ROWTOK[s] = -1; GATES[s] = 0.f; } }
            if (F.tid == 0) ntilesG[0] = base[NE] >> 8;
        }
        for (int i = 0; i < 64; ++i) { const int idx = F.wave * 64 + i; const int tok = chunk * CHUNK_TOK + (idx >> 2); const int slot = slotl[idx];
            const v4u* src = (const v4u*)(H1 + (size_t)tok * D); v4u* dst = (v4u*)(XG + (size_t)slot * D);
            dst[F.lane] = src[F.lane]; dst[F.lane + 64] = src[F.lane + 64]; }
    }
}

__device__ __forceinline__ void p9_combine(Frame& F) {
    const bf16* H1 = (const bf16*)(F.ws + WS_H1); const bf16* Y = (const bf16*)(F.ws + WS_Y);
    const int gw = F.vcu * NWAVES + F.wave, NGW = F.G * NWAVES;
    f32x4 gg[4], bb[4];
#pragma unroll
    for (int j = 0; j < 4; ++j) { gg[j] = ((const f32x4*)F.in[16])[F.lane + 64 * j]; bb[j] = ((const f32x4*)F.in[17])[F.lane + 64 * j]; }
    for (int tok = gw; tok < T; tok += NGW) {
        f32x4 v[4]; float s = 0.f;
#pragma unroll
        for (int j = 0; j < 4; ++j) { const u32x2 hb = ((const u32x2*)(H1 + (size_t)tok * D))[F.lane + 64 * j];
            v[j][0] = DN_ALPHA * bflo(hb.x); v[j][1] = DN_ALPHA * bfhi(hb.x); v[j][2] = DN_ALPHA * bflo(hb.y); v[j][3] = DN_ALPHA * bfhi(hb.y);
#pragma unroll
            for (int k = 0; k < 4; ++k) { const u32x2 yb = ((const u32x2*)(Y + ((size_t)tok * 4 + k) * D))[F.lane + 64 * j]; v[j][0] += bflo(yb.x); v[j][1] += bfhi(yb.x); v[j][2] += bflo(yb.y); v[j][3] += bfhi(yb.y); }
            s += (v[j].x + v[j].y) + (v[j].z + v[j].w); }
        const float mean = wave_sum(s) * (1.f / D); float s2 = 0.f;
#pragma unroll
        for (int j = 0; j < 4; ++j) { v[j] = v[j] - mean; s2 += (v[j].x * v[j].x + v[j].y * v[j].y) + (v[j].z * v[j].z + v[j].w * v[j].w); }
        const float rstd = 1.f / sqrtf(wave_sum(s2) * (1.f / D) + LN_EPS);
        GAS f32x4* o = (GAS f32x4*)(F.out + (size_t)tok * D) + F.lane;
#pragma unroll
        for (int j = 0; j < 4; ++j) o[64 * j] = v[j] * rstd * gg[j] + bb[j];
    }
}

struct Args { const float* in[18]; float* out; unsigned char* ws; int ph_lo, ph_hi; };
__global__ void __launch_bounds__(NWAVES * 64, 2) hymba_fwd(Args args) {
    extern __shared__ __attribute__((aligned(16))) unsigned char lds[];
    Frame F;
    F.lds = (LAS unsigned char*)lds;
    F.MISC = (volatile LAS unsigned*)(F.lds + MISC_OFF);
    F.tid = threadIdx.x; F.lane = F.tid & 63; F.wave = __builtin_amdgcn_readfirstlane(F.tid >> 6);
    F.G = gridDim.x; { const int bx = blockIdx.x; F.vcu = (F.G % 8 == 0) ? (bx % 8) * (F.G / 8) + bx / 8 : bx; }
    F.ws = args.ws; F.out = args.out; F.ctl = (gu32*)(args.ws + WS_CTL);
#pragma unroll
    for (int i = 0; i < 18; ++i) F.in[i] = args.in[i];
    for (int u = F.tid; u < (LDS_BYTES - LDSCTL_OFF) / 4; u += NWAVES * 64) ((LAS unsigned*)(F.lds + LDSCTL_OFF))[u] = 0u;
    __syncthreads();
    XcdBarrier bar; bar.bar = (unsigned*)(F.ctl + CW_BAR); bar.x = 0; bar.st = nullptr;
    if (N_LAUNCHES == 1) bar = xcd_barrier_post((unsigned*)(F.ctl + CW_BAR), F.MISC + 8);
#define GRID_BAR() do { if (N_LAUNCHES == 1) xcd_barrier(bar); } while (0)
    const int lo = args.ph_lo, hi = args.ph_hi;
#define IN(k) (lo <= (k) && (k) < hi)
#define BOTH(k) (IN(k) && IN((k) + 1))
    unsigned char* ws = args.ws;

    if (IN(0)) { p0_prologue(F); if (BOTH(0)) GRID_BAR(); }

    if (IN(1)) {
        pg8::Gemm g{(const bf16*)(ws + WS_H0), (const bf16*)(ws + WS_WIN), T, NIN, D}; pg8::StaticOrder S; S.init(T, NIN, F.G, (int)blockIdx.x);
        EpiInProj E{(bf16*)(ws + WS_QA), (bf16*)(ws + WS_KA), (bf16*)(ws + WS_VA), (bf16*)(ws + WS_QH), (bf16*)(ws + WS_IH), (bf16*)(ws + WS_ZG), (float*)(ws + WS_LF), (float*)(ws + WS_LB), F.in[5], F.in[6]};
        pg8::gemm_phase<EpiInProj, pg8::StaticOrder, true, true>(F.lds + RING_OFF, g, S, E);
        if (BOTH(1)) GRID_BAR();
    }
    if (IN(2)) { p2_attn_simple(F); p2_hgrn_simple(F); if (BOTH(2)) GRID_BAR(); }
    if (IN(3)) { p3_finalize(F); if (BOTH(3)) GRID_BAR(); }
    if (IN(4)) {
        pg8::Gemm g{(const bf16*)(ws + WS_MIX), (const bf16*)(ws + WS_WOUT), T, D, D}; pg8::StaticOrder S; S.init(T, D, F.G, (int)blockIdx.x);
        EpiOutProj E{(const bf16*)(ws + WS_H0), (float*)(ws + WS_U)};
        pg8::gemm_phase<EpiOutProj, pg8::StaticOrder, true, true>(F.lds + RING_OFF, g, S, E);
        if (BOTH(4)) GRID_BAR();
    }
    if (IN(5)) { p5_router(F); if (BOTH(5)) GRID_BAR(); }
    if (IN(6)) { p6_dispatch(F); if (BOTH(6)) GRID_BAR(); }
    if (IN(7) || IN(8)) {
        const int* tileExpertG = (const int*)(ws + WS_TAB + 65536);
        __syncthreads();
        for (int i = F.tid; i < MAXTILES; i += NWAVES * 64) ((LAS int*)(F.lds + TAB_OFF))[i] = tileExpertG[i] & 31;
        __syncthreads();
    }
    const int ntiles = (IN(7) || IN(8)) ? *(const int*)(ws + WS_TAB + 98304) : 0;
    if (IN(7)) {
        pg8::Gemm g{(const bf16*)(ws + WS_XG), (const bf16*)(ws + WS_WUP), MAXSLOTS, NE * DFF, D}; MoeOrder S{(const LAS int*)(F.lds + TAB_OFF), ntiles * 8, 8, F.G, (int)blockIdx.x};
        EpiUp E{(bf16*)(ws + WS_ACT), F.in[13]};
        pg8::gemm_phase<EpiUp, MoeOrder, true, true>(F.lds + RING_OFF, g, S, E);
        if (BOTH(7)) GRID_BAR();
    }
    if (IN(8)) {
        pg8::Gemm g{(const bf16*)(ws + WS_ACT), (const bf16*)(ws + WS_WD), MAXSLOTS, NE * D, D}; MoeOrder S{(const LAS int*)(F.lds + TAB_OFF), ntiles * 4, 4, F.G, (int)blockIdx.x};
        EpiDown E{(bf16*)(ws + WS_Y), (const int*)(ws + WS_ROWTOK), (const float*)(ws + WS_GATES), F.in[15]};
        pg8::gemm_phase<EpiDown, MoeOrder, true, true>(F.lds + RING_OFF, g, S, E);
        if (BOTH(8)) GRID_BAR();
    }
    if (IN(9)) { p9_combine(F); }
#undef IN
#undef BOTH
}

extern "C" void kernel_launch(void* const* d_in, const int* in_sizes, int n_in, void* d_out, int out_size, void* d_ws, size_t ws_size, hipStream_t stream) {
    static int grid = 0;
    if (grid == 0) {
        if (n_in != 18 || in_sizes[0] != T * D || out_size != T * D || ws_size < WS_END) { fprintf(stderr, "kernel_launch: unexpected shapes (n_in %d, in0 %d, out %d, ws %zu); nothing launched\n", n_in, n_in > 0 ? in_sizes[0] : -1, out_size, ws_size); grid = -1; return; }
        int dev = 0, cus = 0, per_cu = 0;
        if (hipGetDevice(&dev) != hipSuccess || hipDeviceGetAttribute(&cus, hipDeviceAttributeMultiprocessorCount, dev) != hipSuccess) { grid = -1; return; }
        if (hipFuncSetAttribute((const void*)hymba_fwd, hipFuncAttributeMaxDynamicSharedMemorySize, LDS_BYTES) != hipSuccess) { fprintf(stderr, "kernel_launch: hipFuncSetAttribute failed\n"); grid = -1; return; }
        if (hipOccupancyMaxActiveBlocksPerMultiprocessor(&per_cu, (const void*)hymba_fwd, NWAVES * 64, LDS_BYTES) != hipSuccess || per_cu < 1) fprintf(stderr, "kernel_launch: occupancy query says %d\n", per_cu);
        (void)hipGetLastError();
        grid = cus;
    }
    if (grid < 0) return;
    if (hipMemsetAsync((char*)d_ws + WS_CTL, 0, CTL_ZERO_BYTES, stream) != hipSuccess) return;
    Args a{};
    for (int i = 0; i < 18; ++i) a.in[i] = (const float*)d_in[i];
    a.out = (float*)d_out; a.ws = (unsigned char*)d_ws;
    if (N_LAUNCHES == 1) { a.ph_lo = 0; a.ph_hi = PER_PHASE; hipLaunchKernelGGL(hymba_fwd, dim3(grid), dim3(NWAVES * 64), LDS_BYTES, stream, a); }
    else for (int li = 0; li < PER_PHASE; ++li) { a.ph_lo = li; a.ph_hi = li + 1; hipLaunchKernelGGL(hymba_fwd, dim3(grid), dim3(NWAVES * 64), LDS_BYTES, stream, a); }
}
```

```cpp
#include <hip/hip_runtime.h>
#include <cstdio>
#include <cstdint>
#ifndef MK_N_LAUNCHES
#define MK_N_LAUNCHES 1
#endif
namespace pg8 {
#define PG8_LAS __attribute__((address_space(3)))
typedef unsigned short bf16_t;
typedef short bf16x8 __attribute__((ext_vector_type(8)));
typedef float f32x4 __attribute__((ext_vector_type(4)));
typedef unsigned u32x4 __attribute__((ext_vector_type(4)));
constexpr int BM = 256, BK = 64, HALF = 128, HTB = HALF * BK * 2  , STAGE_BYTES = 8 * HTB, NXCD = 8, WGM = 8;

__host__ __device__ __forceinline__ int lds_byte(int r, int c) { const int st = (r >> 4) * 2 + (c >> 5), rr = r & 15, cc = c & 31, ob = rr * 64 + cc * 2; return st * 1024 + (ob ^ (((ob >> 9) & 1) << 5)); }
__host__ __device__ __forceinline__ void stage_rc(int b, int& R, int& C) { const int st = b / 1024, sb = b % 1024, swz = sb ^ (((sb >> 9) & 1) << 5); R = (st >> 1) * 16 + swz / 64; C = (st & 1) * 32 + (swz % 64) / 2; }
__host__ __device__ __forceinline__ int perm32(int rho) { const int n = rho >> 4, i = rho & 15; return 8 * (i >> 2) + 4 * n + (i & 3); }

struct Unit { int pm, pn; };
struct Gemm { const bf16_t* A; const bf16_t* Bt; int M, N, K; };

struct StaticOrder {
    int nM, nN, nwg, G, c;
    __host__ __device__ void init(int M, int N, int G_, int c_) { nM = M / BM; nN = N / BM; nwg = nM * nN; G = G_; c = c_; }
    __host__ __device__ bool next(int i, Unit& u) const {
        const long L = (long)i * G + c; if (L >= nwg) return false;
        int wgid = (int)L; { const int q = nwg / NXCD, r = nwg % NXCD, xcd = wgid % NXCD, off = wgid / NXCD; wgid = (xcd < r ? xcd * (q + 1) : r * (q + 1) + (xcd - r) * q) + off; }
        const int nig = WGM * nN, gid = wgid / nig, fm = gid * WGM, gsz = (nM - fm) < WGM ? (nM - fm) : WGM;
        u.pm = fm + ((wgid % nig) % gsz); u.pn = (wgid % nig) / gsz; return true;
    }
    __device__ __forceinline__ void a_ready(const Unit&) const {}
    __device__ __forceinline__ void done(const Unit&) const {}
};

__device__ __forceinline__ unsigned cvt_pk_bf16(float lo, float hi) { unsigned r; asm volatile("v_cvt_pk_bf16_f32 %0, %1, %2" : "=v"(r) : "v"(lo), "v"(hi)); return r; }
typedef float f32x2 __attribute__((ext_vector_type(2)));
__device__ __forceinline__ f32x2 gelu_pk(f32x2 v) {
    const f32x2 av = __builtin_elementwise_abs(v), d = av * 0.2316418882f + 1.0f;
    f32x2 t; t.x = __builtin_amdgcn_rcpf(d.x); t.y = __builtin_amdgcn_rcpf(d.y);
    f32x2 q = t * 0.5307027145f + (-0.7265760135f); q = q * t + 0.7107068705f; q = q * t + (-0.142248368f); q = q * t + 0.127414796f; q = q * t;
    const f32x2 s = (v * v) * (-0.72134752044f);
    f32x2 e; e.x = __builtin_amdgcn_exp2f(s.x); e.y = __builtin_amdgcn_exp2f(s.y);
    const f32x2 m = v * (q * e), r = v - m;
    f32x2 o; o.x = v.x < 0.f ? m.x : r.x; o.y = v.y < 0.f ? m.y : r.y; return o;
}

template <int ACT  > struct EpiBf16 {
    static constexpr bool PERM = true, AFTER_DRAIN = false; static_assert(ACT == 0 || ACT == 1, "EpiBf16: ACT is 0 (none) or 1 (gelu_pk)");
    bf16_t* O; int ldc; const float* bias; int split_cols; size_t split_stride; float scale0;
    __device__ __forceinline__ void operator()(const f32x4 (&acc)[2][2][4][2], const Unit& u, int wr, int wc, int fr, int fq) const {
        const int row0 = u.pm * BM + wr * 64 + fr; int colt = u.pn * BM; bf16_t* base = O;
        float sc = 1.f; if (split_cols) { const int t = colt / split_cols; base += (size_t)t * split_stride; colt -= t * split_cols; if (t == 0) sc = scale0; }
        const int col0 = colt + wc * 32 + 8 * fq, bcol0 = u.pn * BM + wc * 32 + 8 * fq;
        f32x4 bv[2][2];
#pragma unroll
        for (int bj = 0; bj < 2; ++bj)
#pragma unroll
            for (int n = 0; n < 2; ++n) bv[bj][n] = bias ? *(const f32x4*)(bias + bcol0 + bj * HALF + 4 * n) : (f32x4){0.f, 0.f, 0.f, 0.f};
#pragma unroll
        for (int ai = 0; ai < 2; ++ai)
#pragma unroll
            for (int m = 0; m < 4; ++m) { bf16_t* rowp = base + (size_t)(row0 + ai * HALF + m * 16) * ldc + col0;
#pragma unroll
                for (int bj = 0; bj < 2; ++bj) { f32x4 v0 = acc[ai][bj][m][0] + bv[bj][0], v1 = acc[ai][bj][m][1] + bv[bj][1];
                    if (ACT == 1) { f32x2 a = gelu_pk((f32x2){v0[0], v0[1]}), b = gelu_pk((f32x2){v0[2], v0[3]}), c = gelu_pk((f32x2){v1[0], v1[1]}), d = gelu_pk((f32x2){v1[2], v1[3]});
                        v0 = (f32x4){a.x, a.y, b.x, b.y}; v1 = (f32x4){c.x, c.y, d.x, d.y}; }
                    v0 = v0 * sc; v1 = v1 * sc; u32x4 w; w.x = cvt_pk_bf16(v0[0], v0[1]); w.y = cvt_pk_bf16(v0[2], v0[3]); w.z = cvt_pk_bf16(v1[0], v1[1]); w.w = cvt_pk_bf16(v1[2], v1[3]);
                    *(u32x4*)(rowp + bj * HALF) = w; } }
    }
};
typedef int i32x8 __attribute__((ext_vector_type(8)));
template <class Epi, class Sched, bool ALIGN_EPI = false, bool SP2 = false, bool GATHER = false, bool FP8 = false>
__device__ __forceinline__ void gemm_phase(PG8_LAS unsigned char* lds, const Gemm g, const Sched& S, const Epi& E, const PG8_LAS unsigned short* rowl = nullptr) {
    static_assert(!GATHER || SP2, "GATHER is implemented for the SP2 loop only");
    const int tid = threadIdx.x, wid = __builtin_amdgcn_readfirstlane(tid >> 6), lane = tid & 63, wr = wid >> 2, wc = wid & 3, fr = lane & 15, fq = lane >> 4;
    const int K = g.K, nt = K / BK;
    unsigned voffA[2], voffB[2];
#pragma unroll
    for (int i = 0; i < 2; ++i) { int R, C; stage_rc(tid * 16 + i * 8192, R, C); const int Rb = Epi::PERM ? ((R & ~31) + perm32(R & 31)) : R;
        voffA[i] = (unsigned)(R * K + C) * 2u; voffB[i] = (unsigned)(Rb * K + C) * 2u; }
    const size_t kstep = (size_t)(BK * 2);
    const size_t hstep = (size_t)HALF * K * 2;
    const size_t tstep = 2 * hstep;
    const unsigned ldsw = (unsigned)wid * 1024u;
    const int aoff = lds_byte(wr * 64 + fr, fq * 8), boff = lds_byte(wc * 32 + fr, fq * 8);
#define PG8_SA(b, h) (((b) * 2 + (h)) * HTB)
#define PG8_SB(b, h) ((4 + (b) * 2 + (h)) * HTB)
#define PG8_STAGE(bufoff, gbase, voff) do { _Pragma("unroll") for (int _i = 0; _i < 2; ++_i) \
        __builtin_amdgcn_global_load_lds((const unsigned*)((const char*)(gbase) + (voff)[_i]), (PG8_LAS unsigned*)(lds + (bufoff) + ldsw + _i * 8192), 16, 0, 0); } while (0)
#define PG8_STAGE_AG(bufoff, kb, rw, h) do { _Pragma("unroll") for (int _i = 0; _i < 2; ++_i) \
        __builtin_amdgcn_global_load_lds((const unsigned*)((const char*)g.A + (kb) + (rw)[h][_i]), (PG8_LAS unsigned*)(lds + (bufoff) + ldsw + _i * 8192), 16, 0, 0); } while (0)
#define PG8_ROWS(rw, uidx) do { _Pragma("unroll") for (int _h = 0; _h < 2; ++_h) _Pragma("unroll") for (int _i = 0; _i < 2; ++_i) { int R_, C_; stage_rc(tid * 16 + _i * 8192, R_, C_); \
        (rw)[_h][_i] = (unsigned)rowl[(uidx) * 256 + _h * 128 + R_] * (unsigned)(K * 2) + (unsigned)(C_ * 2); } } while (0)
#define PG8_RD16(off) (*(const PG8_LAS bf16x8*)(lds + (off)))
#define PG8_CAT2(x, y) __builtin_bit_cast(i32x8, __builtin_shufflevector((x), (y), 0, 1, 2, 3, 4, 5, 6, 7, 8, 9, 10, 11, 12, 13, 14, 15))
#define PG8_LDA(dst, b, h) do { if constexpr (FP8) { _Pragma("unroll") for (int m = 0; m < 4; ++m) dst##8[m] = PG8_CAT2(PG8_RD16(PG8_SA(b, h) + aoff + m * 2048), PG8_RD16(PG8_SA(b, h) + aoff + m * 2048 + 1024)); } \
        else { _Pragma("unroll") for (int m = 0; m < 4; ++m) _Pragma("unroll") for (int k = 0; k < 2; ++k) dst[m][k] = PG8_RD16(PG8_SA(b, h) + aoff + m * 2048 + k * 1024); } } while (0)
#define PG8_LDB(dst, b, h) do { if constexpr (FP8) { _Pragma("unroll") for (int n = 0; n < 2; ++n) dst##8[n] = PG8_CAT2(PG8_RD16(PG8_SB(b, h) + boff + n * 2048), PG8_RD16(PG8_SB(b, h) + boff + n * 2048 + 1024)); } \
        else { _Pragma("unroll") for (int n = 0; n < 2; ++n) _Pragma("unroll") for (int k = 0; k < 2; ++k) dst[n][k] = PG8_RD16(PG8_SB(b, h) + boff + n * 2048 + k * 1024); } } while (0)
#define PG8_MMA(ai, bj, At, Bt) do { __builtin_amdgcn_s_setprio(1); if constexpr (FP8) { _Pragma("unroll") for (int m = 0; m < 4; ++m) _Pragma("unroll") for (int n = 0; n < 2; ++n) \
        asm volatile("v_mfma_scale_f32_16x16x128_f8f6f4 %0, %1, %2, %0, %3, %3 op_sel_hi:[0,0,0]" : "+v"(acc[ai][bj][m][n]) : "v"(Bt##8[n]), "v"(At##8[m]), "v"(f8scale)); } else { \
        _Pragma("unroll") for (int m = 0; m < 4; ++m) _Pragma("unroll") for (int n = 0; n < 2; ++n) _Pragma("unroll") for (int k = 0; k < 2; ++k) \
        acc[ai][bj][m][n] = __builtin_amdgcn_mfma_f32_16x16x32_bf16(Bt[n][k], At[m][k], acc[ai][bj][m][n], 0, 0, 0); } __builtin_amdgcn_s_setprio(0); } while (0)
#define PG8_WAIT_V(n) asm volatile("s_waitcnt vmcnt(" #n ")" ::: "memory")
#define PG8_WAIT_L(n) asm volatile("s_waitcnt lgkmcnt(" #n ")" ::: "memory")
#define PG8_BAR __builtin_amdgcn_s_barrier()
#define PG8_SCHED __builtin_amdgcn_sched_barrier(0)
    Unit cur, nxt; int ui = 0;
    if (!S.next(0, cur)) return;
    f32x4 acc[2][2][4][2];
#pragma unroll
    for (int a = 0; a < 2; ++a)
#pragma unroll
        for (int b = 0; b < 2; ++b)
#pragma unroll
            for (int m = 0; m < 4; ++m)
#pragma unroll
                for (int n = 0; n < 2; ++n) acc[a][b][m][n] = (f32x4){0.f, 0.f, 0.f, 0.f};
    const int f8scale = 0x7f7f7f7f;
    bf16x8 At[4][2], B0[2][2], B1[2][2]; i32x8 At8[4], B08[2], B18[2];
    const char* cA = (const char*)g.A + (size_t)cur.pm * tstep; const char* cB = (const char*)g.Bt + (size_t)cur.pn * tstep;
    S.a_ready(cur);
    unsigned rowC[2][2], rowN[2][2];
    if constexpr (GATHER) { PG8_ROWS(rowC, 0); _Pragma("unroll") for (int h_ = 0; h_ < 2; ++h_) _Pragma("unroll") for (int i_ = 0; i_ < 2; ++i_) rowN[h_][i_] = rowC[h_][i_]; }
    if constexpr (SP2) {
        PG8_STAGE(PG8_SB(0, 0), cB, voffB); PG8_STAGE(PG8_SB(0, 1), cB + hstep, voffB);
        if constexpr (GATHER) { PG8_STAGE_AG(PG8_SA(0, 0), (size_t)0, rowC, 0); PG8_STAGE_AG(PG8_SA(0, 1), (size_t)0, rowC, 1); } else { PG8_STAGE(PG8_SA(0, 0), cA, voffA); PG8_STAGE(PG8_SA(0, 1), cA + hstep, voffA); }
        if (wr == 1) PG8_BAR;
        PG8_WAIT_V(2); PG8_BAR;
        PG8_STAGE(PG8_SB(1, 0), cB + kstep, voffB); if constexpr (GATHER) PG8_STAGE_AG(PG8_SA(1, 0), kstep, rowC, 0); else PG8_STAGE(PG8_SA(1, 0), cA + kstep, voffA); PG8_STAGE(PG8_SB(1, 1), cB + hstep + kstep, voffB);
        PG8_WAIT_V(6); PG8_BAR;
    } else {
        PG8_STAGE(PG8_SB(0, 0), cB, voffB); PG8_STAGE(PG8_SA(0, 0), cA, voffA); PG8_STAGE(PG8_SB(0, 1), cB + hstep, voffB); PG8_STAGE(PG8_SA(0, 1), cA + hstep, voffA);
        if (wr == 1) PG8_BAR;
        PG8_WAIT_V(4); PG8_BAR;
        PG8_STAGE(PG8_SB(1, 0), cB + kstep, voffB); PG8_STAGE(PG8_SA(1, 0), cA + kstep, voffA); PG8_STAGE(PG8_SB(1, 1), cB + hstep + kstep, voffB);
        PG8_WAIT_V(6); PG8_BAR;
    }
    for (;;) {
        const bool has_next = S.next(ui + 1, nxt);
        if constexpr (GATHER) { if (has_next) PG8_ROWS(rowN, ui + 1); }
        const char* nA = has_next ? (const char*)g.A + (size_t)nxt.pm * tstep : cA; const char* nB = has_next ? (const char*)g.Bt + (size_t)nxt.pn * tstep : cB;
#pragma unroll 1
        for (int t = 0; t < nt; t += 2) {
            const bool last = (t == nt - 2);
            const char* a1 = cA + (size_t)(t + 1) * kstep;
            const char* a2 = last ? nA : cA + (size_t)(t + 2) * kstep; const char* b2 = last ? nB : cB + (size_t)(t + 2) * kstep;
            const char* a3 = a2 + kstep; const char* b3 = b2 + kstep;
            if (last && has_next) S.a_ready(nxt);
            if constexpr (SP2) {
            unsigned rs[2][2]; size_t k2 = 0;
            if constexpr (GATHER) { k2 = last ? (size_t)0 : (size_t)(t + 2) * kstep; _Pragma("unroll") for (int h_ = 0; h_ < 2; ++h_) _Pragma("unroll") for (int i_ = 0; i_ < 2; ++i_) rs[h_][i_] = last ? rowN[h_][i_] : rowC[h_][i_]; }
            PG8_LDB(B0, 0, 0); PG8_LDB(B1, 0, 1); PG8_SCHED; PG8_LDA(At, 0, 0); if constexpr (GATHER) PG8_STAGE_AG(PG8_SA(1, 1), (size_t)(t + 1) * kstep, rowC, 1); else PG8_STAGE(PG8_SA(1, 1), a1 + hstep, voffA);
            PG8_WAIT_V(8); PG8_WAIT_L(0); PG8_BAR; PG8_MMA(0, 0, At, B0); PG8_MMA(0, 1, At, B1); PG8_BAR; PG8_SCHED;
            PG8_LDA(At, 0, 1); PG8_STAGE(PG8_SB(0, 0), b2, voffB); PG8_STAGE(PG8_SB(0, 1), b2 + hstep, voffB); if constexpr (GATHER) PG8_STAGE_AG(PG8_SA(0, 0), k2, rs, 0); else PG8_STAGE(PG8_SA(0, 0), a2, voffA);
            PG8_WAIT_V(8); PG8_WAIT_L(0); PG8_BAR; PG8_MMA(1, 0, At, B0); PG8_MMA(1, 1, At, B1); PG8_BAR; PG8_SCHED;
            PG8_LDB(B0, 1, 0); PG8_LDB(B1, 1, 1); PG8_SCHED; PG8_LDA(At, 1, 0); if constexpr (GATHER) PG8_STAGE_AG(PG8_SA(0, 1), k2, rs, 1); else PG8_STAGE(PG8_SA(0, 1), a2 + hstep, voffA);
            PG8_WAIT_V(8); PG8_WAIT_L(0); PG8_BAR; PG8_MMA(0, 0, At, B0); PG8_MMA(0, 1, At, B1); PG8_BAR; PG8_SCHED;
            PG8_LDA(At, 1, 1); PG8_STAGE(PG8_SB(1, 0), b3, voffB); PG8_STAGE(PG8_SB(1, 1), b3 + hstep, voffB); if constexpr (GATHER) PG8_STAGE_AG(PG8_SA(1, 0), k2 + kstep, rs, 0); else PG8_STAGE(PG8_SA(1, 0), a3, voffA);
            PG8_WAIT_V(8); PG8_WAIT_L(0); PG8_BAR; PG8_MMA(1, 0, At, B0); PG8_MMA(1, 1, At, B1); PG8_BAR; PG8_SCHED;
            } else {
            PG8_LDB(B0, 0, 0); PG8_SCHED; PG8_LDA(At, 0, 0); PG8_STAGE(PG8_SA(1, 1), a1 + hstep, voffA);
            PG8_WAIT_L(8); PG8_BAR; PG8_WAIT_L(0); PG8_MMA(0, 0, At, B0); PG8_BAR; PG8_SCHED;
            PG8_LDB(B1, 0, 1); PG8_STAGE(PG8_SB(0, 0), b2, voffB);
            PG8_BAR; PG8_WAIT_L(0); PG8_MMA(0, 1, At, B1); PG8_BAR;
            PG8_LDA(At, 0, 1); PG8_STAGE(PG8_SA(0, 0), a2, voffA);
            PG8_BAR; PG8_WAIT_L(0); PG8_MMA(1, 0, At, B0); PG8_BAR; PG8_SCHED;
            PG8_STAGE(PG8_SB(0, 1), b2 + hstep, voffB);
            PG8_WAIT_V(6); PG8_BAR; PG8_MMA(1, 1, At, B1); PG8_BAR;
            PG8_LDB(B0, 1, 0); PG8_SCHED; PG8_LDA(At, 1, 0); PG8_STAGE(PG8_SA(0, 1), a2 + hstep, voffA);
            PG8_WAIT_L(8); PG8_BAR; PG8_WAIT_L(0); PG8_MMA(0, 0, At, B0); PG8_BAR; PG8_SCHED;
            PG8_LDB(B1, 1, 1); PG8_STAGE(PG8_SB(1, 0), b3, voffB);
            PG8_BAR; PG8_WAIT_L(0); PG8_MMA(0, 1, At, B1); PG8_BAR;
            PG8_LDA(At, 1, 1); PG8_STAGE(PG8_SA(1, 0), a3, voffA);
            PG8_BAR; PG8_WAIT_L(0); PG8_MMA(1, 0, At, B0); PG8_BAR; PG8_SCHED;
            PG8_STAGE(PG8_SB(1, 1), b3 + hstep, voffB);
            PG8_WAIT_V(6); PG8_BAR; PG8_MMA(1, 1, At, B1); PG8_BAR;
            }
        }
        if constexpr (ALIGN_EPI) { if (wr == 0) PG8_BAR; }
        if constexpr (!Epi::AFTER_DRAIN) { E(acc, cur, wr, wc, fr, fq); S.done(cur); }
        if (!has_next) break;
#pragma unroll
        for (int a = 0; a < 2; ++a)
#pragma unroll
            for (int b = 0; b < 2; ++b)
#pragma unroll
                for (int m = 0; m < 4; ++m)
#pragma unroll
                    for (int n = 0; n < 2; ++n) acc[a][b][m][n] = (f32x4){0.f, 0.f, 0.f, 0.f};
        cur = nxt; cA = nA; cB = nB; ++ui;
        if constexpr (GATHER) { _Pragma("unroll") for (int h_ = 0; h_ < 2; ++h_) _Pragma("unroll") for (int i_ = 0; i_ < 2; ++i_) rowC[h_][i_] = rowN[h_][i_]; }
        if constexpr (ALIGN_EPI) { if (wr == 1) PG8_BAR; }
    }
    PG8_WAIT_V(0);
    if constexpr (!ALIGN_EPI) { if (wr == 0) PG8_BAR; }
    PG8_BAR;
    if constexpr (Epi::AFTER_DRAIN) { E.fused(acc, cur, wr, wc, fr, fq, lds, wid, lane); S.done(cur); }
#undef PG8_SA
#undef PG8_SB
#undef PG8_STAGE
#undef PG8_STAGE_AG
#undef PG8_ROWS
#undef PG8_CAT2
#undef PG8_RD16
#undef PG8_LDA
#undef PG8_LDB
#undef PG8_MMA
#undef PG8_WAIT_V
#undef PG8_WAIT_L
#undef PG8_BAR
#undef PG8_SCHED
}
}

constexpr int NWAVES = 8;
#ifndef MK_N_LAUNCHES
#define MK_N_LAUNCHES 1
#endif
constexpr int PER_PHASE = 10;
constexpr int N_LAUNCHES = MK_N_LAUNCHES;

constexpr int NB = 16, SEQ = 2048, T = NB * SEQ, D = 1024, NIN = 3328, NE = 32, TOPK = 4, DFF = 2048;
constexpr int MAXTILES = T * TOPK / 256 + NE;
constexpr int MAXSLOTS = MAXTILES * 256;
constexpr int NCHUNK = 256, CHUNK_TOK = T / NCHUNK;
constexpr float LN_EPS = 1e-5f, RMS_EPS = 1e-6f, DN_ALPHA = 1.18920711500272f, SWIGLU_LIMIT = 7.0f, SWIGLU_ALPHA = 1.702f;

constexpr size_t MiB = 1u << 20;
constexpr size_t WS_CTL = 0, CTL_ZERO_BYTES = 1 * MiB;
constexpr size_t WS_TAB = 1 * MiB;
constexpr size_t WS_WIN = 2 * MiB, WS_WOUT = 9 * MiB, WS_WUP = 11 * MiB, WS_WD = 139 * MiB;
constexpr size_t WS_H1 = 203 * MiB;
constexpr size_t WS_TOPI = 267 * MiB, WS_TOPG = 268 * MiB, WS_SLOT = 269 * MiB, WS_ROWTOK = 270 * MiB, WS_GATES = 271 * MiB;
constexpr size_t WS_H0 = 272 * MiB, WS_QA = 336 * MiB, WS_KA = 368 * MiB, WS_VA = 376 * MiB, WS_QH = 384 * MiB, WS_IH = 416 * MiB, WS_LF = 448 * MiB, WS_LB = 512 * MiB,
                 WS_ZG = 576 * MiB, WS_OF = 608 * MiB, WS_OB = 672 * MiB, WS_MIX = 736 * MiB, WS_U = 800 * MiB;
constexpr size_t WS_XG = 272 * MiB, WS_ACT = 544 * MiB, WS_Y = 272 * MiB, WS_H1F8 = 680 * MiB, WS_END = 928 * MiB;
constexpr float F8_SA = 16.0f, F8_SWU = 64.0f, F8_SACT = 4.0f, F8_SWD = 64.0f;
constexpr int CW_TMO = 0, CW_CODE = 1, CW_BAR = 4096;

constexpr int RING_OFF = 0, RING_BYTES = 131072;
constexpr int LDSCTL_OFF = RING_BYTES, MISC_OFF = LDSCTL_OFF + 320;
constexpr int TAB_OFF = 132096;
constexpr int HIST_OFF = 134400;
constexpr int LDS_BYTES = 147456;
constexpr int ROWL_OFF = 134656, MAXUNITS_WG = 17;
static_assert(TAB_OFF + MAXTILES * 4 <= HIST_OFF && HIST_OFF + 128 <= ROWL_OFF && ROWL_OFF + MAXUNITS_WG * 512 <= LDS_BYTES, "LDS map");
#define GAS __attribute__((address_space(1)))
#define LAS __attribute__((address_space(3)))
typedef unsigned short bf16;
typedef unsigned v4u __attribute__((ext_vector_type(4)));
typedef float f32x4 __attribute__((ext_vector_type(4)));
typedef short bf16x8 __attribute__((ext_vector_type(8)));
typedef GAS unsigned gu32;
typedef GAS unsigned long long gu64;
#define RLX_AGENT __ATOMIC_RELAXED, __HIP_MEMORY_SCOPE_AGENT
#define LDS_WAIT() asm volatile("s_waitcnt lgkmcnt(0)" ::: "memory")
#define VM_WAIT() asm volatile("s_waitcnt vmcnt(0)" ::: "memory")
__device__ __forceinline__ unsigned long long rt() { return __builtin_amdgcn_s_memrealtime(); }
__device__ __forceinline__ unsigned f2bf(float f) { unsigned u = __builtin_bit_cast(unsigned, f); return (u + 0x7fffu + ((u >> 16) & 1u)) >> 16; }
__device__ __forceinline__ unsigned pk2(float lo, float hi) { return f2bf(lo) | (f2bf(hi) << 16); }
#define XB_TMO      128
#define XB_XCNT(j)  (256  + 64 * (j))
#define XB_XSUB(j)  (1280 + 64 * (j))
#define XB_XGEN(j)  (2304 + 64 * (j))
#define XB_TOP      3328
#define XB_TOPGEN   3392
#define XCD_BAR_WORDS 3456
#define XB_SPIN_CAP (1u << 18)

__device__ __forceinline__ unsigned xb_ld(unsigned* p)              { return __hip_atomic_load(p, __ATOMIC_RELAXED, __HIP_MEMORY_SCOPE_AGENT); }
__device__ __forceinline__ unsigned xb_add(unsigned* p, unsigned v) { return __hip_atomic_fetch_add(p, v, __ATOMIC_RELAXED, __HIP_MEMORY_SCOPE_AGENT); }
__device__ __forceinline__ unsigned xb_xcc_id() { return (unsigned)__builtin_amdgcn_s_getreg((3 << 11) | 20) & 0xFu; }
#define XB_SPIN(cond, bar) do { unsigned _sp = 0; while (cond) { __builtin_amdgcn_s_sleep(1); \
    if ((++_sp & 255u) == 0u) { if (xb_ld(&(bar)[XB_TMO])) break; if (_sp > XB_SPIN_CAP) { atomicAdd(&(bar)[XB_TMO], 1u); break; } } } } while (0)

struct XcdBarrier {
    unsigned* bar; unsigned x;
    volatile LAS unsigned* st;
};

__device__ __forceinline__ XcdBarrier xcd_barrier_post(unsigned* bar, volatile LAS unsigned* st) {
    XcdBarrier b; b.bar = bar; b.x = xb_xcc_id(); b.st = st;
    if (threadIdx.x == 0) (void)xb_add(&bar[XB_XCNT(b.x)], 1u);
    return b;
}
__device__ __forceinline__ void xcd_barrier_complete(unsigned* bar, unsigned x, unsigned& nloc, unsigned& nx) {
    const unsigned G = gridDim.x * gridDim.y * gridDim.z;
    unsigned sum, cnt, mine, sp = 0u;
    for (;;) {
        sum = 0u; cnt = 0u; mine = 0u;
#pragma unroll
        for (unsigned j = 0; j < 16; ++j) { const unsigned c = xb_ld(&bar[XB_XCNT(j)]); sum += c; cnt += (c > 0u) ? 1u : 0u; mine = (j == x) ? c : mine; }
        if (sum == G) break;
        __builtin_amdgcn_s_sleep(1);
        if ((++sp & 255u) == 0u) { if (xb_ld(&bar[XB_TMO])) break; if (sp > XB_SPIN_CAP) { atomicAdd(&bar[XB_TMO], 1u); break; } }
    }
    nloc = mine > 0u ? mine : 1u; nx = cnt > 0u ? cnt : 1u;
}

__device__ __forceinline__ void xcd_barrier(const XcdBarrier& b) {
    asm volatile("s_waitcnt vmcnt(0)" ::: "memory");
    __syncthreads();
    if (threadIdx.x == 0) {
        unsigned* bar = b.bar;
        __builtin_amdgcn_s_waitcnt(0);
        unsigned nloc = b.st[0], nx = b.st[1];
        if (nloc == 0u) { xcd_barrier_complete(bar, b.x, nloc, nx); b.st[0] = nloc; b.st[1] = nx; }
        const unsigned old = xb_add(&bar[XB_XSUB(b.x)], 1u);
        const unsigned gen = old / nloc;
        if (old + 1u == (gen + 1u) * nloc) {
            __builtin_amdgcn_fence(__ATOMIC_RELEASE, "agent");
            asm volatile("s_waitcnt vmcnt(0)" ::: "memory");
            const unsigned og = xb_add(&bar[XB_TOP], 1u);
            const unsigned tg = og / nx;
            if (og + 1u == (tg + 1u) * nx) xb_add(&bar[XB_TOPGEN], 1u);
            else XB_SPIN(xb_ld(&bar[XB_TOPGEN]) == tg, bar);
            __builtin_amdgcn_fence(__ATOMIC_ACQUIRE, "agent");
            xb_add(&bar[XB_XGEN(b.x)], 1u);
            asm volatile("s_waitcnt vmcnt(0)" ::: "memory");
        } else {
            XB_SPIN(xb_ld(&bar[XB_XGEN(b.x)]) == gen, bar);
            __builtin_amdgcn_fence(__ATOMIC_ACQUIRE, "agent");
            asm volatile("s_waitcnt vmcnt(0)" ::: "memory");
        }
    }
    __syncthreads();
}

typedef unsigned u32x2 __attribute__((ext_vector_type(2)));
__device__ __forceinline__ float bflo(unsigned w) { return __uint_as_float(w << 16); }
__device__ __forceinline__ float bfhi(unsigned w) { return __uint_as_float(w & 0xffff0000u); }
__device__ __forceinline__ float fsigmoid(float z) { return __builtin_amdgcn_rcpf(1.0f + __expf(-z)); }
__device__ __forceinline__ v4u pack8(const f32x4 a, const f32x4 b) { v4u w; w.x = pg8::cvt_pk_bf16(a[0], a[1]); w.y = pg8::cvt_pk_bf16(a[2], a[3]); w.z = pg8::cvt_pk_bf16(b[0], b[1]); w.w = pg8::cvt_pk_bf16(b[2], b[3]); return w; }
__device__ __forceinline__ float clamp448(float x) { return __builtin_amdgcn_fmed3f(x, -448.0f, 448.0f); }
__device__ __forceinline__ unsigned pk4_fp8(float a, float b, float c, float d) { int w = __builtin_amdgcn_cvt_pk_fp8_f32(clamp448(a), clamp448(b), 0, false); w = __builtin_amdgcn_cvt_pk_fp8_f32(clamp448(c), clamp448(d), w, true); return (unsigned)w; }
__device__ __forceinline__ float wave_sum(float v) {
#pragma unroll
    for (int o = 1; o < 64; o <<= 1) v += __shfl_xor(v, o);
    return v;
}

struct EpiInProj {
    static constexpr bool PERM = true, AFTER_DRAIN = false;
    bf16 *QA, *KA, *VA, *QH, *IH, *ZG; float *LF, *LB; const float *lbl, *normg;
    __device__ __forceinline__ void operator()(const f32x4 (&acc)[2][2][4][2], const pg8::Unit& u, int wr, int wc, int fr, int fq) const {
        const int row0 = u.pm * 256 + wr * 64 + fr, cl = wc * 32 + 8 * fq, pn = u.pn;
        if (pn == 2) {
#pragma unroll
            for (int ai = 0; ai < 2; ++ai)
#pragma unroll
                for (int m = 0; m < 4; ++m) { const size_t r = (size_t)(row0 + ai * 128 + m * 16);
                    *(v4u*)(KA + r * 128 + cl) = pack8(acc[ai][0][m][0], acc[ai][0][m][1]);
                    *(v4u*)(VA + r * 128 + cl) = pack8(acc[ai][1][m][0], acc[ai][1][m][1]); }
        } else if (pn < 7) {
            bf16* base = pn < 2 ? QA + pn * 256 : (pn < 5 ? QH + (pn - 3) * 256 : IH + (pn - 5) * 256);
#pragma unroll
            for (int ai = 0; ai < 2; ++ai)
#pragma unroll
                for (int m = 0; m < 4; ++m) { bf16* rowp = base + (size_t)(row0 + ai * 128 + m * 16) * 512 + cl;
#pragma unroll
                    for (int bj = 0; bj < 2; ++bj) *(v4u*)(rowp + bj * 128) = pack8(acc[ai][bj][m][0], acc[ai][bj][m][1]); }
        } else if (pn < 11) {
            const int dir = pn >= 9 ? 1 : 0, cb = (pn - (dir ? 9 : 7)) * 256; float* base = (dir ? LB : LF) + cb;
#pragma unroll
            for (int bj = 0; bj < 2; ++bj) {
                float lb[8];
#pragma unroll
                for (int j = 0; j < 8; ++j) { const int col = cb + bj * 128 + cl + j; const float a0 = lbl[dir * 1024 + col], a1 = lbl[dir * 1024 + 512 + col]; lb[j] = 1.0f / (1.0f + __expf(a1 - a0)); }
#pragma unroll
                for (int ai = 0; ai < 2; ++ai)
#pragma unroll
                    for (int m = 0; m < 4; ++m) { float* rowp = base + (size_t)(row0 + ai * 128 + m * 16) * 512 + bj * 128 + cl;
                        f32x4 o0, o1, z0 = acc[ai][bj][m][0], z1 = acc[ai][bj][m][1];
                        asm volatile("" : "+v"(z0), "+v"(z1) :: "memory");
#pragma unroll
                        for (int j = 0; j < 4; ++j) { o0[j] = __logf(lb[j] + (1.0f - lb[j]) * fsigmoid(z0[j])); o1[j] = __logf(lb[4 + j] + (1.0f - lb[4 + j]) * fsigmoid(z1[j])); }
                        *(f32x4*)rowp = o0; *(f32x4*)(rowp + 4) = o1; }
            }
        } else {
            const int cb = (pn - 11) * 256;
#pragma unroll
            for (int bj = 0; bj < 2; ++bj) {
                const f32x4 g0 = *(const f32x4*)(normg + cb + bj * 128 + cl), g1 = *(const f32x4*)(normg + cb + bj * 128 + cl + 4);
#pragma unroll
                for (int ai = 0; ai < 2; ++ai)
#pragma unroll
                    for (int m = 0; m < 4; ++m) { bf16* rowp = ZG + (size_t)(row0 + ai * 128 + m * 16) * 512 + cb + bj * 128 + cl;
                        f32x4 o0, o1, y0 = acc[ai][bj][m][0], y1 = acc[ai][bj][m][1];
                        asm volatile("" : "+v"(y0), "+v"(y1) :: "memory");
#pragma unroll
                        for (int j = 0; j < 4; ++j) { const float z0 = y0[j], z1 = y1[j]; o0[j] = g0[j] * z0 * fsigmoid(z0); o1[j] = g1[j] * z1 * fsigmoid(z1); }
                        *(v4u*)rowp = pack8(o0, o1); }
            }
        }
    }
};
struct EpiOutProj {
    static constexpr bool PERM = false, AFTER_DRAIN = false;
    const bf16* H0; float* U;
    __device__ __forceinline__ void operator()(const f32x4 (&acc)[2][2][4][2], const pg8::Unit& u, int wr, int wc, int fr, int fq) const {
        const int row0 = u.pm * 256 + wr * 64 + fr, col0 = u.pn * 256 + wc * 32 + 4 * fq;
#pragma unroll
        for (int ai = 0; ai < 2; ++ai)
#pragma unroll
            for (int m = 0; m < 4; ++m) { const size_t off = (size_t)(row0 + ai * 128 + m * 16) * D + col0;
#pragma unroll
                for (int bj = 0; bj < 2; ++bj)
#pragma unroll
                    for (int n = 0; n < 2; ++n) { const u32x2 hb = *(const u32x2*)(H0 + off + bj * 128 + n * 16);
                        f32x4 h; h[0] = bflo(hb.x); h[1] = bfhi(hb.x); h[2] = bflo(hb.y); h[3] = bfhi(hb.y);
                        *(f32x4*)(U + off + bj * 128 + n * 16) = acc[ai][bj][m][n] + DN_ALPHA * h; } }
    }
};
struct EpiUp {
    static constexpr bool PERM = false, AFTER_DRAIN = false;
    unsigned char* ACT; const float* b_up;
    __device__ __forceinline__ void operator()(const f32x4 (&acc)[2][2][4][2], const pg8::Unit& u, int wr, int wc, int fr, int fq) const {
        const int e = u.pn >> 3, p = u.pn & 7, row0 = u.pm * 256 + wr * 64 + fr, a0 = 128 * p + 32 * wc + 8 * fq;
        f32x4 bg[2], bl[2];
#pragma unroll
        for (int bj = 0; bj < 2; ++bj) { const f32x4 x = *(const f32x4*)(b_up + e * DFF + 2 * (a0 + 4 * bj)), y = *(const f32x4*)(b_up + e * DFF + 2 * (a0 + 4 * bj) + 4);
            bg[bj] = (f32x4){x[0], x[2], y[0], y[2]}; bl[bj] = (f32x4){x[1], x[3], y[1], y[3]}; }
#pragma unroll
        for (int ai = 0; ai < 2; ++ai)
#pragma unroll
            for (int m = 0; m < 4; ++m) { f32x4 o[2], zg[2] = {acc[ai][0][m][0], acc[ai][1][m][0]}, zl[2] = {acc[ai][0][m][1], acc[ai][1][m][1]};
                asm volatile("" : "+v"(zg[0]), "+v"(zg[1]), "+v"(zl[0]), "+v"(zl[1]) :: "memory");
#pragma unroll
                for (int bj = 0; bj < 2; ++bj)
#pragma unroll
                    for (int j = 0; j < 4; ++j) { const float g = fminf(zg[bj][j] * (1.0f / (F8_SA * F8_SWU)) + bg[bj][j], SWIGLU_LIMIT); float l = zl[bj][j] * (1.0f / (F8_SA * F8_SWU)) + bl[bj][j]; l = fminf(fmaxf(l, -SWIGLU_LIMIT), SWIGLU_LIMIT);
                        o[bj][j] = g * fsigmoid(SWIGLU_ALPHA * g) * (l + 1.0f) * F8_SACT; }
                u32x2 pw; pw.x = pk4_fp8(o[0][0], o[0][1], o[0][2], o[0][3]); pw.y = pk4_fp8(o[1][0], o[1][1], o[1][2], o[1][3]);
                *(u32x2*)(ACT + (size_t)(row0 + ai * 128 + m * 16) * D + a0) = pw; }
    }
};
struct EpiDown {
    static constexpr bool PERM = true, AFTER_DRAIN = false;
    bf16* Y; const int* rowTok; const float* gates; const float* b_down;
    __device__ __forceinline__ void operator()(const f32x4 (&acc)[2][2][4][2], const pg8::Unit& u, int wr, int wc, int fr, int fq) const {
        const int e = u.pn >> 2, colt = (u.pn & 3) * 256 + wc * 32 + 8 * fq, slot0 = u.pm * 256 + wr * 64 + fr;
        f32x4 bv[2][2];
#pragma unroll
        for (int bj = 0; bj < 2; ++bj)
#pragma unroll
            for (int n = 0; n < 2; ++n) bv[bj][n] = *(const f32x4*)(b_down + e * D + colt + bj * 128 + 4 * n);
#pragma unroll
        for (int ai = 0; ai < 2; ++ai)
#pragma unroll
            for (int m = 0; m < 4; ++m) { const int slot = slot0 + ai * 128 + m * 16; const int dest = rowTok[slot]; const float g = gates[slot];
                if (dest >= 0) { bf16* rowp = Y + (size_t)dest * D + colt;
#pragma unroll
                    for (int bj = 0; bj < 2; ++bj) *(v4u*)(rowp + bj * 128) = pack8((acc[ai][bj][m][0] * (1.0f / (F8_SACT * F8_SWD)) + bv[bj][0]) * g, (acc[ai][bj][m][1] * (1.0f / (F8_SACT * F8_SWD)) + bv[bj][1]) * g); } }
    }
};
struct MoeOrder {
    const LAS int* tileExpert; int nunits, nN, G, c;
    __device__ __forceinline__ bool next(int i, pg8::Unit& u) const {
        const int L = i * G + c; if (L >= nunits) return false;
        const int tile = L / nN, n = L - tile * nN; u.pm = tile; u.pn = tileExpert[tile] * nN + n; return true;
    }
    __device__ __forceinline__ void a_ready(const pg8::Unit&) const {}
    __device__ __forceinline__ void done(const pg8::Unit&) const {}
};

struct Frame {
    LAS unsigned char* lds;
    volatile LAS unsigned* MISC;
    gu32* ctl;
    int tid, lane, wave;
    int vcu, G;
    const float* in[18]; float* out; unsigned char* ws;
};

__device__ __forceinline__ int up_srccol(int dn) { const int p = dn >> 8, rho = dn & 255, bj = rho >> 7, wc = (rho >> 5) & 3, n = (rho >> 4) & 1, fq = (rho >> 2) & 3, j = rho & 3;
    return 2 * (128 * p + 32 * wc + 8 * fq + 4 * bj + j) + n; }
template <bool UPPERM>
__device__ __forceinline__ void p0_transpose_item(const float* W, int K, int N, bf16* WT, LAS float* scr, int item, int lane) {
    const int nblk = N / 32, kb = item / nblk, nb = item % nblk, k0 = 64 * kb, n0 = 32 * nb;
    const int sc = UPPERM ? up_srccol(n0 + (lane & 31)) : n0 + (lane & 31);
#pragma unroll 8
    for (int i = 0; i < 32; ++i) { const int kk = 2 * i + (lane >> 5); scr[kk * 33 + (lane & 31)] = W[(size_t)(k0 + kk) * N + sc]; }
    LDS_WAIT(); asm volatile("" ::: "memory");
    const int c = lane & 7;
#pragma unroll
    for (int j = 0; j < 4; ++j) { const int n = (lane >> 3) + 8 * j; const LAS float* s = scr + (8 * c) * 33 + n;
        v4u o; o.x = pk2(s[0 * 33], s[1 * 33]); o.y = pk2(s[2 * 33], s[3 * 33]); o.z = pk2(s[4 * 33], s[5 * 33]); o.w = pk2(s[6 * 33], s[7 * 33]);
        *(GAS v4u*)(WT + (size_t)(n0 + n) * K + k0 + 8 * c) = o; }
    LDS_WAIT(); asm volatile("" ::: "memory");
}
template <bool UPPERM>
__device__ __forceinline__ void p0_transpose_item_f8(const float* W, int K, int N, unsigned char* WT, LAS float* scr, int item, int lane, float scale) {
    const int nblk = N / 32, kb = item / nblk, nb = item % nblk, k0 = 64 * kb, n0 = 32 * nb;
    const int sc = UPPERM ? up_srccol(n0 + (lane & 31)) : n0 + (lane & 31);
#pragma unroll 8
    for (int i = 0; i < 32; ++i) { const int kk = 2 * i + (lane >> 5); scr[kk * 33 + (lane & 31)] = W[(size_t)(k0 + kk) * N + sc]; }
    LDS_WAIT(); asm volatile("" ::: "memory");
    const int n = lane >> 1, hf = lane & 1; const LAS float* s = scr + (32 * hf) * 33 + n;
    unsigned o[8];
#pragma unroll
    for (int q = 0; q < 8; ++q) o[q] = pk4_fp8(s[(4 * q) * 33] * scale, s[(4 * q + 1) * 33] * scale, s[(4 * q + 2) * 33] * scale, s[(4 * q + 3) * 33] * scale);
    GAS v4u* dst = (GAS v4u*)(WT + (size_t)(n0 + n) * K + k0 + 32 * hf);
    dst[0] = (v4u){o[0], o[1], o[2], o[3]}; dst[1] = (v4u){o[4], o[5], o[6], o[7]};
    LDS_WAIT(); asm volatile("" ::: "memory");
}
__device__ __forceinline__ void p0_prologue(Frame& F) {
    LAS float* scr = (LAS float*)(F.lds + RING_OFF + F.wave * 16384);
    const int gw = F.vcu * NWAVES + F.wave, NGW = F.G * NWAVES;
    constexpr int I_IN = (D / 64) * (NIN / 32), I_OUT = (D / 64) * (D / 32), I_UP1 = (D / 64) * (DFF / 32), I_DN1 = (D / 64) * (D / 32);
    constexpr int NITEMS = I_IN + I_OUT + NE * I_UP1 + NE * I_DN1;
    bf16* WinT = (bf16*)(F.ws + WS_WIN); bf16* WoutT = (bf16*)(F.ws + WS_WOUT); unsigned char* WupT = (unsigned char*)(F.ws + WS_WUP); unsigned char* WdT = (unsigned char*)(F.ws + WS_WD);
    for (int it = gw; it < NITEMS; it += NGW) {
        int r = it;
        if (r < I_IN) { p0_transpose_item<false>(F.in[3], D, NIN, WinT, scr, r, F.lane); continue; } r -= I_IN;
        if (r < I_OUT) { p0_transpose_item<false>(F.in[7], D, D, WoutT, scr, r, F.lane); continue; } r -= I_OUT;
        if (r < NE * I_UP1) { const int e = r / I_UP1; p0_transpose_item_f8<true>(F.in[12] + (size_t)e * D * DFF, D, DFF, WupT + (size_t)e * DFF * D, scr, r % I_UP1, F.lane, F8_SWU); continue; } r -= NE * I_UP1;
        { const int e = r / I_DN1; p0_transpose_item_f8<false>(F.in[14] + (size_t)e * D * D, D, D, WdT + (size_t)e * D * D, scr, r % I_DN1, F.lane, F8_SWD); }
    }
    const float* x = F.in[0]; bf16* H0 = (bf16*)(F.ws + WS_H0);
    f32x4 gg[4], bb[4];
#pragma unroll
    for (int j = 0; j < 4; ++j) { gg[j] = ((const f32x4*)F.in[1])[F.lane + 64 * j]; bb[j] = ((const f32x4*)F.in[2])[F.lane + 64 * j]; }
    for (int m = gw; m < T; m += NGW) {
        const GAS f32x4* xr = (const GAS f32x4*)(x + (size_t)m * D) + F.lane;
        f32x4 v[4]; float s = 0.f;
#pragma unroll
        for (int j = 0; j < 4; ++j) { v[j] = xr[64 * j]; s += (v[j].x + v[j].y) + (v[j].z + v[j].w); }
        const float mean = wave_sum(s) * (1.f / D); float s2 = 0.f;
#pragma unroll
        for (int j = 0; j < 4; ++j) { v[j] = v[j] - mean; s2 += (v[j].x * v[j].x + v[j].y * v[j].y) + (v[j].z * v[j].z + v[j].w * v[j].w); }
        const float rstd = 1.f / sqrtf(wave_sum(s2) * (1.f / D) + LN_EPS);
        GAS u32x2* o8 = (GAS u32x2*)(H0 + (size_t)m * D) + F.lane;
#pragma unroll
        for (int j = 0; j < 4; ++j) { const f32x4 y = v[j] * rstd * gg[j] + bb[j]; u32x2 w; w.x = pg8::cvt_pk_bf16(y[0], y[1]); w.y = pg8::cvt_pk_bf16(y[2], y[3]); o8[64 * j] = w; }
    }
}

__device__ __forceinline__ void p2_attn_simple(Frame& F) {
    const bf16* QA = (const bf16*)(F.ws + WS_QA); const bf16* KA = (const bf16*)(F.ws + WS_KA); const bf16* VA = (const bf16*)(F.ws + WS_VA); bf16* MIX = (bf16*)(F.ws + WS_MIX);
    const float* sink = F.in[4];
    const int gw = F.vcu * NWAVES + F.wave, NGW = F.G * NWAVES;
    for (int task = gw; task < NB * 8 * (SEQ / 64); task += NGW) {
        const int qb = task & 31, hq = (task >> 5) & 7, b = task >> 8, g = hq >> 2;
        const int t = qb * 64 + F.lane; const size_t row = (size_t)b * SEQ + t;
        float q[64], o[64];
        { const v4u* qp = (const v4u*)(QA + row * 512 + hq * 64);
#pragma unroll
          for (int i = 0; i < 8; ++i) { const v4u w = qp[i]; q[8 * i] = bflo(w.x); q[8 * i + 1] = bfhi(w.x); q[8 * i + 2] = bflo(w.y); q[8 * i + 3] = bfhi(w.y); q[8 * i + 4] = bflo(w.z); q[8 * i + 5] = bfhi(w.z); q[8 * i + 6] = bflo(w.w); q[8 * i + 7] = bfhi(w.w); } }
#pragma unroll
        for (int i = 0; i < 64; ++i) o[i] = 0.f;
        float m = sink[hq], l = 1.0f; const float slope = exp2f(-(float)(hq + 1));
        const int lo = (qb * 64 - 128) < 0 ? 0 : qb * 64 - 128, hi = (qb * 64 + 63 + 128) > SEQ - 1 ? SEQ - 1 : qb * 64 + 63 + 128;
        for (int s = lo; s <= hi; ++s) {
            const v4u* kp = (const v4u*)(KA + ((size_t)b * SEQ + s) * 128 + g * 64); const v4u* vp = (const v4u*)(VA + ((size_t)b * SEQ + s) * 128 + g * 64);
            float dot = 0.f;
#pragma unroll
            for (int i = 0; i < 8; ++i) { const v4u w = kp[i]; dot += q[8 * i] * bflo(w.x) + q[8 * i + 1] * bfhi(w.x) + q[8 * i + 2] * bflo(w.y) + q[8 * i + 3] * bfhi(w.y) + q[8 * i + 4] * bflo(w.z) + q[8 * i + 5] * bfhi(w.z) + q[8 * i + 6] * bflo(w.w) + q[8 * i + 7] * bfhi(w.w); }
            const int dist = t > s ? t - s : s - t; const bool valid = dist <= 128;
            const float sc = dot * 0.125f - slope * (float)dist;
            const float mn = valid ? fmaxf(m, sc) : m; const float a = __expf(m - mn), p = valid ? __expf(sc - mn) : 0.f;
            l = l * a + p; m = mn;
#pragma unroll
            for (int i = 0; i < 8; ++i) { const v4u w = vp[i];
                o[8 * i] = o[8 * i] * a + p * bflo(w.x); o[8 * i + 1] = o[8 * i + 1] * a + p * bfhi(w.x); o[8 * i + 2] = o[8 * i + 2] * a + p * bflo(w.y); o[8 * i + 3] = o[8 * i + 3] * a + p * bfhi(w.y);
                o[8 * i + 4] = o[8 * i + 4] * a + p * bflo(w.z); o[8 * i + 5] = o[8 * i + 5] * a + p * bfhi(w.z); o[8 * i + 6] = o[8 * i + 6] * a + p * bflo(w.w); o[8 * i + 7] = o[8 * i + 7] * a + p * bfhi(w.w); }
        }
        const float inv = 1.0f / l; v4u* op = (v4u*)(MIX + row * D + hq * 64);
#pragma unroll
        for (int i = 0; i < 8; ++i) { v4u w; w.x = pg8::cvt_pk_bf16(o[8 * i] * inv, o[8 * i + 1] * inv); w.y = pg8::cvt_pk_bf16(o[8 * i + 2] * inv, o[8 * i + 3] * inv); w.z = pg8::cvt_pk_bf16(o[8 * i + 4] * inv, o[8 * i + 5] * inv); w.w = pg8::cvt_pk_bf16(o[8 * i + 6] * inv, o[8 * i + 7] * inv); op[i] = w; }
    }
}

typedef float f32x16 __attribute__((ext_vector_type(16)));
typedef short s16x4 __attribute__((ext_vector_type(4)));
typedef float f32x2_t __attribute__((ext_vector_type(2)));
typedef __bf16 bf16x2_t __attribute__((ext_vector_type(2)));
__device__ __forceinline__ unsigned cvtpk_s(float lo, float hi) { f32x2_t v = {lo, hi}; bf16x2_t b = __builtin_convertvector(v, bf16x2_t); return __builtin_bit_cast(unsigned, b); }
#define MFMA32(a, b, c) __builtin_amdgcn_mfma_f32_32x32x16_bf16((a), (b), (c), 0, 0, 0)
constexpr int AK_PITCH = 144, AV_PITCH = 776, AV_OFF = 384 * AK_PITCH;
static_assert(AV_OFF + 64 * AV_PITCH <= RING_BYTES, "attention LDS");
__device__ __forceinline__ void p2_attn(Frame& F) {
    const bf16* QA = (const bf16*)(F.ws + WS_QA); const bf16* KA = (const bf16*)(F.ws + WS_KA); const bf16* VA = (const bf16*)(F.ws + WS_VA); bf16* MIX = (bf16*)(F.ws + WS_MIX);
    const float* sink = F.in[4];
    LAS unsigned char* Ks = F.lds + RING_OFF; LAS unsigned char* Vt = Ks + AV_OFF;
    const int r = F.lane & 31, h = F.lane >> 5;
    constexpr float LOG2E = 1.4426950408889634f, C1 = 0.125f * LOG2E;
    for (int unit = F.vcu; unit < NB * 2 * 16; unit += F.G) {
        const int n = unit & 15, g = (unit >> 4) & 1, b = unit >> 5, kbase = n * 128 - 128;
        __syncthreads();
#pragma unroll
        for (int i = 0; i < 6; ++i) { const int c = F.tid + 512 * i, row = c >> 3, ch = c & 7, pos = kbase + row;
            if (pos >= 0 && pos < SEQ) *(LAS v4u*)(Ks + row * AK_PITCH + ch * 16) = *(const v4u*)(KA + ((size_t)b * SEQ + pos) * 128 + g * 64 + ch * 8); }
#pragma unroll
        for (int i = 0; i < 3; ++i) { const int it = F.tid + 512 * i, kp = it % 192, ch = it / 192, pos = kbase + 2 * kp;
            if (pos >= 0 && pos < SEQ) { const bf16* vp = VA + ((size_t)b * SEQ + pos) * 128 + g * 64 + ch * 8; const v4u w0 = *(const v4u*)vp, w1 = *(const v4u*)(vp + 128);
                LAS unsigned char* dst = Vt + (ch * 8) * AV_PITCH + kp * 4;
                *(LAS unsigned*)(dst + 0 * AV_PITCH) = (w0.x & 0xffffu) | (w1.x << 16); *(LAS unsigned*)(dst + 1 * AV_PITCH) = (w0.x >> 16) | (w1.x & 0xffff0000u);
                *(LAS unsigned*)(dst + 2 * AV_PITCH) = (w0.y & 0xffffu) | (w1.y << 16); *(LAS unsigned*)(dst + 3 * AV_PITCH) = (w0.y >> 16) | (w1.y & 0xffff0000u);
                *(LAS unsigned*)(dst + 4 * AV_PITCH) = (w0.z & 0xffffu) | (w1.z << 16); *(LAS unsigned*)(dst + 5 * AV_PITCH) = (w0.z >> 16) | (w1.z & 0xffff0000u);
                *(LAS unsigned*)(dst + 6 * AV_PITCH) = (w0.w & 0xffffu) | (w1.w << 16); *(LAS unsigned*)(dst + 7 * AV_PITCH) = (w0.w >> 16) | (w1.w & 0xffff0000u); } }
        __syncthreads();
        const int head = g * 4 + (F.wave >> 1);
        const float slope2 = __builtin_amdgcn_exp2f(-(float)(head + 1)) * LOG2E, sink2 = sink[head] * LOG2E;
        for (int qb = 0; qb < 2; ++qb) {
            const int q0 = n * 128 + (F.wave & 1) * 64 + qb * 32;
            pg8::bf16x8 qf[4]; { const bf16* qp = QA + ((size_t)b * SEQ + q0 + r) * 512 + head * 64 + 8 * h;
#pragma unroll
                for (int ds = 0; ds < 4; ++ds) qf[ds] = *(const pg8::bf16x8*)(qp + 16 * ds); }
            f32x16 o0, o1;
#pragma unroll
            for (int i = 0; i < 16; ++i) { o0[i] = 0.f; o1[i] = 0.f; }
            float m = sink2, l = (h == 0) ? 1.0f : 0.0f;
            const int kt_lo = (q0 - 128) < 0 ? 0 : q0 - 128, kt_hi = (q0 + 128) > SEQ - 32 ? SEQ - 32 : q0 + 128;
            for (int k0 = kt_lo; k0 <= kt_hi; k0 += 32) {
                const int kl = k0 - kbase;
                f32x16 s;
#pragma unroll
                for (int i = 0; i < 16; ++i) s[i] = 0.f;
#pragma unroll
                for (int ds = 0; ds < 4; ++ds) { const pg8::bf16x8 kf = *(const LAS pg8::bf16x8*)(Ks + (kl + r) * AK_PITCH + ds * 32 + h * 16); s = MFMA32(kf, qf[ds], s); }
                const float base = (float)(q0 + r - k0 - 4 * h);
                const bool partial = (k0 < q0 + 31 - 128) || (k0 + 31 > q0 + 128);
                float mt = -INFINITY;
#pragma unroll
                for (int i = 0; i < 16; ++i) { const float dist = fabsf(base - (float)((i & 3) + 8 * (i >> 2))); float sv = s[i] * C1 - slope2 * dist; if (partial) sv = dist <= 128.0f ? sv : -INFINITY; s[i] = sv; mt = fmaxf(mt, sv); }
                mt = fmaxf(mt, __shfl_xor(mt, 32));
                const float mn = fmaxf(m, mt), alpha = __builtin_amdgcn_exp2f(m - mn); m = mn;
                float ps = 0.f;
#pragma unroll
                for (int i = 0; i < 16; ++i) { s[i] = __builtin_amdgcn_exp2f(s[i] - mn); ps += s[i]; }
                l = l * alpha + ps;
#pragma unroll
                for (int i = 0; i < 16; ++i) { o0[i] *= alpha; o1[i] *= alpha; }
#pragma unroll
                for (int sp = 0; sp < 2; ++sp) {
                    v4u pw; pw.x = cvtpk_s(s[8 * sp], s[8 * sp + 1]); pw.y = cvtpk_s(s[8 * sp + 2], s[8 * sp + 3]); pw.z = cvtpk_s(s[8 * sp + 4], s[8 * sp + 5]); pw.w = cvtpk_s(s[8 * sp + 6], s[8 * sp + 7]);
                    const pg8::bf16x8 pf = __builtin_bit_cast(pg8::bf16x8, pw);
                    const LAS unsigned char* vp = Vt + r * AV_PITCH + (kl + 16 * sp + 4 * h) * 2;
                    { const s16x4 lo = *(const LAS s16x4*)vp, hi = *(const LAS s16x4*)(vp + 16); o0 = MFMA32(__builtin_shufflevector(lo, hi, 0, 1, 2, 3, 4, 5, 6, 7), pf, o0); }
                    { const s16x4 lo = *(const LAS s16x4*)(vp + 32 * AV_PITCH), hi = *(const LAS s16x4*)(vp + 32 * AV_PITCH + 16); o1 = MFMA32(__builtin_shufflevector(lo, hi, 0, 1, 2, 3, 4, 5, 6, 7), pf, o1); }
                }
            }
            l += __shfl_xor(l, 32); const float inv = 1.0f / l;
            bf16* op = MIX + ((size_t)b * SEQ + q0 + r) * D + head * 64 + 4 * h;
#pragma unroll
            for (int gi = 0; gi < 4; ++gi) {
                u32x2 w0; w0.x = cvtpk_s(o0[4 * gi] * inv, o0[4 * gi + 1] * inv); w0.y = cvtpk_s(o0[4 * gi + 2] * inv, o0[4 * gi + 3] * inv); *(u32x2*)(op + 8 * gi) = w0;
                u32x2 w1; w1.x = cvtpk_s(o1[4 * gi] * inv, o1[4 * gi + 1] * inv); w1.y = cvtpk_s(o1[4 * gi + 2] * inv, o1[4 * gi + 3] * inv); *(u32x2*)(op + 32 + 8 * gi) = w1; }
        }
    }
}
__device__ __forceinline__ void p2_hgrn_simple(Frame& F) {
    const bf16* QH = (const bf16*)(F.ws + WS_QH); const bf16* IH = (const bf16*)(F.ws + WS_IH);
    LAS float* Qs = (LAS float*)(F.lds + RING_OFF); LAS float* Fs = Qs + 32 * 128; LAS float* Vs = Fs + 32 * 128;
    const int vidx = F.tid >> 2, dq = F.tid & 3;
    for (int unit = F.vcu; unit < NB * 4 * 2; unit += F.G) {
        const int dir = unit & 1, h = (unit >> 1) & 3, b = unit >> 3;
        const float* LG = (const float*)(F.ws + (dir ? WS_LB : WS_LF)); float* OUT = (float*)(F.ws + (dir ? WS_OB : WS_OF));
        float S[32];
#pragma unroll
        for (int i = 0; i < 32; ++i) S[i] = 0.f;
        for (int tile = 0; tile < SEQ / 32; ++tile) {
            __syncthreads();
#pragma unroll
            for (int i = 0; i < 8; ++i) { const int idx = F.tid + 512 * i, tt = idx >> 7, d = idx & 127; const int t = dir ? SEQ - 1 - (tile * 32 + tt) : tile * 32 + tt;
                const size_t g = ((size_t)b * SEQ + t) * 512 + h * 128 + d;
                Qs[idx] = __uint_as_float(((unsigned)QH[g]) << 16); Vs[idx] = __uint_as_float(((unsigned)IH[g]) << 16); Fs[idx] = __expf(LG[g]); }
            __syncthreads();
            for (int tt = 0; tt < 32; ++tt) {
                const float v = Vs[tt * 128 + vidx]; float o = 0.f;
#pragma unroll
                for (int dd = 0; dd < 32; dd += 4) { const f32x4 f = *(const LAS f32x4*)(Fs + tt * 128 + dq * 32 + dd), qq = *(const LAS f32x4*)(Qs + tt * 128 + dq * 32 + dd);
#pragma unroll
                    for (int j = 0; j < 4; ++j) { S[dd + j] = f[j] * (S[dd + j] - v) + v; o += S[dd + j] * qq[j]; } }
                o += __shfl_xor(o, 1); o += __shfl_xor(o, 2);
                const int t = dir ? SEQ - 1 - (tile * 32 + tt) : tile * 32 + tt;
                if (dq == 0) OUT[((size_t)b * SEQ + t) * 512 + h * 128 + vidx] = o;
            }
        }
    }
}

#define MFMA16(a, b, c) __builtin_amdgcn_mfma_f32_16x16x32_bf16((a), (b), (c), 0, 0, 0)
constexpr int HP = 272, HPS = 144;
constexpr int H_QR = 0, H_KR = 17408, H_KT = 34816, H_VT = 53248, H_AT = 62464, H_ST = 71680, H_QTOT = 89088, H_EREF = 91136, H_ELR = 91648;
static_assert(H_ELR + 512 <= RING_BYTES, "hgrn LDS");
__device__ __forceinline__ void p2_hgrn(Frame& F) {
    const unsigned short* QH = (const unsigned short*)(F.ws + WS_QH); const unsigned short* IH = (const unsigned short*)(F.ws + WS_IH);
    LAS unsigned char* L = F.lds + RING_OFF;
    const int tid = F.tid, w = F.wave, i16 = F.lane & 15, kg = F.lane >> 4;
    const int d = tid & 127, tq = tid >> 7, vv = tid & 63, sg = tid >> 6;
    constexpr float LOG2E = 1.4426950408889634f;
    for (int unit = F.vcu; unit < NB * 4 * 2 * 2; unit += F.G) {
        const int vh = unit & 1, dir = (unit >> 1) & 1, h = (unit >> 2) & 3, b = unit >> 4;
        const float* LG = (const float*)(F.ws + (dir ? WS_LB : WS_LF)); float* OUT = (float*)(F.ws + (dir ? WS_OB : WS_OF));
        const size_t rowb = (size_t)b * SEQ;
        f32x4 S[4];
#pragma unroll
        for (int i = 0; i < 4; ++i) S[i] = (f32x4){0.f, 0.f, 0.f, 0.f};
        unsigned short qreg[16], vreg[8]; float lf[16];
#define HG_TIME(c, tau) (dir ? (SEQ - 1 - (64 * (c) + (tau))) : (64 * (c) + (tau)))
#define HG_LOAD(c) do { \
        _Pragma("unroll") for (int j = 0; j < 16; ++j) { const size_t g = (rowb + HG_TIME(c, 16 * tq + j)) * 512 + h * 128 + d; qreg[j] = QH[g]; lf[j] = LG[g]; } \
        _Pragma("unroll") for (int j = 0; j < 8; ++j) vreg[j] = IH[(rowb + HG_TIME(c, 8 * sg + j)) * 512 + h * 128 + vh * 64 + vv]; } while (0)
        HG_LOAD(0);
        for (int c = 0; c < SEQ / 64; ++c) {
            __syncthreads();
            float cs[16]; { float run = 0.f;
#pragma unroll
                for (int j = 0; j < 16; ++j) { run += lf[j] * LOG2E; cs[j] = run; }
                *(LAS float*)(L + H_QTOT + (tq * 128 + d) * 4) = run; }
            __syncthreads();
            float pre, ref, last;
            { const float t0 = *(const LAS float*)(L + H_QTOT + d * 4), t1 = *(const LAS float*)(L + H_QTOT + (128 + d) * 4), t2 = *(const LAS float*)(L + H_QTOT + (256 + d) * 4), t3 = *(const LAS float*)(L + H_QTOT + (384 + d) * 4);
              pre = (tq > 0 ? t0 : 0.f) + (tq > 1 ? t1 : 0.f) + (tq > 2 ? t2 : 0.f); ref = t0 + t1; last = (t0 + t1) + (t2 + t3); }
            if (tq == 0) { *(LAS float*)(L + H_EREF + d * 4) = __builtin_amdgcn_exp2f(ref); *(LAS float*)(L + H_ELR + d * 4) = __builtin_amdgcn_exp2f(last - ref); }
            { unsigned kt[8];
#pragma unroll
              for (int j = 0; j < 16; j += 2) {
                  const float c0 = pre + cs[j] - ref, c1 = pre + cs[j + 1] - ref;
                  const float q0 = __uint_as_float(((unsigned)qreg[j]) << 16), q1 = __uint_as_float(((unsigned)qreg[j + 1]) << 16);
                  const float k0 = 1.0f - __builtin_amdgcn_exp2f(lf[j] * LOG2E), k1 = 1.0f - __builtin_amdgcn_exp2f(lf[j + 1] * LOG2E);
                  const float qr0 = q0 * __builtin_amdgcn_exp2f(c0), qr1 = q1 * __builtin_amdgcn_exp2f(c1), kr0 = k0 * __builtin_amdgcn_exp2f(-c0), kr1 = k1 * __builtin_amdgcn_exp2f(-c1);
                  const unsigned qq = cvtpk_s(qr0, qr1), kk = cvtpk_s(kr0, kr1); kt[j >> 1] = kk;
                  *(LAS unsigned short*)(L + H_QR + (16 * tq + j) * HP + d * 2) = (unsigned short)qq; *(LAS unsigned short*)(L + H_QR + (16 * tq + j + 1) * HP + d * 2) = (unsigned short)(qq >> 16);
                  *(LAS unsigned short*)(L + H_KR + (16 * tq + j) * HP + d * 2) = (unsigned short)kk; *(LAS unsigned short*)(L + H_KR + (16 * tq + j + 1) * HP + d * 2) = (unsigned short)(kk >> 16); }
              *(LAS v4u*)(L + H_KT + d * HPS + tq * 32) = (v4u){kt[0], kt[1], kt[2], kt[3]}; *(LAS v4u*)(L + H_KT + d * HPS + tq * 32 + 16) = (v4u){kt[4], kt[5], kt[6], kt[7]}; }
            { v4u vw; vw.x = (unsigned)vreg[0] | ((unsigned)vreg[1] << 16); vw.y = (unsigned)vreg[2] | ((unsigned)vreg[3] << 16); vw.z = (unsigned)vreg[4] | ((unsigned)vreg[5] << 16); vw.w = (unsigned)vreg[6] | ((unsigned)vreg[7] << 16);
              *(LAS v4u*)(L + H_VT + vv * HPS + sg * 16) = vw; }
            if (c + 1 < SEQ / 64) HG_LOAD(c + 1);
            __syncthreads();
            {
                const f32x4 er = *(const LAS f32x4*)(L + H_EREF + (16 * w + 4 * kg) * 4);
#pragma unroll
                for (int vt = 0; vt < 4; ++vt) { S[vt] = S[vt] * er; u32x2 pk; pk.x = cvtpk_s(S[vt][0], S[vt][1]); pk.y = cvtpk_s(S[vt][2], S[vt][3]);
                    *(LAS u32x2*)(L + H_ST + (16 * vt + i16) * HP + (16 * w + 4 * kg) * 2) = pk; }
                const int tt = w >> 1;
#pragma unroll
                for (int q2 = 0; q2 < 2; ++q2) { const int st = 2 * (w & 1) + q2; LAS unsigned char* ap = L + H_AT + (16 * tt + i16) * HPS + (16 * st + 4 * kg) * 2;
                    if (st > tt) { *(LAS u32x2*)ap = (u32x2){0u, 0u}; }
                    else { f32x4 a = (f32x4){0.f, 0.f, 0.f, 0.f};
#pragma unroll
                        for (int ks = 0; ks < 4; ++ks) { const pg8::bf16x8 kf = *(const LAS pg8::bf16x8*)(L + H_KR + (16 * st + i16) * HP + (32 * ks + 8 * kg) * 2), qf = *(const LAS pg8::bf16x8*)(L + H_QR + (16 * tt + i16) * HP + (32 * ks + 8 * kg) * 2);
                            a = MFMA16(kf, qf, a); }
                        if (st == tt) {
#pragma unroll
                            for (int i = 0; i < 4; ++i) a[i] = (4 * kg + i <= i16) ? a[i] : 0.f; }
                        u32x2 pk; pk.x = cvtpk_s(a[0], a[1]); pk.y = cvtpk_s(a[2], a[3]); *(LAS u32x2*)ap = pk; } }
#pragma unroll
                for (int ks = 0; ks < 2; ++ks) { const pg8::bf16x8 af = *(const LAS pg8::bf16x8*)(L + H_KT + (16 * w + i16) * HPS + (32 * ks + 8 * kg) * 2);
#pragma unroll
                    for (int vt = 0; vt < 4; ++vt) { const pg8::bf16x8 bfv = *(const LAS pg8::bf16x8*)(L + H_VT + (16 * vt + i16) * HPS + (32 * ks + 8 * kg) * 2); S[vt] = MFMA16(af, bfv, S[vt]); } }
                const f32x4 el = *(const LAS f32x4*)(L + H_ELR + (16 * w + 4 * kg) * 4);
#pragma unroll
                for (int vt = 0; vt < 4; ++vt) S[vt] = S[vt] * el;
            }
            __syncthreads();
            {
                const int vt = w & 3, tp = w >> 2;
                f32x4 oa[2]; oa[0] = (f32x4){0.f, 0.f, 0.f, 0.f}; oa[1] = oa[0];
#pragma unroll
                for (int ks = 0; ks < 4; ++ks) { const pg8::bf16x8 sf = *(const LAS pg8::bf16x8*)(L + H_ST + (16 * vt + i16) * HP + (32 * ks + 8 * kg) * 2);
#pragma unroll
                    for (int q2 = 0; q2 < 2; ++q2) { const pg8::bf16x8 qf = *(const LAS pg8::bf16x8*)(L + H_QR + (16 * (2 * tp + q2) + i16) * HP + (32 * ks + 8 * kg) * 2); oa[q2] = MFMA16(sf, qf, oa[q2]); } }
#pragma unroll
                for (int ks = 0; ks < 2; ++ks) if (ks <= tp) { const pg8::bf16x8 vf = *(const LAS pg8::bf16x8*)(L + H_VT + (16 * vt + i16) * HPS + (32 * ks + 8 * kg) * 2);
#pragma unroll
                    for (int q2 = 0; q2 < 2; ++q2) { const pg8::bf16x8 af = *(const LAS pg8::bf16x8*)(L + H_AT + (16 * (2 * tp + q2) + i16) * HPS + (32 * ks + 8 * kg) * 2); oa[q2] = MFMA16(vf, af, oa[q2]); } }
#pragma unroll
                for (int q2 = 0; q2 < 2; ++q2) { const int tm = HG_TIME(c, 16 * (2 * tp + q2) + i16); *(f32x4*)(OUT + (rowb + tm) * 512 + h * 128 + vh * 64 + 16 * vt + 4 * kg) = oa[q2]; }
            }
        }
#undef HG_LOAD
#undef HG_TIME
    }
}
__device__ __forceinline__ void p3_finalize(Frame& F) {
    const float* OFp = (const float*)(F.ws + WS_OF); const float* OBp = (const float*)(F.ws + WS_OB); const bf16* ZG = (const bf16*)(F.ws + WS_ZG); bf16* MIX = (bf16*)(F.ws + WS_MIX);
    const int gw = F.vcu * NWAVES + F.wave, NGW = F.G * NWAVES;
    for (int it = gw; it < T * 4; it += NGW) {
        const int tok = it >> 2, h = it & 3; const size_t g = (size_t)tok * 512 + h * 128 + 2 * F.lane;
        const float2 a = *(const float2*)(OFp + g), c = *(const float2*)(OBp + g); const float o0 = a.x + c.x, o1 = a.y + c.y;
        const float ss = wave_sum(o0 * o0 + o1 * o1); const float r = 1.0f / sqrtf(ss * (1.0f / 128.0f) + RMS_EPS);
        const unsigned zg = *(const unsigned*)(ZG + g);
        *(unsigned*)(MIX + (size_t)tok * D + 512 + h * 128 + 2 * F.lane) = pg8::cvt_pk_bf16(o0 * r * bflo(zg), o1 * r * bfhi(zg));
    }
}

__device__ __forceinline__ void p5_router(Frame& F) {
    const float* U = (const float*)(F.ws + WS_U); bf16* H1 = (bf16*)(F.ws + WS_H1); unsigned char* H1F8 = F.ws + WS_H1F8; int* TOPI = (int*)(F.ws + WS_TOPI); float* TOPG = (float*)(F.ws + WS_TOPG); int* cntTab = (int*)(F.ws + WS_TAB);
    const float* Wr = F.in[10]; const float* br = F.in[11]; const float* lg = F.in[8]; const float* lb = F.in[9];
    LAS float* part = (LAS float*)(F.lds + RING_OFF);
    LAS float* LGs = (LAS float*)(F.lds + RING_OFF + 1024);
    LAS int* hist = (LAS int*)(F.lds + HIST_OFF);
    const int w = F.wave, i16 = F.lane & 15, kg = F.lane >> 4, kcol = 128 * w + 8 * kg;
    pg8::bf16x8 bhi[4][2], blo[4][2];
#pragma unroll
    for (int ks = 0; ks < 4; ++ks)
#pragma unroll
        for (int nt = 0; nt < 2; ++nt) { v4u ph, pl; unsigned* phh = (unsigned*)&ph; unsigned* pll = (unsigned*)&pl;
#pragma unroll
            for (int j = 0; j < 8; j += 2) { const float x0 = Wr[(size_t)(kcol + 32 * ks + j) * NE + 16 * nt + i16], x1 = Wr[(size_t)(kcol + 32 * ks + j + 1) * NE + 16 * nt + i16];
                const unsigned hh = cvtpk_s(x0, x1); phh[j >> 1] = hh; pll[j >> 1] = cvtpk_s(x0 - bflo(hh), x1 - bfhi(hh)); }
            bhi[ks][nt] = __builtin_bit_cast(pg8::bf16x8, ph); blo[ks][nt] = __builtin_bit_cast(pg8::bf16x8, pl); }
    const float mybias = br[F.lane & 31];
    for (int chunk = F.vcu; chunk < NCHUNK; chunk += F.G) {
        __syncthreads();
        if (F.tid < NE) hist[F.tid] = 0;
        for (int it = 0; it < CHUNK_TOK / 16; ++it) {
            const int tok0 = chunk * CHUNK_TOK + it * 16, tok = tok0 + i16;
            f32x4 u[4][2]; float s1 = 0.f, s2 = 0.f;
#pragma unroll
            for (int ks = 0; ks < 4; ++ks)
#pragma unroll
                for (int q = 0; q < 2; ++q) { u[ks][q] = *(const GAS f32x4*)(U + (size_t)tok * D + kcol + 32 * ks + 4 * q);
                    s1 += (u[ks][q][0] + u[ks][q][1]) + (u[ks][q][2] + u[ks][q][3]); s2 += (u[ks][q][0] * u[ks][q][0] + u[ks][q][1] * u[ks][q][1]) + (u[ks][q][2] * u[ks][q][2] + u[ks][q][3] * u[ks][q][3]); }
            s1 += __shfl_xor(s1, 16); s1 += __shfl_xor(s1, 32); s2 += __shfl_xor(s2, 16); s2 += __shfl_xor(s2, 32);
            if (kg == 0) { part[(w * 16 + i16) * 2] = s1; part[(w * 16 + i16) * 2 + 1] = s2; }
            __syncthreads();
            float t1 = 0.f, t2 = 0.f;
#pragma unroll
            for (int ww = 0; ww < 8; ++ww) { t1 += part[(ww * 16 + i16) * 2]; t2 += part[(ww * 16 + i16) * 2 + 1]; }
            const float mean = t1 * (1.0f / D), rstd = 1.0f / sqrtf(fmaxf(t2 * (1.0f / D) - mean * mean, 0.f) + LN_EPS);
            f32x4 acc[2]; acc[0] = (f32x4){0.f, 0.f, 0.f, 0.f}; acc[1] = acc[0];
#pragma unroll
            for (int ks = 0; ks < 4; ++ks) { v4u ph, pl; unsigned* phh = (unsigned*)&ph; unsigned* pll = (unsigned*)&pl;
#pragma unroll
                for (int q = 0; q < 2; ++q) { const f32x4 gq = *(const f32x4*)(lg + kcol + 32 * ks + 4 * q), bq = *(const f32x4*)(lb + kcol + 32 * ks + 4 * q); const f32x4 y = (u[ks][q] - mean) * rstd * gq + bq;
                    const unsigned h0 = cvtpk_s(y[0], y[1]), h1 = cvtpk_s(y[2], y[3]); phh[2 * q] = h0; phh[2 * q + 1] = h1;
                    pll[2 * q] = cvtpk_s(y[0] - bflo(h0), y[1] - bfhi(h0)); pll[2 * q + 1] = cvtpk_s(y[2] - bflo(h1), y[3] - bfhi(h1)); }
                *(GAS v4u*)(H1 + (size_t)tok * D + kcol + 32 * ks) = ph;
                { u32x2 f8; f8.x = pk4_fp8(bflo(ph.x) * F8_SA, bfhi(ph.x) * F8_SA, bflo(ph.y) * F8_SA, bfhi(ph.y) * F8_SA); f8.y = pk4_fp8(bflo(ph.z) * F8_SA, bfhi(ph.z) * F8_SA, bflo(ph.w) * F8_SA, bfhi(ph.w) * F8_SA);
                  *(GAS u32x2*)(H1F8 + (size_t)tok * D + kcol + 32 * ks) = f8; }
                const pg8::bf16x8 ahi = __builtin_bit_cast(pg8::bf16x8, ph), alo = __builtin_bit_cast(pg8::bf16x8, pl);
#pragma unroll
                for (int nt = 0; nt < 2; ++nt) { acc[nt] = MFMA16(ahi, bhi[ks][nt], acc[nt]); acc[nt] = MFMA16(alo, bhi[ks][nt], acc[nt]); acc[nt] = MFMA16(ahi, blo[ks][nt], acc[nt]); } }
#pragma unroll
            for (int nt = 0; nt < 2; ++nt)
#pragma unroll
                for (int i = 0; i < 4; ++i) LGs[(w * 16 + 4 * kg + i) * 32 + 16 * nt + i16] = acc[nt][i];
            __syncthreads();
            {
                const int tl = 2 * w + (F.lane >> 5), e = F.lane & 31; float v = mybias;
#pragma unroll
                for (int ww = 0; ww < 8; ++ww) v += LGs[(ww * 16 + tl) * 32 + e];
                float tv[4]; int tix[4];
#pragma unroll
                for (int k = 0; k < 4; ++k) { float bv = v; int bi = e;
#pragma unroll
                    for (int o = 1; o < 32; o <<= 1) { const float ov = __shfl_xor(bv, o); const int oi = __shfl_xor(bi, o); const bool take = (ov > bv) || (ov == bv && oi < bi); bv = take ? ov : bv; bi = take ? oi : bi; }
                    tv[k] = bv; tix[k] = bi; if (e == bi) v = -3.0e38f; }
                const float e1 = __expf(tv[1] - tv[0]), e2 = __expf(tv[2] - tv[0]), e3 = __expf(tv[3] - tv[0]); const float inv = 1.0f / (1.0f + e1 + e2 + e3);
                if (e == 0) { const size_t tk = (size_t)(tok0 + tl);
                    *(int4*)(TOPI + tk * 4) = make_int4(tix[0], tix[1], tix[2], tix[3]); *(float4*)(TOPG + tk * 4) = make_float4(inv, e1 * inv, e2 * inv, e3 * inv);
                    atomicAdd((int*)&hist[tix[0]], 1); atomicAdd((int*)&hist[tix[1]], 1); atomicAdd((int*)&hist[tix[2]], 1); atomicAdd((int*)&hist[tix[3]], 1); }
            }
        }
        __syncthreads();
        if (F.tid < NE) cntTab[chunk * NE + F.tid] = hist[F.tid];
    }
}

__device__ __forceinline__ void p6_dispatch(Frame& F) {
    const int* cntTab = (const int*)(F.ws + WS_TAB); int* tileExpertG = (int*)(F.ws + WS_TAB + 65536); int* ntilesG = (int*)(F.ws + WS_TAB + 98304);
    const int* TOPI = (const int*)(F.ws + WS_TOPI); const float* TOPG = (const float*)(F.ws + WS_TOPG); int* ROWTOK = (int*)(F.ws + WS_ROWTOK); float* GATES = (float*)(F.ws + WS_GATES);
    LAS int* ptot = (LAS int*)(F.lds + RING_OFF);
    LAS int* ppre = ptot + 512;
    LAS int* tot = ppre + 512;
    LAS int* base = tot + 32;
    LAS int* myoff = base + 36;
    LAS int* ent = myoff + 32;
    LAS int* slotl = ent + 512;
    for (int chunk = F.vcu; chunk < NCHUNK; chunk += F.G) {
        __syncthreads();
        { const int e = F.tid & 31, part = F.tid >> 5; int st = 0, sp = 0;
          for (int w = part * 16; w < part * 16 + 16; ++w) { const int c = cntTab[w * NE + e]; st += c; sp += (w < chunk) ? c : 0; }
          ptot[part * 32 + e] = st; ppre[part * 32 + e] = sp; }
        ent[F.tid] = TOPI[(size_t)chunk * CHUNK_TOK * 4 + F.tid];
        __syncthreads();
        if (F.tid < NE) { int st = 0, sp = 0; for (int p = 0; p < 16; ++p) { st += ptot[p * 32 + F.tid]; sp += ppre[p * 32 + F.tid]; } tot[F.tid] = st; myoff[F.tid] = sp; }
        __syncthreads();
        if (F.tid == 0) { int acc = 0; for (int e = 0; e < NE; ++e) { base[e] = acc; acc += (tot[e] + 255) & ~255; } base[NE] = acc; }
        __syncthreads();
        if (F.tid < NE) { int pos = base[F.tid] + myoff[F.tid]; for (int i = 0; i < 512; ++i) if (ent[i] == F.tid) slotl[i] = pos++; }
        __syncthreads();
        { const int slot = slotl[F.tid]; const size_t ge = (size_t)chunk * CHUNK_TOK * 4 + F.tid; ROWTOK[slot] = (int)ge; GATES[slot] = TOPG[ge]; }
        if (chunk == 0) {
            if (F.tid < NE) { const int e = F.tid; for (int tl = base[e] >> 8; tl < (base[e + 1] >> 8); ++tl) tileExpertG[tl] = e; for (int s = base[e] + tot[e]; s < base[e + 1]; ++s) { ROWTOK[s] = -1; GATES[s] = 0.f; } }
            if (F.tid == 0) ntilesG[0] = base[NE] >> 8;
        }
    }
}

__device__ __forceinline__ void p9_combine(Frame& F) {
    const bf16* H1 = (const bf16*)(F.ws + WS_H1); const bf16* Y = (const bf16*)(F.ws + WS_Y);
    const int gw = F.vcu * NWAVES + F.wave, NGW = F.G * NWAVES;
    f32x4 gg[4], bb[4];
#pragma unroll
    for (int j = 0; j < 4; ++j) { gg[j] = ((const f32x4*)F.in[16])[F.lane + 64 * j]; bb[j] = ((const f32x4*)F.in[17])[F.lane + 64 * j]; }
    for (int tok = gw; tok < T; tok += NGW) {
        f32x4 v[4]; float s = 0.f;
#pragma unroll
        for (int j = 0; j < 4; ++j) { const u32x2 hb = ((const u32x2*)(H1 + (size_t)tok * D))[F.lane + 64 * j];
            v[j][0] = DN_ALPHA * bflo(hb.x); v[j][1] = DN_ALPHA * bfhi(hb.x); v[j][2] = DN_ALPHA * bflo(hb.y); v[j][3] = DN_ALPHA * bfhi(hb.y);
#pragma unroll
            for (int k = 0; k < 4; ++k) { const u32x2 yb = ((const u32x2*)(Y + ((size_t)tok * 4 + k) * D))[F.lane + 64 * j]; v[j][0] += bflo(yb.x); v[j][1] += bfhi(yb.x); v[j][2] += bflo(yb.y); v[j][3] += bfhi(yb.y); }
            s += (v[j].x + v[j].y) + (v[j].z + v[j].w); }
        const float mean = wave_sum(s) * (1.f / D); float s2 = 0.f;
#pragma unroll
        for (int j = 0; j < 4; ++j) { v[j] = v[j] - mean; s2 += (v[j].x * v[j].x + v[j].y * v[j].y) + (v[j].z * v[j].z + v[j].w * v[j].w); }
        const float rstd = 1.f / sqrtf(wave_sum(s2) * (1.f / D) + LN_EPS);
        GAS f32x4* o = (GAS f32x4*)(F.out + (size_t)tok * D) + F.lane;
#pragma unroll
        for (int j = 0; j < 4; ++j) o[64 * j] = v[j] * rstd * gg[j] + bb[j];
    }
}

struct Args { const float* in[18]; float* out; unsigned char* ws; int ph_lo, ph_hi; };
__global__ void __launch_bounds__(NWAVES * 64, 2) hymba_fwd(Args args) {
    extern __shared__ __attribute__((aligned(16))) unsigned char lds[];
    Frame F;
    F.lds = (LAS unsigned char*)lds;
    F.MISC = (volatile LAS unsigned*)(F.lds + MISC_OFF);
    F.tid = threadIdx.x; F.lane = F.tid & 63; F.wave = __builtin_amdgcn_readfirstlane(F.tid >> 6);
    F.G = gridDim.x; { const int bx = blockIdx.x; F.vcu = (F.G % 8 == 0) ? (bx % 8) * (F.G / 8) + bx / 8 : bx; }
    F.ws = args.ws; F.out = args.out; F.ctl = (gu32*)(args.ws + WS_CTL);
#pragma unroll
    for (int i = 0; i < 18; ++i) F.in[i] = args.in[i];
    for (int u = F.tid; u < (LDS_BYTES - LDSCTL_OFF) / 4; u += NWAVES * 64) ((LAS unsigned*)(F.lds + LDSCTL_OFF))[u] = 0u;
    __syncthreads();
    XcdBarrier bar; bar.bar = (unsigned*)(F.ctl + CW_BAR); bar.x = 0; bar.st = nullptr;
    if (N_LAUNCHES == 1) bar = xcd_barrier_post((unsigned*)(F.ctl + CW_BAR), F.MISC + 8);
#define GRID_BAR() do { if (N_LAUNCHES == 1) xcd_barrier(bar); } while (0)
    const int lo = args.ph_lo, hi = args.ph_hi;
#define IN(k) (lo <= (k) && (k) < hi)
#define BOTH(k) (IN(k) && IN((k) + 1))
    unsigned char* ws = args.ws;

#ifndef PROBE_DBL
#define PROBE_DBL 0
#endif
#define DBL(k) ((PROBE_DBL >> (k)) & 1)
    if (IN(0)) { p0_prologue(F); if (DBL(0)) { __syncthreads(); p0_prologue(F); } if (BOTH(0)) GRID_BAR(); }

    if (IN(1)) {
        pg8::Gemm g{(const bf16*)(ws + WS_H0), (const bf16*)(ws + WS_WIN), T, NIN, D}; pg8::StaticOrder S; S.init(T, NIN, F.G, (int)blockIdx.x);
        EpiInProj E{(bf16*)(ws + WS_QA), (bf16*)(ws + WS_KA), (bf16*)(ws + WS_VA), (bf16*)(ws + WS_QH), (bf16*)(ws + WS_IH), (bf16*)(ws + WS_ZG), (float*)(ws + WS_LF), (float*)(ws + WS_LB), F.in[5], F.in[6]};
        pg8::gemm_phase<EpiInProj, pg8::StaticOrder, true, true>(F.lds + RING_OFF, g, S, E);
        if (BOTH(1)) GRID_BAR();
    }
    if (IN(2)) { p2_attn(F); __syncthreads(); p2_hgrn(F); if (DBL(2)) { __syncthreads(); p2_attn(F); __syncthreads(); p2_hgrn(F); } if (BOTH(2)) GRID_BAR(); }
    if (IN(3)) { p3_finalize(F); if (DBL(3)) p3_finalize(F); if (BOTH(3)) GRID_BAR(); }
    if (IN(4)) {
        pg8::Gemm g{(const bf16*)(ws + WS_MIX), (const bf16*)(ws + WS_WOUT), T, D, D}; pg8::StaticOrder S; S.init(T, D, F.G, (int)blockIdx.x);
        EpiOutProj E{(const bf16*)(ws + WS_H0), (float*)(ws + WS_U)};
        pg8::gemm_phase<EpiOutProj, pg8::StaticOrder, true, true>(F.lds + RING_OFF, g, S, E);
        if (BOTH(4)) GRID_BAR();
    }
    if (IN(5)) { p5_router(F); if (DBL(5)) { __syncthreads(); p5_router(F); } if (BOTH(5)) GRID_BAR(); }
    if (IN(6)) { p6_dispatch(F); if (DBL(6)) { __syncthreads(); p6_dispatch(F); } if (BOTH(6)) GRID_BAR(); }
    const int ntiles = (IN(7) || IN(8)) ? *(const int*)(ws + WS_TAB + 98304) : 0;
    if (IN(7) || IN(8)) {
        const int* tileExpertG = (const int*)(ws + WS_TAB + 65536); const int* ROWTOK = (const int*)(ws + WS_ROWTOK);
        __syncthreads();
        for (int i = F.tid; i < MAXTILES; i += NWAVES * 64) ((LAS int*)(F.lds + TAB_OFF))[i] = tileExpertG[i] & 31;
        if (IN(7)) for (int i = 0; i < MAXUNITS_WG; ++i) { const int L = i * F.G + (int)blockIdx.x; if (L >= ntiles * 8) break; const int tile = L >> 3;
            if (F.tid < 256) { const int rt = ROWTOK[tile * 256 + F.tid]; ((LAS unsigned short*)(F.lds + ROWL_OFF))[i * 256 + F.tid] = (unsigned short)((rt < 0 ? 0 : rt) >> 2); } }
        __syncthreads();
    }
    if (IN(7)) {
        pg8::Gemm g{(const bf16*)(ws + WS_H1F8), (const bf16*)(ws + WS_WUP), T, NE * DFF, D / 2}; MoeOrder S{(const LAS int*)(F.lds + TAB_OFF), ntiles * 8, 8, F.G, (int)blockIdx.x};
        EpiUp E{ws + WS_ACT, F.in[13]};
        pg8::gemm_phase<EpiUp, MoeOrder, true, true, true, true>(F.lds + RING_OFF, g, S, E, (const LAS unsigned short*)(F.lds + ROWL_OFF));
        if (BOTH(7)) GRID_BAR();
    }
    if (IN(8)) {
        pg8::Gemm g{(const bf16*)(ws + WS_ACT), (const bf16*)(ws + WS_WD), MAXSLOTS, NE * D, D / 2}; MoeOrder S{(const LAS int*)(F.lds + TAB_OFF), ntiles * 4, 4, F.G, (int)blockIdx.x};
        EpiDown E{(bf16*)(ws + WS_Y), (const int*)(ws + WS_ROWTOK), (const float*)(ws + WS_GATES), F.in[15]};
        pg8::gemm_phase<EpiDown, MoeOrder, true, true, false, true>(F.lds + RING_OFF, g, S, E);
        if (BOTH(8)) GRID_BAR();
    }
    if (IN(9)) { p9_combine(F); if (DBL(9)) p9_combine(F); }
#undef IN
#undef BOTH
}

extern "C" void kernel_launch(void* const* d_in, const int* in_sizes, int n_in, void* d_out, int out_size, void* d_ws, size_t ws_size, hipStream_t stream) {
    static int grid = 0;
    if (grid == 0) {
        if (n_in != 18 || in_sizes[0] != T * D || out_size != T * D || ws_size < WS_END) { fprintf(stderr, "kernel_launch: unexpected shapes (n_in %d, in0 %d, out %d, ws %zu); nothing launched\n", n_in, n_in > 0 ? in_sizes[0] : -1, out_size, ws_size); grid = -1; return; }
        int dev = 0, cus = 0, per_cu = 0;
        if (hipGetDevice(&dev) != hipSuccess || hipDeviceGetAttribute(&cus, hipDeviceAttributeMultiprocessorCount, dev) != hipSuccess) { grid = -1; return; }
        if (hipFuncSetAttribute((const void*)hymba_fwd, hipFuncAttributeMaxDynamicSharedMemorySize, LDS_BYTES) != hipSuccess) { fprintf(stderr, "kernel_launch: hipFuncSetAttribute failed\n"); grid = -1; return; }
        if (hipOccupancyMaxActiveBlocksPerMultiprocessor(&per_cu, (const void*)hymba_fwd, NWAVES * 64, LDS_BYTES) != hipSuccess || per_cu < 1) fprintf(stderr, "kernel_launch: occupancy query says %d\n", per_cu);
        (void)hipGetLastError();
        grid = cus;
    }
    if (grid < 0) return;
    if (hipMemsetAsync((char*)d_ws + WS_CTL, 0, CTL_ZERO_BYTES, stream) != hipSuccess) return;
    Args a{};
    for (int i = 0; i < 18; ++i) a.in[i] = (const float*)d_in[i];
    a.out = (float*)d_out; a.ws = (unsigned char*)d_ws;
    if (N_LAUNCHES == 1) { a.ph_lo = 0; a.ph_hi = PER_PHASE; hipLaunchKernelGGL(hymba_fwd, dim3(grid), dim3(NWAVES * 64), LDS_BYTES, stream, a); }
    else for (int li = 0; li < PER_PHASE; ++li) { a.ph_lo = li; a.ph_hi = li + 1; hipLaunchKernelGGL(hymba_fwd, dim3(grid), dim3(NWAVES * 64), LDS_BYTES, stream, a); }
}
```

```cpp
#include <hip/hip_runtime.h>
#include <cstdio>
#include <cstdint>
#include <cstddef>
#ifndef MK_N_LAUNCHES
#define MK_N_LAUNCHES 1
#endif
namespace pg8 {
#define PG8_LAS __attribute__((address_space(3)))
typedef unsigned short bf16_t;
typedef short bf16x8 __attribute__((ext_vector_type(8)));
typedef float f32x4 __attribute__((ext_vector_type(4)));
typedef unsigned u32x4 __attribute__((ext_vector_type(4)));
constexpr int BM = 256, BK = 64, HALF = 128, HTB = HALF * BK * 2  , STAGE_BYTES = 8 * HTB, NXCD = 8, WGM = 8;

__host__ __device__ __forceinline__ int lds_byte(int r, int c) { const int st = (r >> 4) * 2 + (c >> 5), rr = r & 15, cc = c & 31, ob = rr * 64 + cc * 2; return st * 1024 + (ob ^ (((ob >> 9) & 1) << 5)); }
__host__ __device__ __forceinline__ void stage_rc(int b, int& R, int& C) { const int st = b / 1024, sb = b % 1024, swz = sb ^ (((sb >> 9) & 1) << 5); R = (st >> 1) * 16 + swz / 64; C = (st & 1) * 32 + (swz % 64) / 2; }
__host__ __device__ __forceinline__ int perm32(int rho) { const int n = rho >> 4, i = rho & 15; return 8 * (i >> 2) + 4 * n + (i & 3); }

struct Unit { int pm, pn, ord; };
struct Gemm { const bf16_t* A; const bf16_t* Bt; int M, N, K; };

struct StaticOrder {
    int nM, nN, nwg, G, c;
    __host__ __device__ void init(int M, int N, int G_, int c_) { nM = M / BM; nN = N / BM; nwg = nM * nN; G = G_; c = c_; }
    __host__ __device__ bool next(int i, Unit& u) const {
        const long L = (long)i * G + c; if (L >= nwg) return false;
        int wgid = (int)L; { const int q = nwg / NXCD, r = nwg % NXCD, xcd = wgid % NXCD, off = wgid / NXCD; wgid = (xcd < r ? xcd * (q + 1) : r * (q + 1) + (xcd - r) * q) + off; }
        const int nig = WGM * nN, gid = wgid / nig, fm = gid * WGM, gsz = (nM - fm) < WGM ? (nM - fm) : WGM;
        u.pm = fm + ((wgid % nig) % gsz); u.pn = (wgid % nig) / gsz; return true;
    }
    __device__ __forceinline__ void a_ready(const Unit&) const {}
    __device__ __forceinline__ void done(const Unit&) const {}
};

__device__ __forceinline__ unsigned cvt_pk_bf16(float lo, float hi) { unsigned r; asm volatile("v_cvt_pk_bf16_f32 %0, %1, %2" : "=v"(r) : "v"(lo), "v"(hi)); return r; }
typedef float f32x2 __attribute__((ext_vector_type(2)));
__device__ __forceinline__ f32x2 gelu_pk(f32x2 v) {
    const f32x2 av = __builtin_elementwise_abs(v), d = av * 0.2316418882f + 1.0f;
    f32x2 t; t.x = __builtin_amdgcn_rcpf(d.x); t.y = __builtin_amdgcn_rcpf(d.y);
    f32x2 q = t * 0.5307027145f + (-0.7265760135f); q = q * t + 0.7107068705f; q = q * t + (-0.142248368f); q = q * t + 0.127414796f; q = q * t;
    const f32x2 s = (v * v) * (-0.72134752044f);
    f32x2 e; e.x = __builtin_amdgcn_exp2f(s.x); e.y = __builtin_amdgcn_exp2f(s.y);
    const f32x2 m = v * (q * e), r = v - m;
    f32x2 o; o.x = v.x < 0.f ? m.x : r.x; o.y = v.y < 0.f ? m.y : r.y; return o;
}

template <int ACT  > struct EpiBf16 {
    static constexpr bool PERM = true, AFTER_DRAIN = false; static_assert(ACT == 0 || ACT == 1, "EpiBf16: ACT is 0 (none) or 1 (gelu_pk)");
    bf16_t* O; int ldc; const float* bias; int split_cols; size_t split_stride; float scale0;
    __device__ __forceinline__ void operator()(const f32x4 (&acc)[2][2][4][2], const Unit& u, int wr, int wc, int fr, int fq) const {
        const int row0 = u.pm * BM + wr * 64 + fr; int colt = u.pn * BM; bf16_t* base = O;
        float sc = 1.f; if (split_cols) { const int t = colt / split_cols; base += (size_t)t * split_stride; colt -= t * split_cols; if (t == 0) sc = scale0; }
        const int col0 = colt + wc * 32 + 8 * fq, bcol0 = u.pn * BM + wc * 32 + 8 * fq;
        f32x4 bv[2][2];
#pragma unroll
        for (int bj = 0; bj < 2; ++bj)
#pragma unroll
            for (int n = 0; n < 2; ++n) bv[bj][n] = bias ? *(const f32x4*)(bias + bcol0 + bj * HALF + 4 * n) : (f32x4){0.f, 0.f, 0.f, 0.f};
#pragma unroll
        for (int ai = 0; ai < 2; ++ai)
#pragma unroll
            for (int m = 0; m < 4; ++m) { bf16_t* rowp = base + (size_t)(row0 + ai * HALF + m * 16) * ldc + col0;
#pragma unroll
                for (int bj = 0; bj < 2; ++bj) { f32x4 v0 = acc[ai][bj][m][0] + bv[bj][0], v1 = acc[ai][bj][m][1] + bv[bj][1];
                    if (ACT == 1) { f32x2 a = gelu_pk((f32x2){v0[0], v0[1]}), b = gelu_pk((f32x2){v0[2], v0[3]}), c = gelu_pk((f32x2){v1[0], v1[1]}), d = gelu_pk((f32x2){v1[2], v1[3]});
                        v0 = (f32x4){a.x, a.y, b.x, b.y}; v1 = (f32x4){c.x, c.y, d.x, d.y}; }
                    v0 = v0 * sc; v1 = v1 * sc; u32x4 w; w.x = cvt_pk_bf16(v0[0], v0[1]); w.y = cvt_pk_bf16(v0[2], v0[3]); w.z = cvt_pk_bf16(v1[0], v1[1]); w.w = cvt_pk_bf16(v1[2], v1[3]);
                    *(u32x4*)(rowp + bj * HALF) = w; } }
    }
};
typedef int i32x8 __attribute__((ext_vector_type(8)));
template <class Epi, class Sched, bool ALIGN_EPI = false, bool SP2 = false, bool GATHER = false, bool FP8 = false>
__device__ __forceinline__ void gemm_phase(PG8_LAS unsigned char* lds, const Gemm g, const Sched& S, const Epi& E, const PG8_LAS unsigned short* rowl = nullptr) {
    static_assert(!GATHER || SP2, "GATHER is implemented for the SP2 loop only");
    const int tid = threadIdx.x, wid = __builtin_amdgcn_readfirstlane(tid >> 6), lane = tid & 63, wr = wid >> 2, wc = wid & 3, fr = lane & 15, fq = lane >> 4;
    const int K = g.K, nt = K / BK;
    unsigned voffA[2], voffB[2];
#pragma unroll
    for (int i = 0; i < 2; ++i) { int R, C; stage_rc(tid * 16 + i * 8192, R, C); const int Rb = Epi::PERM ? ((R & ~31) + perm32(R & 31)) : R;
        voffA[i] = (unsigned)(R * K + C) * 2u; voffB[i] = (unsigned)(Rb * K + C) * 2u; }
    const size_t kstep = (size_t)(BK * 2);
    const size_t hstep = (size_t)HALF * K * 2;
    const size_t tstep = 2 * hstep;
    const unsigned ldsw = (unsigned)wid * 1024u;
    const int aoff = lds_byte(wr * 64 + fr, fq * 8), boff = lds_byte(wc * 32 + fr, fq * 8);
#define PG8_SA(b, h) (((b) * 2 + (h)) * HTB)
#define PG8_SB(b, h) ((4 + (b) * 2 + (h)) * HTB)
#define PG8_STAGE(bufoff, gbase, voff) do { _Pragma("unroll") for (int _i = 0; _i < 2; ++_i) \
        __builtin_amdgcn_global_load_lds((const unsigned*)((const char*)(gbase) + (voff)[_i]), (PG8_LAS unsigned*)(lds + (bufoff) + ldsw + _i * 8192), 16, 0, 0); } while (0)
#define PG8_STAGE_AG(bufoff, kb, rw, h) do { _Pragma("unroll") for (int _i = 0; _i < 2; ++_i) \
        __builtin_amdgcn_global_load_lds((const unsigned*)((const char*)g.A + (kb) + (rw)[h][_i]), (PG8_LAS unsigned*)(lds + (bufoff) + ldsw + _i * 8192), 16, 0, 0); } while (0)
#define PG8_ROWS(rw, uidx) do { _Pragma("unroll") for (int _h = 0; _h < 2; ++_h) _Pragma("unroll") for (int _i = 0; _i < 2; ++_i) { int R_, C_; stage_rc(tid * 16 + _i * 8192, R_, C_); \
        (rw)[_h][_i] = (unsigned)rowl[(uidx) * 256 + _h * 128 + R_] * (unsigned)(K * 2) + (unsigned)(C_ * 2); } } while (0)
#define PG8_RD16(off) (*(const PG8_LAS bf16x8*)(lds + (off)))
#define PG8_CAT2(x, y) __builtin_bit_cast(i32x8, __builtin_shufflevector((x), (y), 0, 1, 2, 3, 4, 5, 6, 7, 8, 9, 10, 11, 12, 13, 14, 15))
#define PG8_LDA(dst, b, h) do { if constexpr (FP8) { _Pragma("unroll") for (int m = 0; m < 4; ++m) dst##8[m] = PG8_CAT2(PG8_RD16(PG8_SA(b, h) + aoff + m * 2048), PG8_RD16(PG8_SA(b, h) + aoff + m * 2048 + 1024)); } \
        else { _Pragma("unroll") for (int m = 0; m < 4; ++m) _Pragma("unroll") for (int k = 0; k < 2; ++k) dst[m][k] = PG8_RD16(PG8_SA(b, h) + aoff + m * 2048 + k * 1024); } } while (0)
#define PG8_LDB(dst, b, h) do { if constexpr (FP8) { _Pragma("unroll") for (int n = 0; n < 2; ++n) dst##8[n] = PG8_CAT2(PG8_RD16(PG8_SB(b, h) + boff + n * 2048), PG8_RD16(PG8_SB(b, h) + boff + n * 2048 + 1024)); } \
        else { _Pragma("unroll") for (int n = 0; n < 2; ++n) _Pragma("unroll") for (int k = 0; k < 2; ++k) dst[n][k] = PG8_RD16(PG8_SB(b, h) + boff + n * 2048 + k * 1024); } } while (0)
#define PG8_MMA(ai, bj, At, Bt) do { __builtin_amdgcn_s_setprio(1); if constexpr (FP8) { _Pragma("unroll") for (int m = 0; m < 4; ++m) _Pragma("unroll") for (int n = 0; n < 2; ++n) \
        asm volatile("v_mfma_scale_f32_16x16x128_f8f6f4 %0, %1, %2, %0, %3, %3 op_sel_hi:[0,0,0]" : "+v"(acc[ai][bj][m][n]) : "v"(Bt##8[n]), "v"(At##8[m]), "v"(f8scale)); } else { \
        _Pragma("unroll") for (int m = 0; m < 4; ++m) _Pragma("unroll") for (int n = 0; n < 2; ++n) _Pragma("unroll") for (int k = 0; k < 2; ++k) \
        acc[ai][bj][m][n] = __builtin_amdgcn_mfma_f32_16x16x32_bf16(Bt[n][k], At[m][k], acc[ai][bj][m][n], 0, 0, 0); } __builtin_amdgcn_s_setprio(0); } while (0)
#define PG8_WAIT_V(n) asm volatile("s_waitcnt vmcnt(" #n ")" ::: "memory")
#define PG8_WAIT_L(n) asm volatile("s_waitcnt lgkmcnt(" #n ")" ::: "memory")
#define PG8_BAR __builtin_amdgcn_s_barrier()
#define PG8_SCHED __builtin_amdgcn_sched_barrier(0)
    Unit cur, nxt; int ui = 0;
    if (!S.next(0, cur)) return;
    f32x4 acc[2][2][4][2];
#pragma unroll
    for (int a = 0; a < 2; ++a)
#pragma unroll
        for (int b = 0; b < 2; ++b)
#pragma unroll
            for (int m = 0; m < 4; ++m)
#pragma unroll
                for (int n = 0; n < 2; ++n) acc[a][b][m][n] = (f32x4){0.f, 0.f, 0.f, 0.f};
    const int f8scale = 0x7f7f7f7f;
    bf16x8 At[4][2], B0[2][2], B1[2][2]; i32x8 At8[4], B08[2], B18[2];
    const char* cA = (const char*)g.A + (size_t)cur.pm * tstep; const char* cB = (const char*)g.Bt + (size_t)cur.pn * tstep;
    S.a_ready(cur);
    unsigned rowC[2][2], rowN[2][2];
    if constexpr (GATHER) { PG8_ROWS(rowC, 0); _Pragma("unroll") for (int h_ = 0; h_ < 2; ++h_) _Pragma("unroll") for (int i_ = 0; i_ < 2; ++i_) rowN[h_][i_] = rowC[h_][i_]; }
    if constexpr (SP2) {
        PG8_STAGE(PG8_SB(0, 0), cB, voffB); PG8_STAGE(PG8_SB(0, 1), cB + hstep, voffB);
        if constexpr (GATHER) { PG8_STAGE_AG(PG8_SA(0, 0), (size_t)0, rowC, 0); PG8_STAGE_AG(PG8_SA(0, 1), (size_t)0, rowC, 1); } else { PG8_STAGE(PG8_SA(0, 0), cA, voffA); PG8_STAGE(PG8_SA(0, 1), cA + hstep, voffA); }
        if (wr == 1) PG8_BAR;
        PG8_WAIT_V(2); PG8_BAR;
        PG8_STAGE(PG8_SB(1, 0), cB + kstep, voffB); if constexpr (GATHER) PG8_STAGE_AG(PG8_SA(1, 0), kstep, rowC, 0); else PG8_STAGE(PG8_SA(1, 0), cA + kstep, voffA); PG8_STAGE(PG8_SB(1, 1), cB + hstep + kstep, voffB);
        PG8_WAIT_V(6); PG8_BAR;
    } else {
        PG8_STAGE(PG8_SB(0, 0), cB, voffB); PG8_STAGE(PG8_SA(0, 0), cA, voffA); PG8_STAGE(PG8_SB(0, 1), cB + hstep, voffB); PG8_STAGE(PG8_SA(0, 1), cA + hstep, voffA);
        if (wr == 1) PG8_BAR;
        PG8_WAIT_V(4); PG8_BAR;
        PG8_STAGE(PG8_SB(1, 0), cB + kstep, voffB); PG8_STAGE(PG8_SA(1, 0), cA + kstep, voffA); PG8_STAGE(PG8_SB(1, 1), cB + hstep + kstep, voffB);
        PG8_WAIT_V(6); PG8_BAR;
    }
    for (;;) {
        const bool has_next = S.next(ui + 1, nxt);
        if constexpr (GATHER) { if (has_next) PG8_ROWS(rowN, ui + 1); }
        const char* nA = has_next ? (const char*)g.A + (size_t)nxt.pm * tstep : cA; const char* nB = has_next ? (const char*)g.Bt + (size_t)nxt.pn * tstep : cB;
#pragma unroll 1
        for (int t = 0; t < nt; t += 2) {
            const bool last = (t == nt - 2);
            const char* a1 = cA + (size_t)(t + 1) * kstep;
            const char* a2 = last ? nA : cA + (size_t)(t + 2) * kstep; const char* b2 = last ? nB : cB + (size_t)(t + 2) * kstep;
            const char* a3 = a2 + kstep; const char* b3 = b2 + kstep;
            if (last && has_next) S.a_ready(nxt);
            if constexpr (SP2) {
            unsigned rs[2][2]; size_t k2 = 0;
            if constexpr (GATHER) { k2 = last ? (size_t)0 : (size_t)(t + 2) * kstep; _Pragma("unroll") for (int h_ = 0; h_ < 2; ++h_) _Pragma("unroll") for (int i_ = 0; i_ < 2; ++i_) rs[h_][i_] = last ? rowN[h_][i_] : rowC[h_][i_]; }
            PG8_LDB(B0, 0, 0); PG8_LDB(B1, 0, 1); PG8_SCHED; PG8_LDA(At, 0, 0); if constexpr (GATHER) PG8_STAGE_AG(PG8_SA(1, 1), (size_t)(t + 1) * kstep, rowC, 1); else PG8_STAGE(PG8_SA(1, 1), a1 + hstep, voffA);
            PG8_WAIT_V(8); PG8_WAIT_L(0); PG8_BAR; PG8_MMA(0, 0, At, B0); PG8_MMA(0, 1, At, B1); PG8_BAR; PG8_SCHED;
            PG8_LDA(At, 0, 1); PG8_STAGE(PG8_SB(0, 0), b2, voffB); PG8_STAGE(PG8_SB(0, 1), b2 + hstep, voffB); if constexpr (GATHER) PG8_STAGE_AG(PG8_SA(0, 0), k2, rs, 0); else PG8_STAGE(PG8_SA(0, 0), a2, voffA);
            PG8_WAIT_V(8); PG8_WAIT_L(0); PG8_BAR; PG8_MMA(1, 0, At, B0); PG8_MMA(1, 1, At, B1); PG8_BAR; PG8_SCHED;
            PG8_LDB(B0, 1, 0); PG8_LDB(B1, 1, 1); PG8_SCHED; PG8_LDA(At, 1, 0); if constexpr (GATHER) PG8_STAGE_AG(PG8_SA(0, 1), k2, rs, 1); else PG8_STAGE(PG8_SA(0, 1), a2 + hstep, voffA);
            PG8_WAIT_V(8); PG8_WAIT_L(0); PG8_BAR; PG8_MMA(0, 0, At, B0); PG8_MMA(0, 1, At, B1); PG8_BAR; PG8_SCHED;
            PG8_LDA(At, 1, 1); PG8_STAGE(PG8_SB(1, 0), b3, voffB); PG8_STAGE(PG8_SB(1, 1), b3 + hstep, voffB); if constexpr (GATHER) PG8_STAGE_AG(PG8_SA(1, 0), k2 + kstep, rs, 0); else PG8_STAGE(PG8_SA(1, 0), a3, voffA);
            PG8_WAIT_V(8); PG8_WAIT_L(0); PG8_BAR; PG8_MMA(1, 0, At, B0); PG8_MMA(1, 1, At, B1); PG8_BAR; PG8_SCHED;
            } else {
            PG8_LDB(B0, 0, 0); PG8_SCHED; PG8_LDA(At, 0, 0); PG8_STAGE(PG8_SA(1, 1), a1 + hstep, voffA);
            PG8_WAIT_L(8); PG8_BAR; PG8_WAIT_L(0); PG8_MMA(0, 0, At, B0); PG8_BAR; PG8_SCHED;
            PG8_LDB(B1, 0, 1); PG8_STAGE(PG8_SB(0, 0), b2, voffB);
            PG8_BAR; PG8_WAIT_L(0); PG8_MMA(0, 1, At, B1); PG8_BAR;
            PG8_LDA(At, 0, 1); PG8_STAGE(PG8_SA(0, 0), a2, voffA);
            PG8_BAR; PG8_WAIT_L(0); PG8_MMA(1, 0, At, B0); PG8_BAR; PG8_SCHED;
            PG8_STAGE(PG8_SB(0, 1), b2 + hstep, voffB);
            PG8_WAIT_V(6); PG8_BAR; PG8_MMA(1, 1, At, B1); PG8_BAR;
            PG8_LDB(B0, 1, 0); PG8_SCHED; PG8_LDA(At, 1, 0); PG8_STAGE(PG8_SA(0, 1), a2 + hstep, voffA);
            PG8_WAIT_L(8); PG8_BAR; PG8_WAIT_L(0); PG8_MMA(0, 0, At, B0); PG8_BAR; PG8_SCHED;
            PG8_LDB(B1, 1, 1); PG8_STAGE(PG8_SB(1, 0), b3, voffB);
            PG8_BAR; PG8_WAIT_L(0); PG8_MMA(0, 1, At, B1); PG8_BAR;
            PG8_LDA(At, 1, 1); PG8_STAGE(PG8_SA(1, 0), a3, voffA);
            PG8_BAR; PG8_WAIT_L(0); PG8_MMA(1, 0, At, B0); PG8_BAR; PG8_SCHED;
            PG8_STAGE(PG8_SB(1, 1), b3 + hstep, voffB);
            PG8_WAIT_V(6); PG8_BAR; PG8_MMA(1, 1, At, B1); PG8_BAR;
            }
        }
        if constexpr (ALIGN_EPI) { if (wr == 0) PG8_BAR; }
        if constexpr (!Epi::AFTER_DRAIN) { E(acc, cur, wr, wc, fr, fq); S.done(cur); }
        if (!has_next) break;
#pragma unroll
        for (int a = 0; a < 2; ++a)
#pragma unroll
            for (int b = 0; b < 2; ++b)
#pragma unroll
                for (int m = 0; m < 4; ++m)
#pragma unroll
                    for (int n = 0; n < 2; ++n) acc[a][b][m][n] = (f32x4){0.f, 0.f, 0.f, 0.f};
        cur = nxt; cA = nA; cB = nB; ++ui;
        if constexpr (GATHER) { _Pragma("unroll") for (int h_ = 0; h_ < 2; ++h_) _Pragma("unroll") for (int i_ = 0; i_ < 2; ++i_) rowC[h_][i_] = rowN[h_][i_]; }
        if constexpr (ALIGN_EPI) { if (wr == 1) PG8_BAR; }
    }
    PG8_WAIT_V(0);
    if constexpr (!ALIGN_EPI) { if (wr == 0) PG8_BAR; }
    PG8_BAR;
    if constexpr (Epi::AFTER_DRAIN) { E.fused(acc, cur, wr, wc, fr, fq, lds, wid, lane); S.done(cur); }
#undef PG8_SA
#undef PG8_SB
#undef PG8_STAGE
#undef PG8_STAGE_AG
#undef PG8_ROWS
#undef PG8_CAT2
#undef PG8_RD16
#undef PG8_LDA
#undef PG8_LDB
#undef PG8_MMA
#undef PG8_WAIT_V
#undef PG8_WAIT_L
#undef PG8_BAR
#undef PG8_SCHED
}
}

constexpr int NWAVES = 8;
#ifndef MK_N_LAUNCHES
#define MK_N_LAUNCHES 1
#endif
constexpr int PER_PHASE = 10;
constexpr int N_LAUNCHES = MK_N_LAUNCHES;

constexpr int NB = 16, SEQ = 2048, T = NB * SEQ, D = 1024, NIN = 3328, NE = 32, TOPK = 4, DFF = 2048;
constexpr int MAXTILES = T * TOPK / 256 + NE;
constexpr int MAXSLOTS = MAXTILES * 256;
constexpr int NCHUNK = 256, CHUNK_TOK = T / NCHUNK;
constexpr float LN_EPS = 1e-5f, RMS_EPS = 1e-6f, DN_ALPHA = 1.18920711500272f, SWIGLU_LIMIT = 7.0f, SWIGLU_ALPHA = 1.702f;

constexpr size_t MiB = 1u << 20;
constexpr size_t WS_CTL = 0, CTL_ZERO_BYTES = 1 * MiB;
constexpr size_t WS_TAB = 1 * MiB;
constexpr size_t WS_WIN = 2 * MiB, WS_WOUT = 9 * MiB, WS_WUP = 11 * MiB, WS_WD = 139 * MiB;
constexpr size_t WS_H1 = 203 * MiB;
constexpr size_t WS_TOPI = 267 * MiB, WS_TOPG = 268 * MiB, WS_SLOT = 269 * MiB, WS_ROWTOK = 270 * MiB, WS_GATES = 271 * MiB;
constexpr size_t WS_H0 = 272 * MiB, WS_QA = 336 * MiB, WS_KA = 368 * MiB, WS_VA = 376 * MiB, WS_QH = 384 * MiB, WS_IH = 416 * MiB, WS_LF = 448 * MiB, WS_LB = 512 * MiB,
                 WS_ZG = 576 * MiB, WS_OF = 608 * MiB, WS_OB = 672 * MiB, WS_MIX = 736 * MiB, WS_U = 800 * MiB;
constexpr size_t WS_XG = 272 * MiB, WS_ACT = 544 * MiB, WS_Y = 272 * MiB, WS_H1F8 = 680 * MiB, WS_END = 928 * MiB;
constexpr float F8_SA = 16.0f, F8_SWU = 64.0f, F8_SACT = 4.0f, F8_SWD = 64.0f, F8_SY = 64.0f;
constexpr int CW_TMO = 0, CW_CODE = 1, CW_BAR = 4096;

constexpr int RING_OFF = 0, RING_BYTES = 131072;
constexpr int TAB_OFF = 131072;
constexpr int HIST_OFF = 133248;
constexpr int ROWL_OFF = 133376, MAXUNITS_WG = 17;
constexpr int DG_OFF = 142080, MAXDOWN_WG = 9;
constexpr int LDSCTL_OFF = 160512, MISC_OFF = LDSCTL_OFF + 320;
constexpr int LDS_BYTES = 163840;
static_assert(TAB_OFF + MAXTILES * 4 <= HIST_OFF && HIST_OFF + 128 <= ROWL_OFF && ROWL_OFF + MAXUNITS_WG * 512 <= DG_OFF && DG_OFF + MAXDOWN_WG * 2048 <= LDSCTL_OFF && MISC_OFF + 128 <= LDS_BYTES, "LDS map");
#define GAS __attribute__((address_space(1)))
#define LAS __attribute__((address_space(3)))
typedef unsigned short bf16;
typedef unsigned v4u __attribute__((ext_vector_type(4)));
typedef float f32x4 __attribute__((ext_vector_type(4)));
typedef short bf16x8 __attribute__((ext_vector_type(8)));
typedef GAS unsigned gu32;
typedef GAS unsigned long long gu64;
#define RLX_AGENT __ATOMIC_RELAXED, __HIP_MEMORY_SCOPE_AGENT
#define LDS_WAIT() asm volatile("s_waitcnt lgkmcnt(0)" ::: "memory")
#define VM_WAIT() asm volatile("s_waitcnt vmcnt(0)" ::: "memory")
__device__ __forceinline__ unsigned long long rt() { return __builtin_amdgcn_s_memrealtime(); }
__device__ __forceinline__ unsigned f2bf(float f) { unsigned u = __builtin_bit_cast(unsigned, f); return (u + 0x7fffu + ((u >> 16) & 1u)) >> 16; }
__device__ __forceinline__ unsigned pk2(float lo, float hi) { return f2bf(lo) | (f2bf(hi) << 16); }
#define XB_TMO      128
#define XB_XCNT(j)  (256  + 64 * (j))
#define XB_XSUB(j)  (1280 + 64 * (j))
#define XB_XGEN(j)  (2304 + 64 * (j))
#define XB_TOP      3328
#define XB_TOPGEN   3392
#define XCD_BAR_WORDS 3456
#define XB_SPIN_CAP (1u << 18)

__device__ __forceinline__ unsigned xb_ld(unsigned* p)              { return __hip_atomic_load(p, __ATOMIC_RELAXED, __HIP_MEMORY_SCOPE_AGENT); }
__device__ __forceinline__ unsigned xb_add(unsigned* p, unsigned v) { return __hip_atomic_fetch_add(p, v, __ATOMIC_RELAXED, __HIP_MEMORY_SCOPE_AGENT); }
__device__ __forceinline__ unsigned xb_xcc_id() { return (unsigned)__builtin_amdgcn_s_getreg((3 << 11) | 20) & 0xFu; }
#define XB_SPIN(cond, bar) do { unsigned _sp = 0; while (cond) { __builtin_amdgcn_s_sleep(1); \
    if ((++_sp & 255u) == 0u) { if (xb_ld(&(bar)[XB_TMO])) break; if (_sp > XB_SPIN_CAP) { atomicAdd(&(bar)[XB_TMO], 1u); break; } } } } while (0)

struct XcdBarrier {
    unsigned* bar; unsigned x;
    volatile LAS unsigned* st;
};

__device__ __forceinline__ XcdBarrier xcd_barrier_post(unsigned* bar, volatile LAS unsigned* st) {
    XcdBarrier b; b.bar = bar; b.x = xb_xcc_id(); b.st = st;
    if (threadIdx.x == 0) (void)xb_add(&bar[XB_XCNT(b.x)], 1u);
    return b;
}
__device__ __forceinline__ void xcd_barrier_complete(unsigned* bar, unsigned x, unsigned& nloc, unsigned& nx) {
    const unsigned G = gridDim.x * gridDim.y * gridDim.z;
    unsigned sum, cnt, mine, sp = 0u;
    for (;;) {
        sum = 0u; cnt = 0u; mine = 0u;
#pragma unroll
        for (unsigned j = 0; j < 16; ++j) { const unsigned c = xb_ld(&bar[XB_XCNT(j)]); sum += c; cnt += (c > 0u) ? 1u : 0u; mine = (j == x) ? c : mine; }
        if (sum == G) break;
        __builtin_amdgcn_s_sleep(1);
        if ((++sp & 255u) == 0u) { if (xb_ld(&bar[XB_TMO])) break; if (sp > XB_SPIN_CAP) { atomicAdd(&bar[XB_TMO], 1u); break; } }
    }
    nloc = mine > 0u ? mine : 1u; nx = cnt > 0u ? cnt : 1u;
}

__device__ __forceinline__ void xcd_barrier(const XcdBarrier& b) {
    asm volatile("s_waitcnt vmcnt(0)" ::: "memory");
    __syncthreads();
    if (threadIdx.x == 0) {
        unsigned* bar = b.bar;
        __builtin_amdgcn_s_waitcnt(0);
        unsigned nloc = b.st[0], nx = b.st[1];
        if (nloc == 0u) { xcd_barrier_complete(bar, b.x, nloc, nx); b.st[0] = nloc; b.st[1] = nx; }
        const unsigned old = xb_add(&bar[XB_XSUB(b.x)], 1u);
        const unsigned gen = old / nloc;
        if (old + 1u == (gen + 1u) * nloc) {
            __builtin_amdgcn_fence(__ATOMIC_RELEASE, "agent");
            asm volatile("s_waitcnt vmcnt(0)" ::: "memory");
            const unsigned og = xb_add(&bar[XB_TOP], 1u);
            const unsigned tg = og / nx;
            if (og + 1u == (tg + 1u) * nx) xb_add(&bar[XB_TOPGEN], 1u);
            else XB_SPIN(xb_ld(&bar[XB_TOPGEN]) == tg, bar);
            __builtin_amdgcn_fence(__ATOMIC_ACQUIRE, "agent");
            xb_add(&bar[XB_XGEN(b.x)], 1u);
            asm volatile("s_waitcnt vmcnt(0)" ::: "memory");
        } else {
            XB_SPIN(xb_ld(&bar[XB_XGEN(b.x)]) == gen, bar);
            __builtin_amdgcn_fence(__ATOMIC_ACQUIRE, "agent");
            asm volatile("s_waitcnt vmcnt(0)" ::: "memory");
        }
    }
    __syncthreads();
}

typedef unsigned u32x2 __attribute__((ext_vector_type(2)));
typedef float f32x2_t __attribute__((ext_vector_type(2)));
typedef __bf16 bf16x2_t __attribute__((ext_vector_type(2)));
__device__ __forceinline__ float bflo(unsigned w) { return __uint_as_float(w << 16); }
__device__ __forceinline__ float bfhi(unsigned w) { return __uint_as_float(w & 0xffff0000u); }
__device__ __forceinline__ float fsigmoid(float z) { return __builtin_amdgcn_rcpf(1.0f + __expf(-z)); }
__device__ __forceinline__ v4u pack8(const f32x4 a, const f32x4 b) { v4u w; w.x = pg8::cvt_pk_bf16(a[0], a[1]); w.y = pg8::cvt_pk_bf16(a[2], a[3]); w.z = pg8::cvt_pk_bf16(b[0], b[1]); w.w = pg8::cvt_pk_bf16(b[2], b[3]); return w; }
__device__ __forceinline__ float clamp448(float x) { return __builtin_amdgcn_fmed3f(x, -448.0f, 448.0f); }
__device__ __forceinline__ unsigned pk4_fp8(float a, float b, float c, float d) { int w = __builtin_amdgcn_cvt_pk_fp8_f32(clamp448(a), clamp448(b), 0, false); w = __builtin_amdgcn_cvt_pk_fp8_f32(clamp448(c), clamp448(d), w, true); return (unsigned)w; }
__device__ __forceinline__ unsigned pk4_fp8_nc(float a, float b, float c, float d) { int w = __builtin_amdgcn_cvt_pk_fp8_f32(a, b, 0, false); w = __builtin_amdgcn_cvt_pk_fp8_f32(c, d, w, true); return (unsigned)w; }
__device__ __forceinline__ float wave_sum(float v) {
#pragma unroll
    for (int o = 1; o < 64; o <<= 1) v += __shfl_xor(v, o);
    return v;
}

struct EpiInProj {
    static constexpr bool PERM = true, AFTER_DRAIN = false;
    bf16 *QA, *KA, *VA, *QH, *IH, *ZG; float *LF, *LB; const float *lbl, *normg;
    __device__ __forceinline__ void operator()(const f32x4 (&acc)[2][2][4][2], const pg8::Unit& u, int wr, int wc, int fr, int fq) const {
        const int row0 = u.pm * 256 + wr * 64 + fr, cl = wc * 32 + 8 * fq, pn = u.pn;
        if (pn == 2) {
#pragma unroll
            for (int ai = 0; ai < 2; ++ai)
#pragma unroll
                for (int m = 0; m < 4; ++m) { const size_t r = (size_t)(row0 + ai * 128 + m * 16);
                    *(v4u*)(KA + r * 128 + cl) = pack8(acc[ai][0][m][0], acc[ai][0][m][1]);
                    *(v4u*)(VA + r * 128 + cl) = pack8(acc[ai][1][m][0], acc[ai][1][m][1]); }
        } else if (pn < 7) {
            bf16* base = pn < 2 ? QA + pn * 256 : (pn < 5 ? QH + (pn - 3) * 256 : IH + (pn - 5) * 256);
            const float qs = pn < 2 ? 0.125f * 1.4426950408889634f : 1.0f;
#pragma unroll
            for (int ai = 0; ai < 2; ++ai)
#pragma unroll
                for (int m = 0; m < 4; ++m) { bf16* rowp = base + (size_t)(row0 + ai * 128 + m * 16) * 512 + cl;
#pragma unroll
                    for (int bj = 0; bj < 2; ++bj) *(v4u*)(rowp + bj * 128) = pack8(acc[ai][bj][m][0] * qs, acc[ai][bj][m][1] * qs); }
        } else if (pn < 11) {
            const int dir = pn >= 9 ? 1 : 0, cb = (pn - (dir ? 9 : 7)) * 256; float* base = (dir ? LB : LF) + cb;
#pragma unroll
            for (int bj = 0; bj < 2; ++bj) {
                float lb[8];
#pragma unroll
                for (int j = 0; j < 8; ++j) { const int col = cb + bj * 128 + cl + j; const float a0 = lbl[dir * 1024 + col], a1 = lbl[dir * 1024 + 512 + col]; lb[j] = 1.0f / (1.0f + __expf(a1 - a0)); }
#pragma unroll
                for (int ai = 0; ai < 2; ++ai)
#pragma unroll
                    for (int m = 0; m < 4; ++m) { float* rowp = base + (size_t)(row0 + ai * 128 + m * 16) * 512 + bj * 128 + cl;
                        f32x4 o0, o1, z0 = acc[ai][bj][m][0], z1 = acc[ai][bj][m][1];
                        asm volatile("" : "+v"(z0), "+v"(z1) :: "memory");
#pragma unroll
                        for (int j = 0; j < 4; ++j) { o0[j] = __logf(lb[j] + (1.0f - lb[j]) * fsigmoid(z0[j])); o1[j] = __logf(lb[4 + j] + (1.0f - lb[4 + j]) * fsigmoid(z1[j])); }
                        *(f32x4*)rowp = o0; *(f32x4*)(rowp + 4) = o1; }
            }
        } else {
            const int cb = (pn - 11) * 256;
#pragma unroll
            for (int bj = 0; bj < 2; ++bj) {
                const f32x4 g0 = *(const f32x4*)(normg + cb + bj * 128 + cl), g1 = *(const f32x4*)(normg + cb + bj * 128 + cl + 4);
#pragma unroll
                for (int ai = 0; ai < 2; ++ai)
#pragma unroll
                    for (int m = 0; m < 4; ++m) { bf16* rowp = ZG + (size_t)(row0 + ai * 128 + m * 16) * 512 + cb + bj * 128 + cl;
                        f32x4 o0, o1, y0 = acc[ai][bj][m][0], y1 = acc[ai][bj][m][1];
                        asm volatile("" : "+v"(y0), "+v"(y1) :: "memory");
#pragma unroll
                        for (int j = 0; j < 4; ++j) { const float z0 = y0[j], z1 = y1[j]; o0[j] = g0[j] * z0 * fsigmoid(z0); o1[j] = g1[j] * z1 * fsigmoid(z1); }
                        *(v4u*)rowp = pack8(o0, o1); }
            }
        }
    }
};
struct EpiOutProj {
    static constexpr bool PERM = true, AFTER_DRAIN = false;
    const bf16* H0; bf16* U;
    __device__ __forceinline__ void operator()(const f32x4 (&acc)[2][2][4][2], const pg8::Unit& u, int wr, int wc, int fr, int fq) const {
        const int row0 = u.pm * 256 + wr * 64 + fr, col0 = u.pn * 256 + wc * 32 + 8 * fq;
#pragma unroll
        for (int ai = 0; ai < 2; ++ai)
#pragma unroll
            for (int m = 0; m < 4; ++m) { const size_t off = (size_t)(row0 + ai * 128 + m * 16) * D + col0;
#pragma unroll
                for (int bj = 0; bj < 2; ++bj) { const v4u hb = *(const v4u*)(H0 + off + bj * 128);
                    f32x4 h0, h1; h0[0] = bflo(hb.x); h0[1] = bfhi(hb.x); h0[2] = bflo(hb.y); h0[3] = bfhi(hb.y); h1[0] = bflo(hb.z); h1[1] = bfhi(hb.z); h1[2] = bflo(hb.w); h1[3] = bfhi(hb.w);
                    *(v4u*)(U + off + bj * 128) = pack8(acc[ai][bj][m][0] + DN_ALPHA * h0, acc[ai][bj][m][1] + DN_ALPHA * h1); } }
    }
};
struct EpiUp {
    static constexpr bool PERM = false, AFTER_DRAIN = false;
    unsigned char* ACT; const float* b_up;
    __device__ __forceinline__ void operator()(const f32x4 (&acc)[2][2][4][2], const pg8::Unit& u, int wr, int wc, int fr, int fq) const {
        const int e = u.pn >> 3, p = u.pn & 7, row0 = u.pm * 256 + wr * 64 + fr, a0 = 128 * p + 32 * wc + 8 * fq;
        f32x4 bg[2], bl[2];
#pragma unroll
        for (int bj = 0; bj < 2; ++bj) { const f32x4 x = *(const f32x4*)(b_up + e * DFF + 2 * (a0 + 4 * bj)), y = *(const f32x4*)(b_up + e * DFF + 2 * (a0 + 4 * bj) + 4);
            bg[bj] = (f32x4){x[0], x[2], y[0], y[2]}; bl[bj] = (f32x4){x[1], x[3], y[1], y[3]}; }
#pragma unroll
        for (int ai = 0; ai < 2; ++ai)
#pragma unroll
            for (int m = 0; m < 4; ++m) { f32x4 o[2], zg[2] = {acc[ai][0][m][0], acc[ai][1][m][0]}, zl[2] = {acc[ai][0][m][1], acc[ai][1][m][1]};
                asm volatile("" : "+v"(zg[0]), "+v"(zg[1]), "+v"(zl[0]), "+v"(zl[1]) :: "memory");
#pragma unroll
                for (int bj = 0; bj < 2; ++bj)
#pragma unroll
                    for (int j = 0; j < 4; j += 2) {
                        constexpr float SC = 1.0f / (F8_SA * F8_SWU), NE2 = -SWIGLU_ALPHA * 1.4426950408889634f;
                        f32x2_t g2 = (f32x2_t){zg[bj][j], zg[bj][j + 1]} * SC + (f32x2_t){bg[bj][j], bg[bj][j + 1]}; g2[0] = fminf(g2[0], SWIGLU_LIMIT); g2[1] = fminf(g2[1], SWIGLU_LIMIT);
                        f32x2_t l2 = (f32x2_t){zl[bj][j], zl[bj][j + 1]} * SC + (f32x2_t){bl[bj][j], bl[bj][j + 1]}; l2[0] = __builtin_amdgcn_fmed3f(l2[0], -SWIGLU_LIMIT, SWIGLU_LIMIT); l2[1] = __builtin_amdgcn_fmed3f(l2[1], -SWIGLU_LIMIT, SWIGLU_LIMIT);
                        f32x2_t e2 = g2 * NE2; e2[0] = __builtin_amdgcn_exp2f(e2[0]); e2[1] = __builtin_amdgcn_exp2f(e2[1]); e2 = e2 + 1.0f;
                        f32x2_t r2; r2[0] = __builtin_amdgcn_rcpf(e2[0]); r2[1] = __builtin_amdgcn_rcpf(e2[1]);
                        const f32x2_t o2 = (g2 * r2) * (l2 * F8_SACT + F8_SACT);
                        o[bj][j] = o2[0]; o[bj][j + 1] = o2[1]; }
                u32x2 pw; pw.x = pk4_fp8_nc(o[0][0], o[0][1], o[0][2], o[0][3]); pw.y = pk4_fp8_nc(o[1][0], o[1][1], o[1][2], o[1][3]);
                *(u32x2*)(ACT + (size_t)(row0 + ai * 128 + m * 16) * D + a0) = pw; }
    }
};
struct EpiDown {
    static constexpr bool PERM = false, AFTER_DRAIN = false;
    unsigned char* Y; const LAS u32x2* dg; const float* b_down;
    __device__ __forceinline__ void operator()(const f32x4 (&acc)[2][2][4][2], const pg8::Unit& u, int wr, int wc, int fr, int fq) const {
        const int e = u.pn >> 2, colt = (u.pn & 3) * 256 + wc * 64 + 16 * fq, r0 = u.ord * 256 + wr * 64 + fr;
        int dest[2][4]; float gt[2][4];
#pragma unroll
        for (int ai = 0; ai < 2; ++ai)
#pragma unroll
            for (int m = 0; m < 4; ++m) { const u32x2 t = dg[r0 + ai * 128 + m * 16]; dest[ai][m] = (int)t.x; gt[ai][m] = __uint_as_float(t.y); }
        f32x4 bv[2][2];
#pragma unroll
        for (int bj = 0; bj < 2; ++bj)
#pragma unroll
            for (int n = 0; n < 2; ++n) bv[bj][n] = *(const f32x4*)(b_down + e * D + colt + 8 * bj + 4 * n);
#pragma unroll
        for (int ai = 0; ai < 2; ++ai)
#pragma unroll
            for (int m = 0; m < 4; ++m) { const float g = gt[ai][m];
                if (dest[ai][m] >= 0) { v4u pw; unsigned pq[4];
#pragma unroll
                    for (int bj = 0; bj < 2; ++bj)
#pragma unroll
                        for (int n = 0; n < 2; ++n) { const f32x4 y = (acc[ai][bj][m][n] * (1.0f / (F8_SACT * F8_SWD)) + bv[bj][n]) * g; pq[2 * bj + n] = pk4_fp8(y[0], y[1], y[2], y[3]); }
                    pw.x = pq[0]; pw.y = pq[1]; pw.z = pq[2]; pw.w = pq[3];
                    *(v4u*)(Y + (size_t)dest[ai][m] * D + colt) = pw; } }
    }
};
struct EpiNull { static constexpr bool PERM = false, AFTER_DRAIN = false; int* sink;
    __device__ __forceinline__ void operator()(const f32x4 (&acc)[2][2][4][2], const pg8::Unit& u, int wr, int wc, int fr, int fq) const { if (acc[0][0][0][0][0] == 1.2345e-33f) sink[0] = 1; } };
__device__ __forceinline__ int moe_tile(int i, int c, int nN) { const int slot = c >> 3, g = i * 8 + (c & 7); return nN == 8 ? g * 4 + (slot >> 3) : g * 8 + (slot >> 2); }
struct MoeOrder {
    const LAS int* tileExpert; int ntiles, nN, G, c;
    __device__ __forceinline__ bool next(int i, pg8::Unit& u) const {
        int tile, n;
        if (G == 256) { tile = moe_tile(i, c, nN); n = (c >> 3) & (nN - 1); }
        else { const int L = i * G + c; tile = L / nN; n = L - tile * nN; }
        if (tile >= ntiles) return false;
        u.pm = tile; u.pn = tileExpert[tile] * nN + n; u.ord = i; return true;
    }
    __device__ __forceinline__ void a_ready(const pg8::Unit&) const {}
    __device__ __forceinline__ void done(const pg8::Unit&) const {}
};

struct Frame {
    LAS unsigned char* lds;
    volatile LAS unsigned* MISC;
    gu32* ctl;
    int tid, lane, wave;
    int vcu, G;
    const __attribute__((address_space(4))) unsigned char* ka;
    float* out; unsigned char* ws;
};
#define FIN(F_, k_) (*(const float* const __attribute__((address_space(4)))*)((F_).ka + 8 * (k_)))

__device__ __forceinline__ int up_srccol(int dn) { const int p = dn >> 8, rho = dn & 255, bj = rho >> 7, wc = (rho >> 5) & 3, n = (rho >> 4) & 1, fq = (rho >> 2) & 3, j = rho & 3;
    return 2 * (128 * p + 32 * wc + 8 * fq + 4 * bj + j) + n; }
template <bool UPPERM>
__device__ __forceinline__ void p0_transpose_item(const float* W, int K, int N, bf16* WT, LAS float* scr, int item, int lane) {
    const int nblk = N / 32, kb = item / nblk, nb = item % nblk, k0 = 64 * kb, n0 = 32 * nb;
    const int sc = UPPERM ? up_srccol(n0 + (lane & 31)) : n0 + (lane & 31);
#pragma unroll 8
    for (int i = 0; i < 32; ++i) { const int kk = 2 * i + (lane >> 5); scr[kk * 33 + (lane & 31)] = W[(size_t)(k0 + kk) * N + sc]; }
    LDS_WAIT(); asm volatile("" ::: "memory");
    const int c = lane & 7;
#pragma unroll
    for (int j = 0; j < 4; ++j) { const int n = (lane >> 3) + 8 * j; const LAS float* s = scr + (8 * c) * 33 + n;
        v4u o; o.x = pk2(s[0 * 33], s[1 * 33]); o.y = pk2(s[2 * 33], s[3 * 33]); o.z = pk2(s[4 * 33], s[5 * 33]); o.w = pk2(s[6 * 33], s[7 * 33]);
        *(GAS v4u*)(WT + (size_t)(n0 + n) * K + k0 + 8 * c) = o; }
    LDS_WAIT(); asm volatile("" ::: "memory");
}
template <bool UPPERM>
__device__ __forceinline__ void p0_transpose_item_f8(const float* W, int K, int N, unsigned char* WT, LAS float* scr, int item, int lane, float scale) {
    const int nblk = N / 32, kb = item / nblk, nb = item % nblk, k0 = 64 * kb, n0 = 32 * nb;
    const int sc = UPPERM ? up_srccol(n0 + (lane & 31)) : n0 + (lane & 31);
#pragma unroll 8
    for (int i = 0; i < 32; ++i) { const int kk = 2 * i + (lane >> 5); scr[kk * 33 + (lane & 31)] = W[(size_t)(k0 + kk) * N + sc]; }
    LDS_WAIT(); asm volatile("" ::: "memory");
    const int n = lane >> 1, hf = lane & 1; const LAS float* s = scr + (32 * hf) * 33 + n;
    unsigned o[8];
#pragma unroll
    for (int q = 0; q < 8; ++q) o[q] = pk4_fp8(s[(4 * q) * 33] * scale, s[(4 * q + 1) * 33] * scale, s[(4 * q + 2) * 33] * scale, s[(4 * q + 3) * 33] * scale);
    GAS v4u* dst = (GAS v4u*)(WT + (size_t)(n0 + n) * K + k0 + 32 * hf);
    dst[0] = (v4u){o[0], o[1], o[2], o[3]}; dst[1] = (v4u){o[4], o[5], o[6], o[7]};
    LDS_WAIT(); asm volatile("" ::: "memory");
}
__device__ __forceinline__ int up_dstrow(int sc) { const int n = sc & 1, a = sc >> 1, p = a >> 7, al = a & 127, wc = al >> 5, fq = (al >> 3) & 3, bj = (al >> 2) & 1, j = al & 3;
    return 256 * p + 128 * bj + 32 * wc + 16 * n + 4 * fq + j; }
__device__ __forceinline__ int down_dstrow(int sc) { const int c = sc & 255, wc = c >> 6, fq = (c >> 4) & 3, bj = (c >> 3) & 1, n = (c >> 2) & 1, rg = c & 3; return (sc & ~255) + 128 * bj + 32 * wc + 16 * n + 4 * fq + rg; }
constexpr int CV_UP1 = (D / 128) * (DFF / 16), CV_DN1 = (D / 128) * (D / 16), CV_NUP = NE * CV_UP1, CV_NITEMS = CV_NUP + NE * CV_DN1;
__device__ __forceinline__ void cv_load(const Frame& F, int it, f32x4 (&v)[8]) {
    static_assert(CV_UP1 == 1024 && CV_DN1 == 512 && DFF == 2048 && D == 1024, "shift decomposition below");
    const bool up = it < CV_NUP; const int r = up ? it : it - CV_NUP, sh = up ? 10 : 9, N = up ? DFF : D, e = r >> sh, item = r & ((1 << sh) - 1);
    const float* W = (up ? FIN(F, 12) : FIN(F, 14)) + (size_t)e * D * N;
    const int kb0 = item >> (sh - 3), nb = item & ((1 << (sh - 3)) - 1), k0 = 128 * kb0 + 8 * (F.lane >> 2), n0 = 16 * nb + 4 * (F.lane & 3);
#pragma unroll
    for (int i = 0; i < 8; ++i) v[i] = *(const GAS f32x4*)(W + (size_t)(k0 + i) * N + n0);
}
__device__ __forceinline__ void cv_store(const Frame& F, int it, const f32x4 (&v)[8]) {
    const bool up = it < CV_NUP; const int r = up ? it : it - CV_NUP, sh = up ? 10 : 9, N = up ? DFF : D, e = r >> sh, item = r & ((1 << sh) - 1);
    unsigned char* WT = F.ws + (up ? WS_WUP : WS_WD) + (size_t)e * N * D; const float scale = up ? F8_SWU : F8_SWD;
    const int kb0 = item >> (sh - 3), nb = item & ((1 << (sh - 3)) - 1), k0 = 128 * kb0 + 8 * (F.lane >> 2), n0 = 16 * nb + 4 * (F.lane & 3);
#pragma unroll
    for (int j = 0; j < 4; ++j) { const int dn = up ? up_dstrow(n0 + j) : down_dstrow(n0 + j);
        u32x2 o; o.x = pk4_fp8(v[0][j] * scale, v[1][j] * scale, v[2][j] * scale, v[3][j] * scale); o.y = pk4_fp8(v[4][j] * scale, v[5][j] * scale, v[6][j] * scale, v[7][j] * scale);
        *(GAS u32x2*)(WT + (size_t)dn * D + k0) = o; }
}
__device__ __forceinline__ void p0_prologue(Frame& F) {
    LAS float* scr = (LAS float*)(F.lds + RING_OFF + F.wave * 16384);
    const int gw = F.vcu * NWAVES + F.wave, NGW = F.G * NWAVES;
    constexpr int I_IN = (D / 64) * (NIN / 32), I_OUT = (D / 64) * (D / 32);
    bf16* WinT = (bf16*)(F.ws + WS_WIN); bf16* WoutT = (bf16*)(F.ws + WS_WOUT); unsigned char* WupT = (unsigned char*)(F.ws + WS_WUP); unsigned char* WdT = (unsigned char*)(F.ws + WS_WD);
    for (int it = gw; it < I_IN + I_OUT; it += NGW) {
        if (it < I_IN) p0_transpose_item<false>(FIN(F, 3), D, NIN, WinT, scr, it, F.lane); else p0_transpose_item<false>(FIN(F, 7), D, D, WoutT, scr, it - I_IN, F.lane);
    }
    (void)WupT; (void)WdT;
    const float* x = FIN(F, 0); bf16* H0 = (bf16*)(F.ws + WS_H0);
    f32x4 gg[4], bb[4];
#pragma unroll
    for (int j = 0; j < 4; ++j) { gg[j] = ((const f32x4*)FIN(F, 1))[F.lane + 64 * j]; bb[j] = ((const f32x4*)FIN(F, 2))[F.lane + 64 * j]; }
    for (int m = gw; m < T; m += NGW) {
        const GAS f32x4* xr = (const GAS f32x4*)(x + (size_t)m * D) + F.lane;
        f32x4 v[4]; float s = 0.f;
#pragma unroll
        for (int j = 0; j < 4; ++j) { v[j] = xr[64 * j]; s += (v[j].x + v[j].y) + (v[j].z + v[j].w); }
        const float mean = wave_sum(s) * (1.f / D); float s2 = 0.f;
#pragma unroll
        for (int j = 0; j < 4; ++j) { v[j] = v[j] - mean; s2 += (v[j].x * v[j].x + v[j].y * v[j].y) + (v[j].z * v[j].z + v[j].w * v[j].w); }
        const float rstd = 1.f / sqrtf(wave_sum(s2) * (1.f / D) + LN_EPS);
        GAS u32x2* o8 = (GAS u32x2*)(H0 + (size_t)m * D) + F.lane;
#pragma unroll
        for (int j = 0; j < 4; ++j) { const f32x4 y = v[j] * rstd * gg[j] + bb[j]; u32x2 w; w.x = pg8::cvt_pk_bf16(y[0], y[1]); w.y = pg8::cvt_pk_bf16(y[2], y[3]); o8[64 * j] = w; }
    }
}

__device__ __forceinline__ void p2_attn_simple(Frame& F) {
    const bf16* QA = (const bf16*)(F.ws + WS_QA); const bf16* KA = (const bf16*)(F.ws + WS_KA); const bf16* VA = (const bf16*)(F.ws + WS_VA); bf16* MIX = (bf16*)(F.ws + WS_MIX);
    const float* sink = FIN(F, 4);
    const int gw = F.vcu * NWAVES + F.wave, NGW = F.G * NWAVES;
    for (int task = gw; task < NB * 8 * (SEQ / 64); task += NGW) {
        const int qb = task & 31, hq = (task >> 5) & 7, b = task >> 8, g = hq >> 2;
        const int t = qb * 64 + F.lane; const size_t row = (size_t)b * SEQ + t;
        float q[64], o[64];
        { const v4u* qp = (const v4u*)(QA + row * 512 + hq * 64);
#pragma unroll
          for (int i = 0; i < 8; ++i) { const v4u w = qp[i]; q[8 * i] = bflo(w.x); q[8 * i + 1] = bfhi(w.x); q[8 * i + 2] = bflo(w.y); q[8 * i + 3] = bfhi(w.y); q[8 * i + 4] = bflo(w.z); q[8 * i + 5] = bfhi(w.z); q[8 * i + 6] = bflo(w.w); q[8 * i + 7] = bfhi(w.w); } }
#pragma unroll
        for (int i = 0; i < 64; ++i) o[i] = 0.f;
        float m = sink[hq], l = 1.0f; const float slope = exp2f(-(float)(hq + 1));
        const int lo = (qb * 64 - 128) < 0 ? 0 : qb * 64 - 128, hi = (qb * 64 + 63 + 128) > SEQ - 1 ? SEQ - 1 : qb * 64 + 63 + 128;
        for (int s = lo; s <= hi; ++s) {
            const v4u* kp = (const v4u*)(KA + ((size_t)b * SEQ + s) * 128 + g * 64); const v4u* vp = (const v4u*)(VA + ((size_t)b * SEQ + s) * 128 + g * 64);
            float dot = 0.f;
#pragma unroll
            for (int i = 0; i < 8; ++i) { const v4u w = kp[i]; dot += q[8 * i] * bflo(w.x) + q[8 * i + 1] * bfhi(w.x) + q[8 * i + 2] * bflo(w.y) + q[8 * i + 3] * bfhi(w.y) + q[8 * i + 4] * bflo(w.z) + q[8 * i + 5] * bfhi(w.z) + q[8 * i + 6] * bflo(w.w) + q[8 * i + 7] * bfhi(w.w); }
            const int dist = t > s ? t - s : s - t; const bool valid = dist <= 128;
            const float sc = dot * 0.125f - slope * (float)dist;
            const float mn = valid ? fmaxf(m, sc) : m; const float a = __expf(m - mn), p = valid ? __expf(sc - mn) : 0.f;
            l = l * a + p; m = mn;
#pragma unroll
            for (int i = 0; i < 8; ++i) { const v4u w = vp[i];
                o[8 * i] = o[8 * i] * a + p * bflo(w.x); o[8 * i + 1] = o[8 * i + 1] * a + p * bfhi(w.x); o[8 * i + 2] = o[8 * i + 2] * a + p * bflo(w.y); o[8 * i + 3] = o[8 * i + 3] * a + p * bfhi(w.y);
                o[8 * i + 4] = o[8 * i + 4] * a + p * bflo(w.z); o[8 * i + 5] = o[8 * i + 5] * a + p * bfhi(w.z); o[8 * i + 6] = o[8 * i + 6] * a + p * bflo(w.w); o[8 * i + 7] = o[8 * i + 7] * a + p * bfhi(w.w); }
        }
        const float inv = 1.0f / l; v4u* op = (v4u*)(MIX + row * D + hq * 64);
#pragma unroll
        for (int i = 0; i < 8; ++i) { v4u w; w.x = pg8::cvt_pk_bf16(o[8 * i] * inv, o[8 * i + 1] * inv); w.y = pg8::cvt_pk_bf16(o[8 * i + 2] * inv, o[8 * i + 3] * inv); w.z = pg8::cvt_pk_bf16(o[8 * i + 4] * inv, o[8 * i + 5] * inv); w.w = pg8::cvt_pk_bf16(o[8 * i + 6] * inv, o[8 * i + 7] * inv); op[i] = w; }
    }
}

typedef float f32x16 __attribute__((ext_vector_type(16)));
typedef short s16x4 __attribute__((ext_vector_type(4)));
__device__ __forceinline__ unsigned cvtpk_s(float lo, float hi) { f32x2_t v = {lo, hi}; bf16x2_t b = __builtin_convertvector(v, bf16x2_t); return __builtin_bit_cast(unsigned, b); }
#define MFMA32(a, b, c) __builtin_amdgcn_mfma_f32_32x32x16_bf16((a), (b), (c), 0, 0, 0)
constexpr int AK_PITCH = 144, AV_PITCH = 776, AV_OFF = 384 * AK_PITCH;
static_assert(AV_OFF + 64 * AV_PITCH <= RING_BYTES, "attention LDS");
__device__ __forceinline__ void p2_attn(Frame& F) {
    const bf16* QA = (const bf16*)(F.ws + WS_QA); const bf16* KA = (const bf16*)(F.ws + WS_KA); const bf16* VA = (const bf16*)(F.ws + WS_VA); bf16* MIX = (bf16*)(F.ws + WS_MIX);
    const float* sink = FIN(F, 4);
    LAS unsigned char* Ks = F.lds + RING_OFF; LAS unsigned char* Vt = Ks + AV_OFF;
    const int r = F.lane & 31, h = F.lane >> 5;
    constexpr float LOG2E = 1.4426950408889634f;
    v4u kreg[6], vreg[6];
#define AT_LOADKV(unit_) do { const int n_ = (unit_) & 15, g_ = ((unit_) >> 4) & 1, b_ = (unit_) >> 5, kb_ = n_ * 128 - 128; \
        _Pragma("unroll") for (int i = 0; i < 6; ++i) { const int c = F.tid + 512 * i, row = c >> 3, ch = c & 7; int pos = kb_ + row; pos = pos < 0 ? 0 : (pos >= SEQ ? SEQ - 1 : pos); \
            kreg[i] = *(const v4u*)(KA + ((size_t)b_ * SEQ + pos) * 128 + g_ * 64 + ch * 8); } \
        _Pragma("unroll") for (int i = 0; i < 3; ++i) { const int it = F.tid + 512 * i, kp = it % 192, ch = it / 192; int pos = kb_ + 2 * kp; pos = pos < 0 ? 0 : (pos >= SEQ ? SEQ - 2 : pos); \
            const bf16* vp = VA + ((size_t)b_ * SEQ + pos) * 128 + g_ * 64 + ch * 8; vreg[2 * i] = *(const v4u*)vp; vreg[2 * i + 1] = *(const v4u*)(vp + 128); } } while (0)
    if (F.vcu < NB * 2 * 16) AT_LOADKV(F.vcu);
    for (int unit = F.vcu; unit < NB * 2 * 16; unit += F.G) {
        const int n = unit & 15, g = (unit >> 4) & 1, b = unit >> 5, kbase = n * 128 - 128;
        const int head = g * 4 + (F.wave >> 1), qw0 = n * 128 + (F.wave & 1) * 64;
        pg8::bf16x8 qf[2][4];
#pragma unroll
        for (int qb = 0; qb < 2; ++qb) { const bf16* qp = QA + ((size_t)b * SEQ + qw0 + qb * 32 + r) * 512 + head * 64 + 8 * h;
#pragma unroll
            for (int ds = 0; ds < 4; ++ds) qf[qb][ds] = *(const pg8::bf16x8*)(qp + 16 * ds); }
        __syncthreads();
#pragma unroll
        for (int i = 0; i < 6; ++i) { const int c = F.tid + 512 * i, row = c >> 3, ch = c & 7; *(LAS v4u*)(Ks + row * AK_PITCH + ch * 16) = kreg[i]; }
#pragma unroll
        for (int i = 0; i < 3; ++i) { const int it = F.tid + 512 * i, kp = it % 192, ch = it / 192; const v4u w0 = vreg[2 * i], w1 = vreg[2 * i + 1];
            LAS unsigned char* dst = Vt + (ch * 8) * AV_PITCH + kp * 4;
            *(LAS unsigned*)(dst + 0 * AV_PITCH) = (w0.x & 0xffffu) | (w1.x << 16); *(LAS unsigned*)(dst + 1 * AV_PITCH) = (w0.x >> 16) | (w1.x & 0xffff0000u);
            *(LAS unsigned*)(dst + 2 * AV_PITCH) = (w0.y & 0xffffu) | (w1.y << 16); *(LAS unsigned*)(dst + 3 * AV_PITCH) = (w0.y >> 16) | (w1.y & 0xffff0000u);
            *(LAS unsigned*)(dst + 4 * AV_PITCH) = (w0.z & 0xffffu) | (w1.z << 16); *(LAS unsigned*)(dst + 5 * AV_PITCH) = (w0.z >> 16) | (w1.z & 0xffff0000u);
            *(LAS unsigned*)(dst + 6 * AV_PITCH) = (w0.w & 0xffffu) | (w1.w << 16); *(LAS unsigned*)(dst + 7 * AV_PITCH) = (w0.w >> 16) | (w1.w & 0xffff0000u); }
        if (unit + F.G < NB * 2 * 16) AT_LOADKV(unit + F.G);
        __syncthreads();
        const float slope2 = __builtin_amdgcn_exp2f(-(float)(head + 1)) * LOG2E, sink2 = sink[head] * LOG2E;
#pragma unroll
        for (int qb = 0; qb < 2; ++qb) {
            const int q0 = qw0 + qb * 32;
            f32x16 o0, o1;
#pragma unroll
            for (int i = 0; i < 16; ++i) { o0[i] = 0.f; o1[i] = 0.f; }
            float m = sink2, l = (h == 0) ? 1.0f : 0.0f;
            const int kt_lo = (q0 - 128) < 0 ? 0 : q0 - 128, kt_hi = (q0 + 128) > SEQ - 32 ? SEQ - 32 : q0 + 128;
            for (int k0 = kt_lo; k0 <= kt_hi; k0 += 32) {
                const int kl = k0 - kbase;
                f32x16 s;
#pragma unroll
                for (int i = 0; i < 16; ++i) s[i] = 0.f;
#pragma unroll
                for (int ds = 0; ds < 4; ++ds) { const pg8::bf16x8 kf = *(const LAS pg8::bf16x8*)(Ks + (kl + r) * AK_PITCH + ds * 32 + h * 16); s = MFMA32(kf, qf[qb][ds], s); }
                const float base = (float)(q0 + r - k0 - 4 * h);
                const bool partial = (k0 < q0 + 31 - 128) || (k0 + 31 > q0 + 128);
                float mt = -INFINITY;
                if (partial) {
#pragma unroll
                    for (int i = 0; i < 16; ++i) { const float dist = fabsf(base - (float)((i & 3) + 8 * (i >> 2))); float sv = s[i] - slope2 * dist; sv = dist <= 128.0f ? sv : -INFINITY; s[i] = sv; mt = fmaxf(mt, sv); }
                } else {
#pragma unroll
                    for (int i = 0; i < 16; ++i) { const float dist = fabsf(base - (float)((i & 3) + 8 * (i >> 2))); const float sv = s[i] - slope2 * dist; s[i] = sv; mt = fmaxf(mt, sv); }
                }
                mt = fmaxf(mt, __shfl_xor(mt, 32));
                if (__any(mt > m)) {
                    const float mn = fmaxf(m, mt), alpha = __builtin_amdgcn_exp2f(m - mn); m = mn; l *= alpha;
#pragma unroll
                    for (int i = 0; i < 16; ++i) { o0[i] *= alpha; o1[i] *= alpha; }
                }
                float ps = 0.f;
#pragma unroll
                for (int i = 0; i < 16; ++i) { s[i] = __builtin_amdgcn_exp2f(s[i] - m); ps += s[i]; }
                l += ps;
#pragma unroll
                for (int sp = 0; sp < 2; ++sp) {
                    v4u pw; pw.x = cvtpk_s(s[8 * sp], s[8 * sp + 1]); pw.y = cvtpk_s(s[8 * sp + 2], s[8 * sp + 3]); pw.z = cvtpk_s(s[8 * sp + 4], s[8 * sp + 5]); pw.w = cvtpk_s(s[8 * sp + 6], s[8 * sp + 7]);
                    const pg8::bf16x8 pf = __builtin_bit_cast(pg8::bf16x8, pw);
                    const LAS unsigned char* vp = Vt + r * AV_PITCH + (kl + 16 * sp + 4 * h) * 2;
                    { const s16x4 lo = *(const LAS s16x4*)vp, hi = *(const LAS s16x4*)(vp + 16); o0 = MFMA32(__builtin_shufflevector(lo, hi, 0, 1, 2, 3, 4, 5, 6, 7), pf, o0); }
                    { const s16x4 lo = *(const LAS s16x4*)(vp + 32 * AV_PITCH), hi = *(const LAS s16x4*)(vp + 32 * AV_PITCH + 16); o1 = MFMA32(__builtin_shufflevector(lo, hi, 0, 1, 2, 3, 4, 5, 6, 7), pf, o1); }
                }
            }
            l += __shfl_xor(l, 32); const float inv = 1.0f / l;
            bf16* op = MIX + ((size_t)b * SEQ + q0 + r) * D + head * 64 + 4 * h;
#pragma unroll
            for (int gi = 0; gi < 4; ++gi) {
                u32x2 w0; w0.x = cvtpk_s(o0[4 * gi] * inv, o0[4 * gi + 1] * inv); w0.y = cvtpk_s(o0[4 * gi + 2] * inv, o0[4 * gi + 3] * inv); *(u32x2*)(op + 8 * gi) = w0;
                u32x2 w1; w1.x = cvtpk_s(o1[4 * gi] * inv, o1[4 * gi + 1] * inv); w1.y = cvtpk_s(o1[4 * gi + 2] * inv, o1[4 * gi + 3] * inv); *(u32x2*)(op + 32 + 8 * gi) = w1; }
        }
    }
#undef AT_LOADKV
}
__device__ __forceinline__ void p2_hgrn_simple(Frame& F) {
    const bf16* QH = (const bf16*)(F.ws + WS_QH); const bf16* IH = (const bf16*)(F.ws + WS_IH);
    LAS float* Qs = (LAS float*)(F.lds + RING_OFF); LAS float* Fs = Qs + 32 * 128; LAS float* Vs = Fs + 32 * 128;
    const int vidx = F.tid >> 2, dq = F.tid & 3;
    for (int unit = F.vcu; unit < NB * 4 * 2; unit += F.G) {
        const int dir = unit & 1, h = (unit >> 1) & 3, b = unit >> 3;
        const float* LG = (const float*)(F.ws + (dir ? WS_LB : WS_LF)); float* OUT = (float*)(F.ws + (dir ? WS_OB : WS_OF));
        float S[32];
#pragma unroll
        for (int i = 0; i < 32; ++i) S[i] = 0.f;
        for (int tile = 0; tile < SEQ / 32; ++tile) {
            __syncthreads();
#pragma unroll
            for (int i = 0; i < 8; ++i) { const int idx = F.tid + 512 * i, tt = idx >> 7, d = idx & 127; const int t = dir ? SEQ - 1 - (tile * 32 + tt) : tile * 32 + tt;
                const size_t g = ((size_t)b * SEQ + t) * 512 + h * 128 + d;
                Qs[idx] = __uint_as_float(((unsigned)QH[g]) << 16); Vs[idx] = __uint_as_float(((unsigned)IH[g]) << 16); Fs[idx] = __expf(LG[g]); }
            __syncthreads();
            for (int tt = 0; tt < 32; ++tt) {
                const float v = Vs[tt * 128 + vidx]; float o = 0.f;
#pragma unroll
                for (int dd = 0; dd < 32; dd += 4) { const f32x4 f = *(const LAS f32x4*)(Fs + tt * 128 + dq * 32 + dd), qq = *(const LAS f32x4*)(Qs + tt * 128 + dq * 32 + dd);
#pragma unroll
                    for (int j = 0; j < 4; ++j) { S[dd + j] = f[j] * (S[dd + j] - v) + v; o += S[dd + j] * qq[j]; } }
                o += __shfl_xor(o, 1); o += __shfl_xor(o, 2);
                const int t = dir ? SEQ - 1 - (tile * 32 + tt) : tile * 32 + tt;
                if (dq == 0) OUT[((size_t)b * SEQ + t) * 512 + h * 128 + vidx] = o;
            }
        }
    }
}

#define MFMA16(a, b, c) __builtin_amdgcn_mfma_f32_16x16x32_bf16((a), (b), (c), 0, 0, 0)
constexpr int HP = 272, HPS = 144;
constexpr int H_QR = 0, H_KR = 17408, H_KT = 34816, H_VT = 53248, H_AT = 62464, H_ST = 71680, H_QTOT = 89088, H_EREF = 91136, H_ELR = 91648;
static_assert(H_ELR + 512 <= RING_BYTES, "hgrn LDS");
__device__ __forceinline__ void p2_hgrn(Frame& F) {
    const bf16* QH = (const bf16*)(F.ws + WS_QH); const bf16* IH = (const bf16*)(F.ws + WS_IH);
    LAS unsigned char* L = F.lds + RING_OFF;
    const int tid = F.tid, w = F.wave, i16 = F.lane & 15, kg = F.lane >> 4;
    const int d0 = 2 * (tid & 63), t8 = tid >> 6, v0 = 2 * (tid & 31), s4 = tid >> 5;
    constexpr float LOG2E = 1.4426950408889634f;
    const int gw = F.vcu * NWAVES + F.wave, NGW = F.G * NWAVES; int cvk = 0;
    for (int unit = F.vcu; unit < NB * 4 * 2 * 2; unit += F.G) {
        const int vh = unit & 1, dir = (unit >> 1) & 1, h = (unit >> 2) & 3, b = unit >> 4;
        const float* LG = (const float*)(F.ws + (dir ? WS_LB : WS_LF)); bf16* OUT = (bf16*)(F.ws + (dir ? WS_OB : WS_OF));
        const size_t rowb = (size_t)b * SEQ;
        f32x4 S[4];
#pragma unroll
        for (int i = 0; i < 4; ++i) S[i] = (f32x4){0.f, 0.f, 0.f, 0.f};
        unsigned qA[8], vA[4], qB[8], vB[4]; f32x2_t lA[8], lB[8];
#define HG_TIME(c, tau) (dir ? (SEQ - 1 - (64 * (c) + (tau))) : (64 * (c) + (tau)))
#define HG_LOAD(c, qr_, lr_, vr_) do { \
        _Pragma("unroll") for (int j = 0; j < 8; ++j) { const size_t g = (rowb + HG_TIME(c, 8 * t8 + j)) * 512 + h * 128 + d0; qr_[j] = *(const unsigned*)(QH + g); lr_[j] = *(const f32x2_t*)(LG + g); } \
        _Pragma("unroll") for (int j = 0; j < 4; ++j) vr_[j] = *(const unsigned*)(IH + (rowb + HG_TIME(c, 4 * s4 + j)) * 512 + h * 128 + vh * 64 + v0); } while (0)
#define HG_CHUNK(c, qr_, lr_, vr_, itx) do { \
            asm volatile("s_waitcnt lgkmcnt(0)" ::: "memory"); __builtin_amdgcn_s_barrier(); asm volatile("" ::: "memory");                                                 \
            f32x2_t cs[8]; { f32x2_t run = {0.f, 0.f}; \
                _Pragma("unroll") for (int j = 0; j < 8; ++j) { run = run + lr_[j] * LOG2E; cs[j] = run; } \
                *(LAS f32x2_t*)(L + H_QTOT + (t8 * 128 + d0) * 4) = run; } \
            asm volatile("s_waitcnt lgkmcnt(0)" ::: "memory"); __builtin_amdgcn_s_barrier(); asm volatile("" ::: "memory"); \
            f32x2_t pre = {0.f, 0.f}, ref = {0.f, 0.f}, last = {0.f, 0.f}; \
            _Pragma("unroll") for (int sgm = 0; sgm < 8; ++sgm) { const f32x2_t tq_ = *(const LAS f32x2_t*)(L + H_QTOT + (sgm * 128 + d0) * 4); if (sgm < t8) pre = pre + tq_; if (sgm < 4) ref = ref + tq_; last = last + tq_; } \
            if (t8 == 0) { f32x2_t er_, el_; er_[0] = __builtin_amdgcn_exp2f(ref[0]); er_[1] = __builtin_amdgcn_exp2f(ref[1]); el_[0] = __builtin_amdgcn_exp2f(last[0] - ref[0]); el_[1] = __builtin_amdgcn_exp2f(last[1] - ref[1]); \
                *(LAS f32x2_t*)(L + H_EREF + d0 * 4) = er_; *(LAS f32x2_t*)(L + H_ELR + d0 * 4) = el_; } \
            { float kr0[8], kr1[8]; \
              _Pragma("unroll") for (int j = 0; j < 8; ++j) { \
                  const float c0 = pre[0] + cs[j][0] - ref[0], c1 = pre[1] + cs[j][1] - ref[1]; \
                  const float q0 = bflo(qr_[j]), q1 = bfhi(qr_[j]); \
                  const float k0 = 1.0f - __builtin_amdgcn_exp2f(lr_[j][0] * LOG2E), k1 = 1.0f - __builtin_amdgcn_exp2f(lr_[j][1] * LOG2E); \
                  kr0[j] = k0 * __builtin_amdgcn_exp2f(-c0); kr1[j] = k1 * __builtin_amdgcn_exp2f(-c1); \
                  *(LAS unsigned*)(L + H_QR + (8 * t8 + j) * HP + d0 * 2) = cvtpk_s(q0 * __builtin_amdgcn_exp2f(c0), q1 * __builtin_amdgcn_exp2f(c1)); \
                  *(LAS unsigned*)(L + H_KR + (8 * t8 + j) * HP + d0 * 2) = cvtpk_s(kr0[j], kr1[j]); } \
              *(LAS v4u*)(L + H_KT + d0 * HPS + t8 * 16) = (v4u){cvtpk_s(kr0[0], kr0[1]), cvtpk_s(kr0[2], kr0[3]), cvtpk_s(kr0[4], kr0[5]), cvtpk_s(kr0[6], kr0[7])}; \
              *(LAS v4u*)(L + H_KT + (d0 + 1) * HPS + t8 * 16) = (v4u){cvtpk_s(kr1[0], kr1[1]), cvtpk_s(kr1[2], kr1[3]), cvtpk_s(kr1[4], kr1[5]), cvtpk_s(kr1[6], kr1[7])}; } \
            { u32x2 a_, b_; a_.x = (vr_[0] & 0xffffu) | (vr_[1] << 16); a_.y = (vr_[2] & 0xffffu) | (vr_[3] << 16); b_.x = (vr_[0] >> 16) | (vr_[1] & 0xffff0000u); b_.y = (vr_[2] >> 16) | (vr_[3] & 0xffff0000u); \
              *(LAS u32x2*)(L + H_VT + v0 * HPS + s4 * 8) = a_; *(LAS u32x2*)(L + H_VT + (v0 + 1) * HPS + s4 * 8) = b_; } \
            if ((c) + 2 < SEQ / 64) HG_LOAD((c) + 2, qr_, lr_, vr_); \
            if (cvprev < CV_NITEMS) cv_store(F, cvprev, cvv);                \
            if ((itx) < CV_NITEMS) cv_load(F, (itx), cvv); cvprev = (itx); \
            asm volatile("s_waitcnt lgkmcnt(0)" ::: "memory"); __builtin_amdgcn_s_barrier(); asm volatile("" ::: "memory"); \
            {     \
                const f32x4 er = *(const LAS f32x4*)(L + H_EREF + (16 * w + 4 * kg) * 4); \
                _Pragma("unroll") for (int vt = 0; vt < 4; ++vt) { S[vt] = S[vt] * er; u32x2 pk; pk.x = cvtpk_s(S[vt][0], S[vt][1]); pk.y = cvtpk_s(S[vt][2], S[vt][3]); \
                    *(LAS u32x2*)(L + H_ST + (16 * vt + i16) * HP + (16 * w + 4 * kg) * 2) = pk; } \
                const int tt = w >> 1; \
                _Pragma("unroll") for (int q2 = 0; q2 < 2; ++q2) { const int st = 2 * (w & 1) + q2; LAS unsigned char* ap = L + H_AT + (16 * tt + i16) * HPS + (16 * st + 4 * kg) * 2; \
                    if (st > tt) { *(LAS u32x2*)ap = (u32x2){0u, 0u}; } \
                    else { f32x4 a = (f32x4){0.f, 0.f, 0.f, 0.f}; \
                        _Pragma("unroll") for (int ks = 0; ks < 4; ++ks) { const pg8::bf16x8 kf = *(const LAS pg8::bf16x8*)(L + H_KR + (16 * st + i16) * HP + (32 * ks + 8 * kg) * 2), qf = *(const LAS pg8::bf16x8*)(L + H_QR + (16 * tt + i16) * HP + (32 * ks + 8 * kg) * 2); \
                            a = MFMA16(kf, qf, a); } \
                        if (st == tt) { _Pragma("unroll") for (int i = 0; i < 4; ++i) a[i] = (4 * kg + i <= i16) ? a[i] : 0.f; } \
                        u32x2 pk; pk.x = cvtpk_s(a[0], a[1]); pk.y = cvtpk_s(a[2], a[3]); *(LAS u32x2*)ap = pk; } } \
                _Pragma("unroll") for (int ks = 0; ks < 2; ++ks) { const pg8::bf16x8 af = *(const LAS pg8::bf16x8*)(L + H_KT + (16 * w + i16) * HPS + (32 * ks + 8 * kg) * 2); \
                    _Pragma("unroll") for (int vt = 0; vt < 4; ++vt) { const pg8::bf16x8 bfv = *(const LAS pg8::bf16x8*)(L + H_VT + (16 * vt + i16) * HPS + (32 * ks + 8 * kg) * 2); S[vt] = MFMA16(af, bfv, S[vt]); } } \
                const f32x4 el = *(const LAS f32x4*)(L + H_ELR + (16 * w + 4 * kg) * 4); \
                _Pragma("unroll") for (int vt = 0; vt < 4; ++vt) S[vt] = S[vt] * el; \
            } \
            asm volatile("s_waitcnt lgkmcnt(0)" ::: "memory"); __builtin_amdgcn_s_barrier(); asm volatile("" ::: "memory"); \
            {     \
                const int vt = w & 3, tp = w >> 2; \
                f32x4 oa[2]; oa[0] = (f32x4){0.f, 0.f, 0.f, 0.f}; oa[1] = oa[0]; \
                _Pragma("unroll") for (int ks = 0; ks < 4; ++ks) { const pg8::bf16x8 sf = *(const LAS pg8::bf16x8*)(L + H_ST + (16 * vt + i16) * HP + (32 * ks + 8 * kg) * 2); \
                    _Pragma("unroll") for (int q2 = 0; q2 < 2; ++q2) { const pg8::bf16x8 qf = *(const LAS pg8::bf16x8*)(L + H_QR + (16 * (2 * tp + q2) + i16) * HP + (32 * ks + 8 * kg) * 2); oa[q2] = MFMA16(sf, qf, oa[q2]); } } \
                _Pragma("unroll") for (int ks = 0; ks < 2; ++ks) if (ks <= tp) { const pg8::bf16x8 vf = *(const LAS pg8::bf16x8*)(L + H_VT + (16 * vt + i16) * HPS + (32 * ks + 8 * kg) * 2); \
                    _Pragma("unroll") for (int q2 = 0; q2 < 2; ++q2) { const pg8::bf16x8 af = *(const LAS pg8::bf16x8*)(L + H_AT + (16 * (2 * tp + q2) + i16) * HPS + (32 * ks + 8 * kg) * 2); oa[q2] = MFMA16(vf, af, oa[q2]); } } \
                _Pragma("unroll") for (int q2 = 0; q2 < 2; ++q2) { const int tm = HG_TIME(c, 16 * (2 * tp + q2) + i16); u32x2 ow; ow.x = cvtpk_s(oa[q2][0], oa[q2][1]); ow.y = cvtpk_s(oa[q2][2], oa[q2][3]); \
                    *(u32x2*)(OUT + (rowb + tm) * 512 + h * 128 + vh * 64 + 16 * vt + 4 * kg) = ow; } \
            } } while (0)
        HG_LOAD(0, qA, lA, vA); HG_LOAD(1, qB, lB, vB);
        f32x4 cvv[8]; int cvprev = CV_NITEMS;
        for (int c = 0; c < SEQ / 64; c += 2) {
            const int it0 = gw + cvk * NGW, it1 = it0 + NGW; cvk += 2;
            HG_CHUNK(c, qA, lA, vA, it0);
            HG_CHUNK(c + 1, qB, lB, vB, it1);
        }
        if (cvprev < CV_NITEMS) cv_store(F, cvprev, cvv);
#undef HG_CHUNK
#undef HG_LOAD
#undef HG_TIME
    }
    for (int it = gw + cvk * NGW; it < CV_NITEMS; it += NGW) { f32x4 cvv[8]; cv_load(F, it, cvv); cv_store(F, it, cvv); }
}
__device__ __forceinline__ void p3_finalize(Frame& F) {
    const bf16* OFp = (const bf16*)(F.ws + WS_OF); const bf16* OBp = (const bf16*)(F.ws + WS_OB); const bf16* ZG = (const bf16*)(F.ws + WS_ZG); bf16* MIX = (bf16*)(F.ws + WS_MIX);
    const int gw = F.vcu * NWAVES + F.wave, NGW = F.G * NWAVES, sub = F.lane >> 4, l16 = F.lane & 15;
    for (int it = gw; it < T; it += NGW) {
        const size_t g = (size_t)it * 512 + sub * 128 + 8 * l16;
        const v4u a = *(const v4u*)(OFp + g), c = *(const v4u*)(OBp + g), z = *(const v4u*)(ZG + g);
        float o[8]; o[0] = bflo(a.x) + bflo(c.x); o[1] = bfhi(a.x) + bfhi(c.x); o[2] = bflo(a.y) + bflo(c.y); o[3] = bfhi(a.y) + bfhi(c.y);
        o[4] = bflo(a.z) + bflo(c.z); o[5] = bfhi(a.z) + bfhi(c.z); o[6] = bflo(a.w) + bflo(c.w); o[7] = bfhi(a.w) + bfhi(c.w);
        float ss = (o[0] * o[0] + o[1] * o[1]) + (o[2] * o[2] + o[3] * o[3]) + (o[4] * o[4] + o[5] * o[5]) + (o[6] * o[6] + o[7] * o[7]);
        ss += __shfl_xor(ss, 1); ss += __shfl_xor(ss, 2); ss += __shfl_xor(ss, 4); ss += __shfl_xor(ss, 8);
        const float r = 1.0f / sqrtf(ss * (1.0f / 128.0f) + RMS_EPS);
        v4u w; w.x = cvtpk_s(o[0] * r * bflo(z.x), o[1] * r * bfhi(z.x)); w.y = cvtpk_s(o[2] * r * bflo(z.y), o[3] * r * bfhi(z.y));
        w.z = cvtpk_s(o[4] * r * bflo(z.z), o[5] * r * bfhi(z.z)); w.w = cvtpk_s(o[6] * r * bflo(z.w), o[7] * r * bfhi(z.w));
        *(v4u*)(MIX + (size_t)it * D + 512 + sub * 128 + 8 * l16) = w;
    }
}

__device__ __forceinline__ void p5_router(Frame& F) {
    const bf16* U = (const bf16*)(F.ws + WS_U); bf16* H1 = (bf16*)(F.ws + WS_H1); unsigned char* H1F8 = F.ws + WS_H1F8; int* TOPI = (int*)(F.ws + WS_TOPI); float* TOPG = (float*)(F.ws + WS_TOPG); int* cntTab = (int*)(F.ws + WS_TAB);
    const float* Wr = FIN(F, 10); const float* br = FIN(F, 11); const float* lg = FIN(F, 8); const float* lb = FIN(F, 9);
    LAS float* part = (LAS float*)(F.lds + RING_OFF);
    LAS float* LGs = (LAS float*)(F.lds + RING_OFF + 1024);
    LAS int* hist = (LAS int*)(F.lds + HIST_OFF);
    const int w = F.wave, i16 = F.lane & 15, kg = F.lane >> 4, kcol = 128 * w + 8 * kg;
    pg8::bf16x8 bhi[4][2], blo[4][2];
#pragma unroll
    for (int ks = 0; ks < 4; ++ks)
#pragma unroll
        for (int nt = 0; nt < 2; ++nt) { v4u ph, pl; unsigned* phh = (unsigned*)&ph; unsigned* pll = (unsigned*)&pl;
#pragma unroll
            for (int j = 0; j < 8; j += 2) { const float x0 = Wr[(size_t)(kcol + 32 * ks + j) * NE + 16 * nt + i16], x1 = Wr[(size_t)(kcol + 32 * ks + j + 1) * NE + 16 * nt + i16];
                const unsigned hh = cvtpk_s(x0, x1); phh[j >> 1] = hh; pll[j >> 1] = cvtpk_s(x0 - bflo(hh), x1 - bfhi(hh)); }
            bhi[ks][nt] = __builtin_bit_cast(pg8::bf16x8, ph); blo[ks][nt] = __builtin_bit_cast(pg8::bf16x8, pl); }
    const float mybias = br[F.lane & 31];
    for (int chunk = F.vcu; chunk < NCHUNK; chunk += F.G) {
        __syncthreads();
        if (F.tid < NE) hist[F.tid] = 0;
        v4u ub[4];
#pragma unroll
        for (int ks = 0; ks < 4; ++ks) ub[ks] = *(const GAS v4u*)(U + (size_t)(chunk * CHUNK_TOK + i16) * D + kcol + 32 * ks);
        for (int it = 0; it < CHUNK_TOK / 16; ++it) {
            const int tok0 = chunk * CHUNK_TOK + it * 16, tok = tok0 + i16;
            f32x4 u[4][2]; float s1 = 0.f, s2 = 0.f;
#pragma unroll
            for (int ks = 0; ks < 4; ++ks) { u[ks][0] = (f32x4){bflo(ub[ks].x), bfhi(ub[ks].x), bflo(ub[ks].y), bfhi(ub[ks].y)}; u[ks][1] = (f32x4){bflo(ub[ks].z), bfhi(ub[ks].z), bflo(ub[ks].w), bfhi(ub[ks].w)};
#pragma unroll
                for (int q = 0; q < 2; ++q) { s1 += (u[ks][q][0] + u[ks][q][1]) + (u[ks][q][2] + u[ks][q][3]); s2 += (u[ks][q][0] * u[ks][q][0] + u[ks][q][1] * u[ks][q][1]) + (u[ks][q][2] * u[ks][q][2] + u[ks][q][3] * u[ks][q][3]); } }
            if (it + 1 < CHUNK_TOK / 16) {
#pragma unroll
                for (int ks = 0; ks < 4; ++ks) ub[ks] = *(const GAS v4u*)(U + (size_t)(tok + 16) * D + kcol + 32 * ks); }
            s1 += __shfl_xor(s1, 16); s1 += __shfl_xor(s1, 32); s2 += __shfl_xor(s2, 16); s2 += __shfl_xor(s2, 32);
            if (kg == 0) { part[(w * 16 + i16) * 2] = s1; part[(w * 16 + i16) * 2 + 1] = s2; }
            __syncthreads();
            float t1 = 0.f, t2 = 0.f;
#pragma unroll
            for (int ww = 0; ww < 8; ++ww) { t1 += part[(ww * 16 + i16) * 2]; t2 += part[(ww * 16 + i16) * 2 + 1]; }
            const float mean = t1 * (1.0f / D), rstd = 1.0f / sqrtf(fmaxf(t2 * (1.0f / D) - mean * mean, 0.f) + LN_EPS);
            f32x4 acc[2]; acc[0] = (f32x4){0.f, 0.f, 0.f, 0.f}; acc[1] = acc[0];
#pragma unroll
            for (int ks = 0; ks < 4; ++ks) { v4u ph, pl; unsigned* phh = (unsigned*)&ph; unsigned* pll = (unsigned*)&pl;
#pragma unroll
                for (int q = 0; q < 2; ++q) { const f32x4 gq = *(const f32x4*)(lg + kcol + 32 * ks + 4 * q), bq = *(const f32x4*)(lb + kcol + 32 * ks + 4 * q); const f32x4 y = (u[ks][q] - mean) * rstd * gq + bq;
                    const unsigned h0 = cvtpk_s(y[0], y[1]), h1 = cvtpk_s(y[2], y[3]); phh[2 * q] = h0; phh[2 * q + 1] = h1;
                    pll[2 * q] = cvtpk_s(y[0] - bflo(h0), y[1] - bfhi(h0)); pll[2 * q + 1] = cvtpk_s(y[2] - bflo(h1), y[3] - bfhi(h1)); }
                *(GAS v4u*)(H1 + (size_t)tok * D + kcol + 32 * ks) = ph;
                { u32x2 f8; f8.x = pk4_fp8(bflo(ph.x) * F8_SA, bfhi(ph.x) * F8_SA, bflo(ph.y) * F8_SA, bfhi(ph.y) * F8_SA); f8.y = pk4_fp8(bflo(ph.z) * F8_SA, bfhi(ph.z) * F8_SA, bflo(ph.w) * F8_SA, bfhi(ph.w) * F8_SA);
                  *(GAS u32x2*)(H1F8 + (size_t)tok * D + kcol + 32 * ks) = f8; }
                const pg8::bf16x8 ahi = __builtin_bit_cast(pg8::bf16x8, ph), alo = __builtin_bit_cast(pg8::bf16x8, pl);
#pragma unroll
                for (int nt = 0; nt < 2; ++nt) { acc[nt] = MFMA16(ahi, bhi[ks][nt], acc[nt]); acc[nt] = MFMA16(alo, bhi[ks][nt], acc[nt]); acc[nt] = MFMA16(ahi, blo[ks][nt], acc[nt]); } }
#pragma unroll
            for (int nt = 0; nt < 2; ++nt)
#pragma unroll
                for (int i = 0; i < 4; ++i) LGs[(w * 16 + 4 * kg + i) * 32 + 16 * nt + i16] = acc[nt][i];
            __syncthreads();
            {
                const int tl = 2 * w + (F.lane >> 5), e = F.lane & 31; float v = mybias;
#pragma unroll
                for (int ww = 0; ww < 8; ++ww) v += LGs[(ww * 16 + tl) * 32 + e];
                float tv[4]; int tix[4];
#pragma unroll
                for (int k = 0; k < 4; ++k) { float bv = v; int bi = e;
#pragma unroll
                    for (int o = 1; o < 32; o <<= 1) { const float ov = __shfl_xor(bv, o); const int oi = __shfl_xor(bi, o); const bool take = (ov > bv) || (ov == bv && oi < bi); bv = take ? ov : bv; bi = take ? oi : bi; }
                    tv[k] = bv; tix[k] = bi; if (e == bi) v = -3.0e38f; }
                const float e1 = __expf(tv[1] - tv[0]), e2 = __expf(tv[2] - tv[0]), e3 = __expf(tv[3] - tv[0]); const float inv = 1.0f / (1.0f + e1 + e2 + e3);
                if (e == 0) { const size_t tk = (size_t)(tok0 + tl);
                    *(int4*)(TOPI + tk * 4) = make_int4(tix[0], tix[1], tix[2], tix[3]); *(float4*)(TOPG + tk * 4) = make_float4(inv, e1 * inv, e2 * inv, e3 * inv);
                    atomicAdd((int*)&hist[tix[0]], 1); atomicAdd((int*)&hist[tix[1]], 1); atomicAdd((int*)&hist[tix[2]], 1); atomicAdd((int*)&hist[tix[3]], 1); }
            }
        }
        __syncthreads();
        if (F.tid < NE) cntTab[chunk * NE + F.tid] = hist[F.tid];
    }
}

__device__ __forceinline__ void p6_dispatch(Frame& F) {
    const int* cntTab = (const int*)(F.ws + WS_TAB); int* tileExpertG = (int*)(F.ws + WS_TAB + 65536); int* ntilesG = (int*)(F.ws + WS_TAB + 98304);
    const int* TOPI = (const int*)(F.ws + WS_TOPI); const float* TOPG = (const float*)(F.ws + WS_TOPG); int* ROWTOK = (int*)(F.ws + WS_ROWTOK); float* GATES = (float*)(F.ws + WS_GATES);
    LAS int* ptot = (LAS int*)(F.lds + RING_OFF);
    LAS int* ppre = ptot + 512;
    LAS int* tot = ppre + 512;
    LAS int* base = tot + 32;
    LAS int* myoff = base + 36;
    LAS int* wcnt = myoff + 32;
    for (int chunk = F.vcu; chunk < NCHUNK; chunk += F.G) {
        __syncthreads();
        { const int e = F.tid & 31, part = F.tid >> 5; int st = 0, sp = 0;
#pragma unroll
          for (int i = 0; i < 16; ++i) { const int w = part * 16 + i; const int c = cntTab[w * NE + e]; st += c; sp += (w < chunk) ? c : 0; }
          ptot[part * 32 + e] = st; ppre[part * 32 + e] = sp; }
        const size_t ge = (size_t)chunk * CHUNK_TOK * 4 + F.tid; const int me = TOPI[ge]; const float mg = TOPG[ge];
        int rank = 0, cntw = 0; const unsigned long long lt = (1ull << F.lane) - 1ull;
#pragma unroll 8
        for (int ee = 0; ee < NE; ++ee) { const unsigned long long m = __ballot(me == ee); if (me == ee) rank = __popcll(m & lt); if (F.lane == ee) cntw = __popcll(m); }
        if (F.lane < NE) wcnt[F.wave * 32 + F.lane] = cntw;
        __syncthreads();
        if (F.tid < NE) { int st = 0, sp = 0;
#pragma unroll
            for (int p = 0; p < 16; ++p) { st += ptot[p * 32 + F.tid]; sp += ppre[p * 32 + F.tid]; }
            tot[F.tid] = st; myoff[F.tid] = sp;
            int incl = (st + 255) & ~255;
#pragma unroll
            for (int o = 1; o < 32; o <<= 1) { const int t = __shfl_up(incl, o); if (F.tid >= o) incl += t; }
            base[F.tid + 1] = incl; if (F.tid == 0) base[0] = 0; }
        __syncthreads();
        { int pos = base[me] + myoff[me] + rank;
          for (int w = 0; w < F.wave; ++w) pos += wcnt[w * 32 + me];
          ROWTOK[pos] = (int)ge; GATES[pos] = mg; }
        if (chunk == 0) {
            for (int tl = F.tid; tl < MAXTILES; tl += NWAVES * 64) { int e = 0;
#pragma unroll 8
                for (int k = 1; k < NE; ++k) e += (tl * 256 >= base[k]) ? 1 : 0;
                tileExpertG[tl] = e; }
            if (F.tid < 256) for (int e = 0; e < NE; ++e) { const int s = base[e] + tot[e] + F.tid; if (s < base[e + 1]) { ROWTOK[s] = -1; GATES[s] = 0.f; } }
            if (F.tid == 0) ntilesG[0] = base[NE] >> 8;
        }
    }
}

typedef float f32x2v __attribute__((ext_vector_type(2)));
__device__ __forceinline__ void p9_combine(Frame& F) {
    const bf16* H1 = (const bf16*)(F.ws + WS_H1); const unsigned char* Y = F.ws + WS_Y;
    const int gw = F.vcu * NWAVES + F.wave, NGW = F.G * NWAVES;
    f32x4 gg[4], bb[4];
#pragma unroll
    for (int j = 0; j < 4; ++j) { gg[j] = ((const f32x4*)FIN(F, 16))[F.lane + 64 * j]; bb[j] = ((const f32x4*)FIN(F, 17))[F.lane + 64 * j]; }
    for (int tok = gw; tok < T; tok += NGW) {
        f32x4 v[4]; float s = 0.f;
#pragma unroll
        for (int j = 0; j < 4; ++j) { const u32x2 hb = ((const u32x2*)(H1 + (size_t)tok * D))[F.lane + 64 * j];
            f32x4 y = (f32x4){0.f, 0.f, 0.f, 0.f};
#pragma unroll
            for (int k = 0; k < 4; ++k) { const unsigned yb = ((const unsigned*)(Y + ((size_t)tok * 4 + k) * D))[F.lane + 64 * j];
                const f32x2v lo = __builtin_amdgcn_cvt_pk_f32_fp8((int)yb, false), hi = __builtin_amdgcn_cvt_pk_f32_fp8((int)yb, true); y[0] += lo[0]; y[1] += lo[1]; y[2] += hi[0]; y[3] += hi[1]; }
            v[j][0] = DN_ALPHA * bflo(hb.x) + y[0] * (1.0f / F8_SY); v[j][1] = DN_ALPHA * bfhi(hb.x) + y[1] * (1.0f / F8_SY); v[j][2] = DN_ALPHA * bflo(hb.y) + y[2] * (1.0f / F8_SY); v[j][3] = DN_ALPHA * bfhi(hb.y) + y[3] * (1.0f / F8_SY);
            s += (v[j].x + v[j].y) + (v[j].z + v[j].w); }
        const float mean = wave_sum(s) * (1.f / D); float s2 = 0.f;
#pragma unroll
        for (int j = 0; j < 4; ++j) { v[j] = v[j] - mean; s2 += (v[j].x * v[j].x + v[j].y * v[j].y) + (v[j].z * v[j].z + v[j].w * v[j].w); }
        const float rstd = 1.f / sqrtf(wave_sum(s2) * (1.f / D) + LN_EPS);
        GAS f32x4* o = (GAS f32x4*)(F.out + (size_t)tok * D) + F.lane;
#pragma unroll
        for (int j = 0; j < 4; ++j) o[64 * j] = v[j] * rstd * gg[j] + bb[j];
    }
}

struct Args { const float* in[18]; float* out; unsigned char* ws; int ph_lo, ph_hi; };
__global__ void __launch_bounds__(NWAVES * 64, 2) hymba_fwd(Args args) {
    extern __shared__ __attribute__((aligned(16))) unsigned char lds[];
    Frame F;
    F.lds = (LAS unsigned char*)lds;
    F.MISC = (volatile LAS unsigned*)(F.lds + MISC_OFF);
    F.tid = threadIdx.x; F.lane = F.tid & 63; F.wave = __builtin_amdgcn_readfirstlane(F.tid >> 6);
    F.G = gridDim.x; { const int bx = blockIdx.x; F.vcu = (F.G % 8 == 0) ? (bx % 8) * (F.G / 8) + bx / 8 : bx; }
    F.ws = args.ws; F.out = args.out; F.ctl = (gu32*)(args.ws + WS_CTL);
    F.ka = (const __attribute__((address_space(4))) unsigned char*)__builtin_amdgcn_kernarg_segment_ptr();
    static_assert(offsetof(Args, in) == 0, "the input pointers lead the kernarg segment");
    for (int u = F.tid; u < (LDS_BYTES - LDSCTL_OFF) / 4; u += NWAVES * 64) ((LAS unsigned*)(F.lds + LDSCTL_OFF))[u] = 0u;
    __syncthreads();
    XcdBarrier bar; bar.bar = (unsigned*)(F.ctl + CW_BAR); bar.x = 0; bar.st = nullptr;
    if (N_LAUNCHES == 1) bar = xcd_barrier_post((unsigned*)(F.ctl + CW_BAR), F.MISC + 8);
#define GRID_BAR() do { if (N_LAUNCHES == 1) xcd_barrier(bar); } while (0)
    const int lo = args.ph_lo, hi = args.ph_hi;
#define IN(k) (lo <= (k) && (k) < hi)
#define BOTH(k) (IN(k) && IN((k) + 1))
    unsigned char* ws = args.ws;

#ifndef PROBE_DBL
#define PROBE_DBL 0
#endif
#define DBL(k) ((PROBE_DBL >> (k)) & 1)
    if (IN(0)) { p0_prologue(F); if (DBL(0)) { __syncthreads(); p0_prologue(F); } if (BOTH(0)) GRID_BAR(); }

    if (IN(1)) {
        pg8::Gemm g{(const bf16*)(ws + WS_H0), (const bf16*)(ws + WS_WIN), T, NIN, D}; pg8::StaticOrder S; S.init(T, NIN, F.G, (int)blockIdx.x);
        EpiInProj E{(bf16*)(ws + WS_QA), (bf16*)(ws + WS_KA), (bf16*)(ws + WS_VA), (bf16*)(ws + WS_QH), (bf16*)(ws + WS_IH), (bf16*)(ws + WS_ZG), (float*)(ws + WS_LF), (float*)(ws + WS_LB), FIN(F, 5), FIN(F, 6)};
        pg8::gemm_phase<EpiInProj, pg8::StaticOrder, true, true>(F.lds + RING_OFF, g, S, E);
        if (DBL(1)) pg8::gemm_phase<EpiInProj, pg8::StaticOrder, true, true>(F.lds + RING_OFF, g, S, E);
        if (DBL(14)) { EpiNull EN{(int*)(ws + WS_TAB + 131072)}; pg8::gemm_phase<EpiNull, pg8::StaticOrder, true, true>(F.lds + RING_OFF, g, S, EN); }
        if (BOTH(1)) GRID_BAR();
    }
    if (IN(2)) { p2_attn(F); __syncthreads(); p2_hgrn(F); if (DBL(2)) { __syncthreads(); p2_attn(F); __syncthreads(); p2_hgrn(F); } if (DBL(10)) { __syncthreads(); p2_attn(F); } if (DBL(11)) { __syncthreads(); p2_hgrn(F); } if (BOTH(2)) GRID_BAR(); }
    if (IN(3)) { p3_finalize(F); if (DBL(3)) p3_finalize(F); if (BOTH(3)) GRID_BAR(); }
    if (IN(4)) {
        pg8::Gemm g{(const bf16*)(ws + WS_MIX), (const bf16*)(ws + WS_WOUT), T, D, D}; pg8::StaticOrder S; S.init(T, D, F.G, (int)blockIdx.x);
        EpiOutProj E{(const bf16*)(ws + WS_H0), (bf16*)(ws + WS_U)};
        pg8::gemm_phase<EpiOutProj, pg8::StaticOrder, true, true>(F.lds + RING_OFF, g, S, E);
        if (DBL(4)) pg8::gemm_phase<EpiOutProj, pg8::StaticOrder, true, true>(F.lds + RING_OFF, g, S, E);
        if (BOTH(4)) GRID_BAR();
    }
    if (IN(5)) { p5_router(F); if (DBL(5)) { __syncthreads(); p5_router(F); } if (BOTH(5)) GRID_BAR(); }
    if (IN(6)) { p6_dispatch(F); if (DBL(6)) { __syncthreads(); p6_dispatch(F); } if (BOTH(6)) GRID_BAR(); }
    const int ntiles = (IN(7) || IN(8)) ? *(const int*)(ws + WS_TAB + 98304) : 0;
    if (IN(7) || IN(8)) {
        const int* tileExpertG = (const int*)(ws + WS_TAB + 65536); const int* ROWTOK = (const int*)(ws + WS_ROWTOK);
        __syncthreads();
        for (int i = F.tid; i < MAXTILES; i += NWAVES * 64) ((LAS int*)(F.lds + TAB_OFF))[i] = tileExpertG[i] & 31;
        if (IN(7)) for (int i = 0; i < MAXUNITS_WG; ++i) { const int tile = F.G == 256 ? moe_tile(i, (int)blockIdx.x, 8) : (i * F.G + (int)blockIdx.x) >> 3; if (tile >= ntiles) break;
            if (F.tid < 256) { const int rt = ROWTOK[tile * 256 + F.tid]; ((LAS unsigned short*)(F.lds + ROWL_OFF))[i * 256 + F.tid] = (unsigned short)((rt < 0 ? 0 : rt) >> 2); } }
        if (IN(8)) { const float* GATES = (const float*)(ws + WS_GATES);
            for (int i = 0; i < MAXDOWN_WG; ++i) { const int tile = F.G == 256 ? moe_tile(i, (int)blockIdx.x, 4) : (i * F.G + (int)blockIdx.x) >> 2; if (tile >= ntiles) break;
                if (F.tid < 256) { u32x2 t; t.x = (unsigned)ROWTOK[tile * 256 + F.tid]; t.y = __float_as_uint(GATES[tile * 256 + F.tid] * F8_SY); ((LAS u32x2*)(F.lds + DG_OFF))[i * 256 + F.tid] = t; } } }
        __syncthreads();
    }
    if (IN(7)) {
        pg8::Gemm g{(const bf16*)(ws + WS_H1F8), (const bf16*)(ws + WS_WUP), T, NE * DFF, D / 2}; MoeOrder S{(const LAS int*)(F.lds + TAB_OFF), ntiles, 8, F.G, (int)blockIdx.x};
        EpiUp E{ws + WS_ACT, FIN(F, 13)};
        pg8::gemm_phase<EpiUp, MoeOrder, true, true, true, true>(F.lds + RING_OFF, g, S, E, (const LAS unsigned short*)(F.lds + ROWL_OFF));
        if (DBL(7)) pg8::gemm_phase<EpiUp, MoeOrder, true, true, true, true>(F.lds + RING_OFF, g, S, E, (const LAS unsigned short*)(F.lds + ROWL_OFF));
        if (DBL(12)) { EpiNull EN{(int*)(ws + WS_TAB + 131072)}; pg8::gemm_phase<EpiNull, MoeOrder, true, true, true, true>(F.lds + RING_OFF, g, S, EN, (const LAS unsigned short*)(F.lds + ROWL_OFF)); }
        if (BOTH(7)) GRID_BAR();
    }
    if (IN(8)) {
        pg8::Gemm g{(const bf16*)(ws + WS_ACT), (const bf16*)(ws + WS_WD), MAXSLOTS, NE * D, D / 2}; MoeOrder S{(const LAS int*)(F.lds + TAB_OFF), ntiles, 4, F.G, (int)blockIdx.x};
        EpiDown E{ws + WS_Y, (const LAS u32x2*)(F.lds + DG_OFF), FIN(F, 15)};
        pg8::gemm_phase<EpiDown, MoeOrder, true, true, false, true>(F.lds + RING_OFF, g, S, E);
        if (DBL(8)) pg8::gemm_phase<EpiDown, MoeOrder, true, true, false, true>(F.lds + RING_OFF, g, S, E);
        if (DBL(13)) { EpiNull EN{(int*)(ws + WS_TAB + 131072)}; pg8::gemm_phase<EpiNull, MoeOrder, true, true, false, true>(F.lds + RING_OFF, g, S, EN); }
        if (BOTH(8)) GRID_BAR();
    }
    if (IN(9)) { p9_combine(F); if (DBL(9)) p9_combine(F); }
#undef IN
#undef BOTH
}

extern "C" void kernel_launch(void* const* d_in, const int* in_sizes, int n_in, void* d_out, int out_size, void* d_ws, size_t ws_size, hipStream_t stream) {
    static int grid = 0;
    if (grid == 0) {
        if (n_in != 18 || in_sizes[0] != T * D || out_size != T * D || ws_size < WS_END) { fprintf(stderr, "kernel_launch: unexpected shapes (n_in %d, in0 %d, out %d, ws %zu); nothing launched\n", n_in, n_in > 0 ? in_sizes[0] : -1, out_size, ws_size); grid = -1; return; }
        int dev = 0, cus = 0, per_cu = 0;
        if (hipGetDevice(&dev) != hipSuccess || hipDeviceGetAttribute(&cus, hipDeviceAttributeMultiprocessorCount, dev) != hipSuccess) { grid = -1; return; }
        if (hipFuncSetAttribute((const void*)hymba_fwd, hipFuncAttributeMaxDynamicSharedMemorySize, LDS_BYTES) != hipSuccess) { fprintf(stderr, "kernel_launch: hipFuncSetAttribute failed\n"); grid = -1; return; }
        if (hipOccupancyMaxActiveBlocksPerMultiprocessor(&per_cu, (const void*)hymba_fwd, NWAVES * 64, LDS_BYTES) != hipSuccess || per_cu < 1) fprintf(stderr, "kernel_launch: occupancy query says %d\n", per_cu);
        (void)hipGetLastError();
        grid = cus;
    }
    if (grid < 0) return;
    if (hipMemsetAsync((char*)d_ws + WS_CTL, 0, CTL_ZERO_BYTES, stream) != hipSuccess) return;
    Args a{};
    for (int i = 0; i < 18; ++i) a.in[i] = (const float*)d_in[i];
    a.out = (float*)d_out; a.ws = (unsigned char*)d_ws;
    if (N_LAUNCHES == 1) { a.ph_lo = 0; a.ph_hi = PER_PHASE; hipLaunchKernelGGL(hymba_fwd, dim3(grid), dim3(NWAVES * 64), LDS_BYTES, stream, a); }
    else for (int li = 0; li < PER_PHASE; ++li) { a.ph_lo = li; a.ph_hi = li + 1; hipLaunchKernelGGL(hymba_fwd, dim3(grid), dim3(NWAVES * 64), LDS_BYTES, stream, a); }
}
```

```cpp
#include <hip/hip_runtime.h>
#include <cstdio>
#include <cstdint>
#include <cstddef>
#ifndef MK_N_LAUNCHES
#define MK_N_LAUNCHES 1
#endif
namespace pg8 {
#define PG8_LAS __attribute__((address_space(3)))
typedef unsigned short bf16_t;
typedef short bf16x8 __attribute__((ext_vector_type(8)));
typedef float f32x4 __attribute__((ext_vector_type(4)));
typedef unsigned u32x4 __attribute__((ext_vector_type(4)));
constexpr int BM = 256, BK = 64, HALF = 128, HTB = HALF * BK * 2  , STAGE_BYTES = 8 * HTB, NXCD = 8, WGM = 8;

__host__ __device__ __forceinline__ int lds_byte(int r, int c) { const int st = (r >> 4) * 2 + (c >> 5), rr = r & 15, cc = c & 31, ob = rr * 64 + cc * 2; return st * 1024 + (ob ^ (((ob >> 9) & 1) << 5)); }
__host__ __device__ __forceinline__ void stage_rc(int b, int& R, int& C) { const int st = b / 1024, sb = b % 1024, swz = sb ^ (((sb >> 9) & 1) << 5); R = (st >> 1) * 16 + swz / 64; C = (st & 1) * 32 + (swz % 64) / 2; }
__host__ __device__ __forceinline__ int perm32(int rho) { const int n = rho >> 4, i = rho & 15; return 8 * (i >> 2) + 4 * n + (i & 3); }

struct Unit { int pm, pn, ord; };
struct Gemm { const bf16_t* A; const bf16_t* Bt; int M, N, K; };

struct StaticOrder {
    int nM, nN, nwg, G, c;
    __host__ __device__ void init(int M, int N, int G_, int c_) { nM = M / BM; nN = N / BM; nwg = nM * nN; G = G_; c = c_; }
    __host__ __device__ bool next(int i, Unit& u) const {
        const long L = (long)i * G + c; if (L >= nwg) return false;
        int wgid = (int)L; { const int q = nwg / NXCD, r = nwg % NXCD, xcd = wgid % NXCD, off = wgid / NXCD; wgid = (xcd < r ? xcd * (q + 1) : r * (q + 1) + (xcd - r) * q) + off; }
        const int nig = WGM * nN, gid = wgid / nig, fm = gid * WGM, gsz = (nM - fm) < WGM ? (nM - fm) : WGM;
        u.pm = fm + ((wgid % nig) % gsz); u.pn = (wgid % nig) / gsz; return true;
    }
    __device__ __forceinline__ void a_ready(const Unit&) const {}
    __device__ __forceinline__ void done(const Unit&) const {}
};

__device__ __forceinline__ unsigned cvt_pk_bf16(float lo, float hi) { unsigned r; asm volatile("v_cvt_pk_bf16_f32 %0, %1, %2" : "=v"(r) : "v"(lo), "v"(hi)); return r; }
typedef float f32x2 __attribute__((ext_vector_type(2)));
__device__ __forceinline__ f32x2 gelu_pk(f32x2 v) {
    const f32x2 av = __builtin_elementwise_abs(v), d = av * 0.2316418882f + 1.0f;
    f32x2 t; t.x = __builtin_amdgcn_rcpf(d.x); t.y = __builtin_amdgcn_rcpf(d.y);
    f32x2 q = t * 0.5307027145f + (-0.7265760135f); q = q * t + 0.7107068705f; q = q * t + (-0.142248368f); q = q * t + 0.127414796f; q = q * t;
    const f32x2 s = (v * v) * (-0.72134752044f);
    f32x2 e; e.x = __builtin_amdgcn_exp2f(s.x); e.y = __builtin_amdgcn_exp2f(s.y);
    const f32x2 m = v * (q * e), r = v - m;
    f32x2 o; o.x = v.x < 0.f ? m.x : r.x; o.y = v.y < 0.f ? m.y : r.y; return o;
}

template <int ACT  > struct EpiBf16 {
    static constexpr bool PERM = true, AFTER_DRAIN = false; static_assert(ACT == 0 || ACT == 1, "EpiBf16: ACT is 0 (none) or 1 (gelu_pk)");
    bf16_t* O; int ldc; const float* bias; int split_cols; size_t split_stride; float scale0;
    __device__ __forceinline__ void operator()(const f32x4 (&acc)[2][2][4][2], const Unit& u, int wr, int wc, int fr, int fq) const {
        const int row0 = u.pm * BM + wr * 64 + fr; int colt = u.pn * BM; bf16_t* base = O;
        float sc = 1.f; if (split_cols) { const int t = colt / split_cols; base += (size_t)t * split_stride; colt -= t * split_cols; if (t == 0) sc = scale0; }
        const int col0 = colt + wc * 32 + 8 * fq, bcol0 = u.pn * BM + wc * 32 + 8 * fq;
        f32x4 bv[2][2];
#pragma unroll
        for (int bj = 0; bj < 2; ++bj)
#pragma unroll
            for (int n = 0; n < 2; ++n) bv[bj][n] = bias ? *(const f32x4*)(bias + bcol0 + bj * HALF + 4 * n) : (f32x4){0.f, 0.f, 0.f, 0.f};
#pragma unroll
        for (int ai = 0; ai < 2; ++ai)
#pragma unroll
            for (int m = 0; m < 4; ++m) { bf16_t* rowp = base + (size_t)(row0 + ai * HALF + m * 16) * ldc + col0;
#pragma unroll
                for (int bj = 0; bj < 2; ++bj) { f32x4 v0 = acc[ai][bj][m][0] + bv[bj][0], v1 = acc[ai][bj][m][1] + bv[bj][1];
                    if (ACT == 1) { f32x2 a = gelu_pk((f32x2){v0[0], v0[1]}), b = gelu_pk((f32x2){v0[2], v0[3]}), c = gelu_pk((f32x2){v1[0], v1[1]}), d = gelu_pk((f32x2){v1[2], v1[3]});
                        v0 = (f32x4){a.x, a.y, b.x, b.y}; v1 = (f32x4){c.x, c.y, d.x, d.y}; }
                    v0 = v0 * sc; v1 = v1 * sc; u32x4 w; w.x = cvt_pk_bf16(v0[0], v0[1]); w.y = cvt_pk_bf16(v0[2], v0[3]); w.z = cvt_pk_bf16(v1[0], v1[1]); w.w = cvt_pk_bf16(v1[2], v1[3]);
                    *(u32x4*)(rowp + bj * HALF) = w; } }
    }
};
typedef int i32x8 __attribute__((ext_vector_type(8)));
template <class Epi, class Sched, bool ALIGN_EPI = false, bool SP2 = false, bool GATHER = false, bool FP8 = false>
__device__ __forceinline__ void gemm_phase(PG8_LAS unsigned char* lds, const Gemm g, const Sched& S, const Epi& E, const PG8_LAS unsigned short* rowl = nullptr) {
    static_assert(!GATHER || SP2, "GATHER is implemented for the SP2 loop only");
    const int tid = threadIdx.x, wid = __builtin_amdgcn_readfirstlane(tid >> 6), lane = tid & 63, wr = wid >> 2, wc = wid & 3, fr = lane & 15, fq = lane >> 4;
    const int K = g.K, nt = K / BK;
    unsigned voffA[2], voffB[2];
#pragma unroll
    for (int i = 0; i < 2; ++i) { int R, C; stage_rc(tid * 16 + i * 8192, R, C); const int Rb = Epi::PERM ? ((R & ~31) + perm32(R & 31)) : R;
        voffA[i] = (unsigned)(R * K + C) * 2u; voffB[i] = (unsigned)(Rb * K + C) * 2u; }
    const size_t kstep = (size_t)(BK * 2);
    const size_t hstep = (size_t)HALF * K * 2;
    const size_t tstep = 2 * hstep;
    const unsigned ldsw = (unsigned)wid * 1024u;
    const int aoff = lds_byte(wr * 64 + fr, fq * 8), boff = lds_byte(wc * 32 + fr, fq * 8);
#define PG8_SA(b, h) (((b) * 2 + (h)) * HTB)
#define PG8_SB(b, h) ((4 + (b) * 2 + (h)) * HTB)
#define PG8_STAGE(bufoff, gbase, voff) do { _Pragma("unroll") for (int _i = 0; _i < 2; ++_i) \
        __builtin_amdgcn_global_load_lds((const unsigned*)((const char*)(gbase) + (voff)[_i]), (PG8_LAS unsigned*)(lds + (bufoff) + ldsw + _i * 8192), 16, 0, 0); } while (0)
#define PG8_STAGE_AG(bufoff, kb, rw, h) do { _Pragma("unroll") for (int _i = 0; _i < 2; ++_i) \
        __builtin_amdgcn_global_load_lds((const unsigned*)((const char*)g.A + (kb) + (rw)[h][_i]), (PG8_LAS unsigned*)(lds + (bufoff) + ldsw + _i * 8192), 16, 0, 0); } while (0)
#define PG8_ROWS(rw, uidx) do { _Pragma("unroll") for (int _h = 0; _h < 2; ++_h) _Pragma("unroll") for (int _i = 0; _i < 2; ++_i) { int R_, C_; stage_rc(tid * 16 + _i * 8192, R_, C_); \
        (rw)[_h][_i] = (unsigned)rowl[(uidx) * 256 + _h * 128 + R_] * (unsigned)(K * 2) + (unsigned)(C_ * 2); } } while (0)
#define PG8_RD16(off) (*(const PG8_LAS bf16x8*)(lds + (off)))
#define PG8_CAT2(x, y) __builtin_bit_cast(i32x8, __builtin_shufflevector((x), (y), 0, 1, 2, 3, 4, 5, 6, 7, 8, 9, 10, 11, 12, 13, 14, 15))
#define PG8_LDA(dst, b, h) do { if constexpr (FP8) { _Pragma("unroll") for (int m = 0; m < 4; ++m) dst##8[m] = PG8_CAT2(PG8_RD16(PG8_SA(b, h) + aoff + m * 2048), PG8_RD16(PG8_SA(b, h) + aoff + m * 2048 + 1024)); } \
        else { _Pragma("unroll") for (int m = 0; m < 4; ++m) _Pragma("unroll") for (int k = 0; k < 2; ++k) dst[m][k] = PG8_RD16(PG8_SA(b, h) + aoff + m * 2048 + k * 1024); } } while (0)
#define PG8_LDB(dst, b, h) do { if constexpr (FP8) { _Pragma("unroll") for (int n = 0; n < 2; ++n) dst##8[n] = PG8_CAT2(PG8_RD16(PG8_SB(b, h) + boff + n * 2048), PG8_RD16(PG8_SB(b, h) + boff + n * 2048 + 1024)); } \
        else { _Pragma("unroll") for (int n = 0; n < 2; ++n) _Pragma("unroll") for (int k = 0; k < 2; ++k) dst[n][k] = PG8_RD16(PG8_SB(b, h) + boff + n * 2048 + k * 1024); } } while (0)
#define PG8_MMA(ai, bj, At, Bt) do { __builtin_amdgcn_s_setprio(1); if constexpr (FP8) { _Pragma("unroll") for (int m = 0; m < 4; ++m) _Pragma("unroll") for (int n = 0; n < 2; ++n) \
        asm volatile("v_mfma_scale_f32_16x16x128_f8f6f4 %0, %1, %2, %0, %3, %3 op_sel_hi:[0,0,0]" : "+v"(acc[ai][bj][m][n]) : "v"(Bt##8[n]), "v"(At##8[m]), "v"(f8scale)); } else { \
        _Pragma("unroll") for (int m = 0; m < 4; ++m) _Pragma("unroll") for (int n = 0; n < 2; ++n) _Pragma("unroll") for (int k = 0; k < 2; ++k) \
        acc[ai][bj][m][n] = __builtin_amdgcn_mfma_f32_16x16x32_bf16(Bt[n][k], At[m][k], acc[ai][bj][m][n], 0, 0, 0); } __builtin_amdgcn_s_setprio(0); } while (0)
#define PG8_WAIT_V(n) asm volatile("s_waitcnt vmcnt(" #n ")" ::: "memory")
#define PG8_WAIT_L(n) asm volatile("s_waitcnt lgkmcnt(" #n ")" ::: "memory")
#define PG8_BAR __builtin_amdgcn_s_barrier()
#define PG8_SCHED __builtin_amdgcn_sched_barrier(0)
    Unit cur, nxt; int ui = 0;
    if (!S.next(0, cur)) return;
    f32x4 acc[2][2][4][2];
#pragma unroll
    for (int a = 0; a < 2; ++a)
#pragma unroll
        for (int b = 0; b < 2; ++b)
#pragma unroll
            for (int m = 0; m < 4; ++m)
#pragma unroll
                for (int n = 0; n < 2; ++n) acc[a][b][m][n] = (f32x4){0.f, 0.f, 0.f, 0.f};
    const int f8scale = 0x7f7f7f7f;
    bf16x8 At[4][2], B0[2][2], B1[2][2]; i32x8 At8[4], B08[2], B18[2];
    const char* cA = (const char*)g.A + (size_t)cur.pm * tstep; const char* cB = (const char*)g.Bt + (size_t)cur.pn * tstep;
    S.a_ready(cur);
    unsigned rowC[2][2], rowN[2][2];
    if constexpr (GATHER) { PG8_ROWS(rowC, 0); _Pragma("unroll") for (int h_ = 0; h_ < 2; ++h_) _Pragma("unroll") for (int i_ = 0; i_ < 2; ++i_) rowN[h_][i_] = rowC[h_][i_]; }
    if constexpr (SP2) {
        PG8_STAGE(PG8_SB(0, 0), cB, voffB); PG8_STAGE(PG8_SB(0, 1), cB + hstep, voffB);
        if constexpr (GATHER) { PG8_STAGE_AG(PG8_SA(0, 0), (size_t)0, rowC, 0); PG8_STAGE_AG(PG8_SA(0, 1), (size_t)0, rowC, 1); } else { PG8_STAGE(PG8_SA(0, 0), cA, voffA); PG8_STAGE(PG8_SA(0, 1), cA + hstep, voffA); }
        if (wr == 1) PG8_BAR;
        PG8_WAIT_V(2); PG8_BAR;
        PG8_STAGE(PG8_SB(1, 0), cB + kstep, voffB); if constexpr (GATHER) PG8_STAGE_AG(PG8_SA(1, 0), kstep, rowC, 0); else PG8_STAGE(PG8_SA(1, 0), cA + kstep, voffA); PG8_STAGE(PG8_SB(1, 1), cB + hstep + kstep, voffB);
        PG8_WAIT_V(6); PG8_BAR;
    } else {
        PG8_STAGE(PG8_SB(0, 0), cB, voffB); PG8_STAGE(PG8_SA(0, 0), cA, voffA); PG8_STAGE(PG8_SB(0, 1), cB + hstep, voffB); PG8_STAGE(PG8_SA(0, 1), cA + hstep, voffA);
        if (wr == 1) PG8_BAR;
        PG8_WAIT_V(4); PG8_BAR;
        PG8_STAGE(PG8_SB(1, 0), cB + kstep, voffB); PG8_STAGE(PG8_SA(1, 0), cA + kstep, voffA); PG8_STAGE(PG8_SB(1, 1), cB + hstep + kstep, voffB);
        PG8_WAIT_V(6); PG8_BAR;
    }
    for (;;) {
        const bool has_next = S.next(ui + 1, nxt);
        if constexpr (GATHER) { if (has_next) PG8_ROWS(rowN, ui + 1); }
        const char* nA = has_next ? (const char*)g.A + (size_t)nxt.pm * tstep : cA; const char* nB = has_next ? (const char*)g.Bt + (size_t)nxt.pn * tstep : cB;
#pragma unroll 1
        for (int t = 0; t < nt; t += 2) {
            const bool last = (t == nt - 2);
            const char* a1 = cA + (size_t)(t + 1) * kstep;
            const char* a2 = last ? nA : cA + (size_t)(t + 2) * kstep; const char* b2 = last ? nB : cB + (size_t)(t + 2) * kstep;
            const char* a3 = a2 + kstep; const char* b3 = b2 + kstep;
            if (last && has_next) S.a_ready(nxt);
            if constexpr (SP2) {
            unsigned rs[2][2]; size_t k2 = 0;
            if constexpr (GATHER) { k2 = last ? (size_t)0 : (size_t)(t + 2) * kstep; _Pragma("unroll") for (int h_ = 0; h_ < 2; ++h_) _Pragma("unroll") for (int i_ = 0; i_ < 2; ++i_) rs[h_][i_] = last ? rowN[h_][i_] : rowC[h_][i_]; }
            PG8_LDB(B0, 0, 0); PG8_LDB(B1, 0, 1); PG8_SCHED; PG8_LDA(At, 0, 0); if constexpr (GATHER) PG8_STAGE_AG(PG8_SA(1, 1), (size_t)(t + 1) * kstep, rowC, 1); else PG8_STAGE(PG8_SA(1, 1), a1 + hstep, voffA);
            PG8_WAIT_V(8); PG8_WAIT_L(0); PG8_BAR; PG8_MMA(0, 0, At, B0); PG8_MMA(0, 1, At, B1); PG8_BAR; PG8_SCHED;
            PG8_LDA(At, 0, 1); PG8_STAGE(PG8_SB(0, 0), b2, voffB); PG8_STAGE(PG8_SB(0, 1), b2 + hstep, voffB); if constexpr (GATHER) PG8_STAGE_AG(PG8_SA(0, 0), k2, rs, 0); else PG8_STAGE(PG8_SA(0, 0), a2, voffA);
            PG8_WAIT_V(8); PG8_WAIT_L(0); PG8_BAR; PG8_MMA(1, 0, At, B0); PG8_MMA(1, 1, At, B1); PG8_BAR; PG8_SCHED;
            PG8_LDB(B0, 1, 0); PG8_LDB(B1, 1, 1); PG8_SCHED; PG8_LDA(At, 1, 0); if constexpr (GATHER) PG8_STAGE_AG(PG8_SA(0, 1), k2, rs, 1); else PG8_STAGE(PG8_SA(0, 1), a2 + hstep, voffA);
            PG8_WAIT_V(8); PG8_WAIT_L(0); PG8_BAR; PG8_MMA(0, 0, At, B0); PG8_MMA(0, 1, At, B1); PG8_BAR; PG8_SCHED;
            PG8_LDA(At, 1, 1); PG8_STAGE(PG8_SB(1, 0), b3, voffB); PG8_STAGE(PG8_SB(1, 1), b3 + hstep, voffB); if constexpr (GATHER) PG8_STAGE_AG(PG8_SA(1, 0), k2 + kstep, rs, 0); else PG8_STAGE(PG8_SA(1, 0), a3, voffA);
            PG8_WAIT_V(8); PG8_WAIT_L(0); PG8_BAR; PG8_MMA(1, 0, At, B0); PG8_MMA(1, 1, At, B1); PG8_BAR; PG8_SCHED;
            } else {
            PG8_LDB(B0, 0, 0); PG8_SCHED; PG8_LDA(At, 0, 0); PG8_STAGE(PG8_SA(1, 1), a1 + hstep, voffA);
            PG8_WAIT_L(8); PG8_BAR; PG8_WAIT_L(0); PG8_MMA(0, 0, At, B0); PG8_BAR; PG8_SCHED;
            PG8_LDB(B1, 0, 1); PG8_STAGE(PG8_SB(0, 0), b2, voffB);
            PG8_BAR; PG8_WAIT_L(0); PG8_MMA(0, 1, At, B1); PG8_BAR;
            PG8_LDA(At, 0, 1); PG8_STAGE(PG8_SA(0, 0), a2, voffA);
            PG8_BAR; PG8_WAIT_L(0); PG8_MMA(1, 0, At, B0); PG8_BAR; PG8_SCHED;
            PG8_STAGE(PG8_SB(0, 1), b2 + hstep, voffB);
            PG8_WAIT_V(6); PG8_BAR; PG8_MMA(1, 1, At, B1); PG8_BAR;
            PG8_LDB(B0, 1, 0); PG8_SCHED; PG8_LDA(At, 1, 0); PG8_STAGE(PG8_SA(0, 1), a2 + hstep, voffA);
            PG8_WAIT_L(8); PG8_BAR; PG8_WAIT_L(0); PG8_MMA(0, 0, At, B0); PG8_BAR; PG8_SCHED;
            PG8_LDB(B1, 1, 1); PG8_STAGE(PG8_SB(1, 0), b3, voffB);
            PG8_BAR; PG8_WAIT_L(0); PG8_MMA(0, 1, At, B1); PG8_BAR;
            PG8_LDA(At, 1, 1); PG8_STAGE(PG8_SA(1, 0), a3, voffA);
            PG8_BAR; PG8_WAIT_L(0); PG8_MMA(1, 0, At, B0); PG8_BAR; PG8_SCHED;
            PG8_STAGE(PG8_SB(1, 1), b3 + hstep, voffB);
            PG8_WAIT_V(6); PG8_BAR; PG8_MMA(1, 1, At, B1); PG8_BAR;
            }
        }
        if constexpr (ALIGN_EPI) { if (wr == 0) PG8_BAR; }
        if constexpr (!Epi::AFTER_DRAIN) { E(acc, cur, wr, wc, fr, fq); S.done(cur); }
        if (!has_next) break;
#pragma unroll
        for (int a = 0; a < 2; ++a)
#pragma unroll
            for (int b = 0; b < 2; ++b)
#pragma unroll
                for (int m = 0; m < 4; ++m)
#pragma unroll
                    for (int n = 0; n < 2; ++n) acc[a][b][m][n] = (f32x4){0.f, 0.f, 0.f, 0.f};
        cur = nxt; cA = nA; cB = nB; ++ui;
        if constexpr (GATHER) { _Pragma("unroll") for (int h_ = 0; h_ < 2; ++h_) _Pragma("unroll") for (int i_ = 0; i_ < 2; ++i_) rowC[h_][i_] = rowN[h_][i_]; }
        if constexpr (ALIGN_EPI) { if (wr == 1) PG8_BAR; }
    }
    PG8_WAIT_V(0);
    if constexpr (!ALIGN_EPI) { if (wr == 0) PG8_BAR; }
    PG8_BAR;
    if constexpr (Epi::AFTER_DRAIN) { E.fused(acc, cur, wr, wc, fr, fq, lds, wid, lane); S.done(cur); }
#undef PG8_SA
#undef PG8_SB
#undef PG8_STAGE
#undef PG8_STAGE_AG
#undef PG8_ROWS
#undef PG8_CAT2
#undef PG8_RD16
#undef PG8_LDA
#undef PG8_LDB
#undef PG8_MMA
#undef PG8_WAIT_V
#undef PG8_WAIT_L
#undef PG8_BAR
#undef PG8_SCHED
}
}

constexpr int NWAVES = 8;
#ifndef MK_N_LAUNCHES
#define MK_N_LAUNCHES 1
#endif
constexpr int PER_PHASE = 10;
constexpr int N_LAUNCHES = MK_N_LAUNCHES;

constexpr int NB = 16, SEQ = 2048, T = NB * SEQ, D = 1024, NIN = 3328, NE = 32, TOPK = 4, DFF = 2048;
constexpr int MAXTILES = T * TOPK / 256 + NE;
constexpr int MAXSLOTS = MAXTILES * 256;
constexpr int NCHUNK = 256, CHUNK_TOK = T / NCHUNK;
constexpr float LN_EPS = 1e-5f, RMS_EPS = 1e-6f, DN_ALPHA = 1.18920711500272f, SWIGLU_LIMIT = 7.0f, SWIGLU_ALPHA = 1.702f;

constexpr size_t MiB = 1u << 20;
constexpr size_t WS_CTL = 0, CTL_ZERO_BYTES = 1 * MiB;
constexpr size_t WS_TAB = 1 * MiB;
constexpr size_t WS_WIN = 2 * MiB, WS_WOUT = 9 * MiB, WS_WUP = 11 * MiB, WS_WD = 139 * MiB;
constexpr size_t WS_H1 = 203 * MiB;
constexpr size_t WS_TOPI = 267 * MiB, WS_TOPG = 268 * MiB, WS_SLOT = 269 * MiB, WS_ROWTOK = 270 * MiB, WS_GATES = 271 * MiB;
constexpr size_t WS_H0 = 272 * MiB, WS_QA = 336 * MiB, WS_KA = 368 * MiB, WS_VA = 376 * MiB, WS_QH = 384 * MiB, WS_IH = 416 * MiB, WS_LF = 448 * MiB, WS_LB = 512 * MiB,
                 WS_ZG = 576 * MiB, WS_OF = 608 * MiB, WS_OB = 672 * MiB, WS_MIX = 736 * MiB, WS_U = 800 * MiB;
constexpr size_t WS_XG = 272 * MiB, WS_ACT = 544 * MiB, WS_Y = 272 * MiB, WS_H1F8 = 680 * MiB, WS_END = 928 * MiB;
constexpr float F8_SA = 16.0f, F8_SWU = 64.0f, F8_SACT = 4.0f, F8_SWD = 64.0f, F8_SY = 64.0f;
constexpr int CW_TMO = 0, CW_CODE = 1, CW_BAR = 4096;

constexpr int RING_OFF = 0, RING_BYTES = 131072;
constexpr int TAB_OFF = 131072;
constexpr int HIST_OFF = 133248;
constexpr int ROWL_OFF = 133376, MAXUNITS_WG = 17;
constexpr int DG_OFF = 142080, MAXDOWN_WG = 9;
constexpr int LDSCTL_OFF = 160512, MISC_OFF = LDSCTL_OFF + 320;
constexpr int LDS_BYTES = 163840;
static_assert(TAB_OFF + MAXTILES * 4 <= HIST_OFF && HIST_OFF + 128 <= ROWL_OFF && ROWL_OFF + MAXUNITS_WG * 512 <= DG_OFF && DG_OFF + MAXDOWN_WG * 2048 <= LDSCTL_OFF && MISC_OFF + 128 <= LDS_BYTES, "LDS map");
#define GAS __attribute__((address_space(1)))
#define LAS __attribute__((address_space(3)))
typedef unsigned short bf16;
typedef unsigned v4u __attribute__((ext_vector_type(4)));
typedef float f32x4 __attribute__((ext_vector_type(4)));
typedef short bf16x8 __attribute__((ext_vector_type(8)));
typedef GAS unsigned gu32;
typedef GAS unsigned long long gu64;
#define RLX_AGENT __ATOMIC_RELAXED, __HIP_MEMORY_SCOPE_AGENT
#define LDS_WAIT() asm volatile("s_waitcnt lgkmcnt(0)" ::: "memory")
#define VM_WAIT() asm volatile("s_waitcnt vmcnt(0)" ::: "memory")
__device__ __forceinline__ unsigned long long rt() { return __builtin_amdgcn_s_memrealtime(); }
__device__ __forceinline__ unsigned f2bf(float f) { unsigned u = __builtin_bit_cast(unsigned, f); return (u + 0x7fffu + ((u >> 16) & 1u)) >> 16; }
__device__ __forceinline__ unsigned pk2(float lo, float hi) { return f2bf(lo) | (f2bf(hi) << 16); }
#define XB_TMO      128
#define XB_XCNT(j)  (256  + 64 * (j))
#define XB_XSUB(j)  (1280 + 64 * (j))
#define XB_XGEN(j)  (2304 + 64 * (j))
#define XB_TOP      3328
#define XB_TOPGEN   3392
#define XCD_BAR_WORDS 3456
#define XB_SPIN_CAP (1u << 18)

__device__ __forceinline__ unsigned xb_ld(unsigned* p)              { return __hip_atomic_load(p, __ATOMIC_RELAXED, __HIP_MEMORY_SCOPE_AGENT); }
__device__ __forceinline__ unsigned xb_add(unsigned* p, unsigned v) { return __hip_atomic_fetch_add(p, v, __ATOMIC_RELAXED, __HIP_MEMORY_SCOPE_AGENT); }
__device__ __forceinline__ unsigned xb_xcc_id() { return (unsigned)__builtin_amdgcn_s_getreg((3 << 11) | 20) & 0xFu; }
#define XB_SPIN(cond, bar) do { unsigned _sp = 0; while (cond) { __builtin_amdgcn_s_sleep(1); \
    if ((++_sp & 255u) == 0u) { if (xb_ld(&(bar)[XB_TMO])) break; if (_sp > XB_SPIN_CAP) { atomicAdd(&(bar)[XB_TMO], 1u); break; } } } } while (0)

struct XcdBarrier {
    unsigned* bar; unsigned x;
    volatile LAS unsigned* st;
};

__device__ __forceinline__ XcdBarrier xcd_barrier_post(unsigned* bar, volatile LAS unsigned* st) {
    XcdBarrier b; b.bar = bar; b.x = xb_xcc_id(); b.st = st;
    if (threadIdx.x == 0) (void)xb_add(&bar[XB_XCNT(b.x)], 1u);
    return b;
}
__device__ __forceinline__ void xcd_barrier_complete(unsigned* bar, unsigned x, unsigned& nloc, unsigned& nx) {
    const unsigned G = gridDim.x * gridDim.y * gridDim.z;
    unsigned sum, cnt, mine, sp = 0u;
    for (;;) {
        sum = 0u; cnt = 0u; mine = 0u;
#pragma unroll
        for (unsigned j = 0; j < 16; ++j) { const unsigned c = xb_ld(&bar[XB_XCNT(j)]); sum += c; cnt += (c > 0u) ? 1u : 0u; mine = (j == x) ? c : mine; }
        if (sum == G) break;
        __builtin_amdgcn_s_sleep(1);
        if ((++sp & 255u) == 0u) { if (xb_ld(&bar[XB_TMO])) break; if (sp > XB_SPIN_CAP) { atomicAdd(&bar[XB_TMO], 1u); break; } }
    }
    nloc = mine > 0u ? mine : 1u; nx = cnt > 0u ? cnt : 1u;
}

__device__ __forceinline__ void xcd_barrier(const XcdBarrier& b) {
    asm volatile("s_waitcnt vmcnt(0)" ::: "memory");
    __syncthreads();
    if (threadIdx.x == 0) {
        unsigned* bar = b.bar;
        __builtin_amdgcn_s_waitcnt(0);
        unsigned nloc = b.st[0], nx = b.st[1];
        if (nloc == 0u) { xcd_barrier_complete(bar, b.x, nloc, nx); b.st[0] = nloc; b.st[1] = nx; }
        const unsigned old = xb_add(&bar[XB_XSUB(b.x)], 1u);
        const unsigned gen = old / nloc;
        if (old + 1u == (gen + 1u) * nloc) {
            __builtin_amdgcn_fence(__ATOMIC_RELEASE, "agent");
            asm volatile("s_waitcnt vmcnt(0)" ::: "memory");
            const unsigned og = xb_add(&bar[XB_TOP], 1u);
            const unsigned tg = og / nx;
            if (og + 1u == (tg + 1u) * nx) xb_add(&bar[XB_TOPGEN], 1u);
            else XB_SPIN(xb_ld(&bar[XB_TOPGEN]) == tg, bar);
            __builtin_amdgcn_fence(__ATOMIC_ACQUIRE, "agent");
            xb_add(&bar[XB_XGEN(b.x)], 1u);
            asm volatile("s_waitcnt vmcnt(0)" ::: "memory");
        } else {
            XB_SPIN(xb_ld(&bar[XB_XGEN(b.x)]) == gen, bar);
            __builtin_amdgcn_fence(__ATOMIC_ACQUIRE, "agent");
            asm volatile("s_waitcnt vmcnt(0)" ::: "memory");
        }
    }
    __syncthreads();
}

typedef unsigned u32x2 __attribute__((ext_vector_type(2)));
typedef float f32x2_t __attribute__((ext_vector_type(2)));
typedef __bf16 bf16x2_t __attribute__((ext_vector_type(2)));
__device__ __forceinline__ float bflo(unsigned w) { return __uint_as_float(w << 16); }
__device__ __forceinline__ float bfhi(unsigned w) { return __uint_as_float(w & 0xffff0000u); }
__device__ __forceinline__ float fsigmoid(float z) { return __builtin_amdgcn_rcpf(1.0f + __expf(-z)); }
__device__ __forceinline__ v4u pack8(const f32x4 a, const f32x4 b) { v4u w; w.x = pg8::cvt_pk_bf16(a[0], a[1]); w.y = pg8::cvt_pk_bf16(a[2], a[3]); w.z = pg8::cvt_pk_bf16(b[0], b[1]); w.w = pg8::cvt_pk_bf16(b[2], b[3]); return w; }
__device__ __forceinline__ float clamp448(float x) { return __builtin_amdgcn_fmed3f(x, -448.0f, 448.0f); }
__device__ __forceinline__ unsigned pk4_fp8(float a, float b, float c, float d) { int w = __builtin_amdgcn_cvt_pk_fp8_f32(clamp448(a), clamp448(b), 0, false); w = __builtin_amdgcn_cvt_pk_fp8_f32(clamp448(c), clamp448(d), w, true); return (unsigned)w; }
__device__ __forceinline__ unsigned pk4_fp8_nc(float a, float b, float c, float d) { int w = __builtin_amdgcn_cvt_pk_fp8_f32(a, b, 0, false); w = __builtin_amdgcn_cvt_pk_fp8_f32(c, d, w, true); return (unsigned)w; }
__device__ __forceinline__ float wave_sum(float v) {
#pragma unroll
    for (int o = 1; o < 64; o <<= 1) v += __shfl_xor(v, o);
    return v;
}

struct EpiInProj {
    static constexpr bool PERM = true, AFTER_DRAIN = false;
    bf16 *QA, *KA, *VA, *QH, *IH, *ZG, *LF, *LB; const float *lbl, *normg;
    __device__ __forceinline__ void operator()(const f32x4 (&acc)[2][2][4][2], const pg8::Unit& u, int wr, int wc, int fr, int fq) const {
        const int row0 = u.pm * 256 + wr * 64 + fr, cl = wc * 32 + 8 * fq, pn = u.pn;
        if (pn == 2) {
#pragma unroll
            for (int ai = 0; ai < 2; ++ai)
#pragma unroll
                for (int m = 0; m < 4; ++m) { const size_t r = (size_t)(row0 + ai * 128 + m * 16);
                    *(v4u*)(KA + r * 128 + cl) = pack8(acc[ai][0][m][0], acc[ai][0][m][1]);
                    *(v4u*)(VA + r * 128 + cl) = pack8(acc[ai][1][m][0], acc[ai][1][m][1]); }
        } else if (pn < 7) {
            bf16* base = pn < 2 ? QA + pn * 256 : (pn < 5 ? QH + (pn - 3) * 256 : IH + (pn - 5) * 256);
            const float qs = pn < 2 ? 0.125f * 1.4426950408889634f : 1.0f;
#pragma unroll
            for (int ai = 0; ai < 2; ++ai)
#pragma unroll
                for (int m = 0; m < 4; ++m) { bf16* rowp = base + (size_t)(row0 + ai * 128 + m * 16) * 512 + cl;
#pragma unroll
                    for (int bj = 0; bj < 2; ++bj) *(v4u*)(rowp + bj * 128) = pack8(acc[ai][bj][m][0] * qs, acc[ai][bj][m][1] * qs); }
        } else if (pn < 11) {
            const int dir = pn >= 9 ? 1 : 0, cb = (pn - (dir ? 9 : 7)) * 256; bf16* base = (dir ? LB : LF) + cb;
#pragma unroll
            for (int bj = 0; bj < 2; ++bj) {
                float lb[8];
#pragma unroll
                for (int j = 0; j < 8; ++j) { const int col = cb + bj * 128 + cl + j; const float a0 = lbl[dir * 1024 + col], a1 = lbl[dir * 1024 + 512 + col]; lb[j] = 1.0f / (1.0f + __expf(a1 - a0)); }
#pragma unroll
                for (int ai = 0; ai < 2; ++ai)
#pragma unroll
                    for (int m = 0; m < 4; ++m) { bf16* rowp = base + (size_t)(row0 + ai * 128 + m * 16) * 512 + bj * 128 + cl;
                        f32x4 o0, o1, z0 = acc[ai][bj][m][0], z1 = acc[ai][bj][m][1];
                        asm volatile("" : "+v"(z0), "+v"(z1) :: "memory");
#pragma unroll
                        for (int j = 0; j < 4; ++j) { o0[j] = __logf(lb[j] + (1.0f - lb[j]) * fsigmoid(z0[j])); o1[j] = __logf(lb[4 + j] + (1.0f - lb[4 + j]) * fsigmoid(z1[j])); }
                        *(v4u*)rowp = pack8(o0, o1); }
            }
        } else {
            const int cb = (pn - 11) * 256;
#pragma unroll
            for (int bj = 0; bj < 2; ++bj) {
                const f32x4 g0 = *(const f32x4*)(normg + cb + bj * 128 + cl), g1 = *(const f32x4*)(normg + cb + bj * 128 + cl + 4);
#pragma unroll
                for (int ai = 0; ai < 2; ++ai)
#pragma unroll
                    for (int m = 0; m < 4; ++m) { bf16* rowp = ZG + (size_t)(row0 + ai * 128 + m * 16) * 512 + cb + bj * 128 + cl;
                        f32x4 o0, o1, y0 = acc[ai][bj][m][0], y1 = acc[ai][bj][m][1];
                        asm volatile("" : "+v"(y0), "+v"(y1) :: "memory");
#pragma unroll
                        for (int j = 0; j < 4; ++j) { const float z0 = y0[j], z1 = y1[j]; o0[j] = g0[j] * z0 * fsigmoid(z0); o1[j] = g1[j] * z1 * fsigmoid(z1); }
                        *(v4u*)rowp = pack8(o0, o1); }
            }
        }
    }
};
struct EpiOutProj {
    static constexpr bool PERM = true, AFTER_DRAIN = false;
    const bf16* H0; bf16* U;
    __device__ __forceinline__ void operator()(const f32x4 (&acc)[2][2][4][2], const pg8::Unit& u, int wr, int wc, int fr, int fq) const {
        const int row0 = u.pm * 256 + wr * 64 + fr, col0 = u.pn * 256 + wc * 32 + 8 * fq;
#pragma unroll
        for (int ai = 0; ai < 2; ++ai)
#pragma unroll
            for (int m = 0; m < 4; ++m) { const size_t off = (size_t)(row0 + ai * 128 + m * 16) * D + col0;
#pragma unroll
                for (int bj = 0; bj < 2; ++bj) { const v4u hb = *(const v4u*)(H0 + off + bj * 128);
                    f32x4 h0, h1; h0[0] = bflo(hb.x); h0[1] = bfhi(hb.x); h0[2] = bflo(hb.y); h0[3] = bfhi(hb.y); h1[0] = bflo(hb.z); h1[1] = bfhi(hb.z); h1[2] = bflo(hb.w); h1[3] = bfhi(hb.w);
                    *(v4u*)(U + off + bj * 128) = pack8(acc[ai][bj][m][0] + DN_ALPHA * h0, acc[ai][bj][m][1] + DN_ALPHA * h1); } }
    }
};
struct EpiUp {
    static constexpr bool PERM = false, AFTER_DRAIN = false;
    unsigned char* ACT; const float* b_up;
    __device__ __forceinline__ void operator()(const f32x4 (&acc)[2][2][4][2], const pg8::Unit& u, int wr, int wc, int fr, int fq) const {
        const int e = u.pn >> 3, p = u.pn & 7, row0 = u.pm * 256 + wr * 64 + fr, a0 = 128 * p + 32 * wc + 8 * fq;
        f32x4 bg[2], bl[2];
#pragma unroll
        for (int bj = 0; bj < 2; ++bj) { const f32x4 x = *(const f32x4*)(b_up + e * DFF + 2 * (a0 + 4 * bj)), y = *(const f32x4*)(b_up + e * DFF + 2 * (a0 + 4 * bj) + 4);
            bg[bj] = (f32x4){x[0], x[2], y[0], y[2]}; bl[bj] = (f32x4){x[1], x[3], y[1], y[3]}; }
#pragma unroll
        for (int ai = 0; ai < 2; ++ai)
#pragma unroll
            for (int m = 0; m < 4; ++m) { f32x4 o[2], zg[2] = {acc[ai][0][m][0], acc[ai][1][m][0]}, zl[2] = {acc[ai][0][m][1], acc[ai][1][m][1]};
                asm volatile("" : "+v"(zg[0]), "+v"(zg[1]), "+v"(zl[0]), "+v"(zl[1]) :: "memory");
#pragma unroll
                for (int bj = 0; bj < 2; ++bj)
#pragma unroll
                    for (int j = 0; j < 4; j += 2) {
                        constexpr float SC = 1.0f / (F8_SA * F8_SWU), NE2 = -SWIGLU_ALPHA * 1.4426950408889634f;
                        f32x2_t g2 = (f32x2_t){zg[bj][j], zg[bj][j + 1]} * SC + (f32x2_t){bg[bj][j], bg[bj][j + 1]}; g2[0] = fminf(g2[0], SWIGLU_LIMIT); g2[1] = fminf(g2[1], SWIGLU_LIMIT);
                        f32x2_t l2 = (f32x2_t){zl[bj][j], zl[bj][j + 1]} * SC + (f32x2_t){bl[bj][j], bl[bj][j + 1]}; l2[0] = __builtin_amdgcn_fmed3f(l2[0], -SWIGLU_LIMIT, SWIGLU_LIMIT); l2[1] = __builtin_amdgcn_fmed3f(l2[1], -SWIGLU_LIMIT, SWIGLU_LIMIT);
                        f32x2_t e2 = g2 * NE2; e2[0] = __builtin_amdgcn_exp2f(e2[0]); e2[1] = __builtin_amdgcn_exp2f(e2[1]); e2 = e2 + 1.0f;
                        f32x2_t r2; r2[0] = __builtin_amdgcn_rcpf(e2[0]); r2[1] = __builtin_amdgcn_rcpf(e2[1]);
                        const f32x2_t o2 = (g2 * r2) * (l2 * F8_SACT + F8_SACT);
                        o[bj][j] = o2[0]; o[bj][j + 1] = o2[1]; }
                u32x2 pw; pw.x = pk4_fp8_nc(o[0][0], o[0][1], o[0][2], o[0][3]); pw.y = pk4_fp8_nc(o[1][0], o[1][1], o[1][2], o[1][3]);
                *(u32x2*)(ACT + (size_t)(row0 + ai * 128 + m * 16) * D + a0) = pw; }
    }
};
struct EpiDown {
    static constexpr bool PERM = false, AFTER_DRAIN = false;
    unsigned char* Y; const LAS u32x2* dg; const float* b_down;
    __device__ __forceinline__ void operator()(const f32x4 (&acc)[2][2][4][2], const pg8::Unit& u, int wr, int wc, int fr, int fq) const {
        const int e = u.pn >> 2, colt = (u.pn & 3) * 256 + wc * 64 + 16 * fq, r0 = u.ord * 256 + wr * 64 + fr;
        int dest[2][4]; float gt[2][4];
#pragma unroll
        for (int ai = 0; ai < 2; ++ai)
#pragma unroll
            for (int m = 0; m < 4; ++m) { const u32x2 t = dg[r0 + ai * 128 + m * 16]; dest[ai][m] = (int)t.x; gt[ai][m] = __uint_as_float(t.y); }
        f32x4 bv[2][2];
#pragma unroll
        for (int bj = 0; bj < 2; ++bj)
#pragma unroll
            for (int n = 0; n < 2; ++n) bv[bj][n] = *(const f32x4*)(b_down + e * D + colt + 8 * bj + 4 * n);
#pragma unroll
        for (int ai = 0; ai < 2; ++ai)
#pragma unroll
            for (int m = 0; m < 4; ++m) { const float g = gt[ai][m];
                if (dest[ai][m] >= 0) { v4u pw; unsigned pq[4];
#pragma unroll
                    for (int bj = 0; bj < 2; ++bj)
#pragma unroll
                        for (int n = 0; n < 2; ++n) { const f32x4 y = (acc[ai][bj][m][n] * (1.0f / (F8_SACT * F8_SWD)) + bv[bj][n]) * g; pq[2 * bj + n] = pk4_fp8(y[0], y[1], y[2], y[3]); }
                    pw.x = pq[0]; pw.y = pq[1]; pw.z = pq[2]; pw.w = pq[3];
                    *(v4u*)(Y + (size_t)dest[ai][m] * D + colt) = pw; } }
    }
};
struct EpiNull { static constexpr bool PERM = false, AFTER_DRAIN = false; int* sink;
    __device__ __forceinline__ void operator()(const f32x4 (&acc)[2][2][4][2], const pg8::Unit& u, int wr, int wc, int fr, int fq) const { if (acc[0][0][0][0][0] == 1.2345e-33f) sink[0] = 1; } };
__device__ __forceinline__ int moe_tile(int i, int c, int nN) { const int slot = c >> 3, g = i * 8 + (c & 7); return nN == 8 ? g * 4 + (slot >> 3) : g * 8 + (slot >> 2); }
struct MoeOrder {
    const LAS int* tileExpert; int ntiles, nN, G, c;
    __device__ __forceinline__ bool next(int i, pg8::Unit& u) const {
        int tile, n;
        if (G == 256) { tile = moe_tile(i, c, nN); n = (c >> 3) & (nN - 1); }
        else { const int L = i * G + c; tile = L / nN; n = L - tile * nN; }
        if (tile >= ntiles) return false;
        u.pm = tile; u.pn = tileExpert[tile] * nN + n; u.ord = i; return true;
    }
    __device__ __forceinline__ void a_ready(const pg8::Unit&) const {}
    __device__ __forceinline__ void done(const pg8::Unit&) const {}
};

struct Frame {
    LAS unsigned char* lds;
    volatile LAS unsigned* MISC;
    gu32* ctl;
    int tid, lane, wave;
    int vcu, G;
    const __attribute__((address_space(4))) unsigned char* ka;
    float* out; unsigned char* ws;
};
#define FIN(F_, k_) (*(const float* const __attribute__((address_space(4)))*)((F_).ka + 8 * (k_)))

__device__ __forceinline__ int up_srccol(int dn) { const int p = dn >> 8, rho = dn & 255, bj = rho >> 7, wc = (rho >> 5) & 3, n = (rho >> 4) & 1, fq = (rho >> 2) & 3, j = rho & 3;
    return 2 * (128 * p + 32 * wc + 8 * fq + 4 * bj + j) + n; }
template <bool UPPERM>
__device__ __forceinline__ void p0_transpose_item(const float* W, int K, int N, bf16* WT, LAS float* scr, int item, int lane) {
    const int nblk = N / 32, kb = item / nblk, nb = item % nblk, k0 = 64 * kb, n0 = 32 * nb;
    const int sc = UPPERM ? up_srccol(n0 + (lane & 31)) : n0 + (lane & 31);
#pragma unroll 8
    for (int i = 0; i < 32; ++i) { const int kk = 2 * i + (lane >> 5); scr[kk * 33 + (lane & 31)] = W[(size_t)(k0 + kk) * N + sc]; }
    LDS_WAIT(); asm volatile("" ::: "memory");
    const int c = lane & 7;
#pragma unroll
    for (int j = 0; j < 4; ++j) { const int n = (lane >> 3) + 8 * j; const LAS float* s = scr + (8 * c) * 33 + n;
        v4u o; o.x = pk2(s[0 * 33], s[1 * 33]); o.y = pk2(s[2 * 33], s[3 * 33]); o.z = pk2(s[4 * 33], s[5 * 33]); o.w = pk2(s[6 * 33], s[7 * 33]);
        *(GAS v4u*)(WT + (size_t)(n0 + n) * K + k0 + 8 * c) = o; }
    LDS_WAIT(); asm volatile("" ::: "memory");
}
template <bool UPPERM>
__device__ __forceinline__ void p0_transpose_item_f8(const float* W, int K, int N, unsigned char* WT, LAS float* scr, int item, int lane, float scale) {
    const int nblk = N / 32, kb = item / nblk, nb = item % nblk, k0 = 64 * kb, n0 = 32 * nb;
    const int sc = UPPERM ? up_srccol(n0 + (lane & 31)) : n0 + (lane & 31);
#pragma unroll 8
    for (int i = 0; i < 32; ++i) { const int kk = 2 * i + (lane >> 5); scr[kk * 33 + (lane & 31)] = W[(size_t)(k0 + kk) * N + sc]; }
    LDS_WAIT(); asm volatile("" ::: "memory");
    const int n = lane >> 1, hf = lane & 1; const LAS float* s = scr + (32 * hf) * 33 + n;
    unsigned o[8];
#pragma unroll
    for (int q = 0; q < 8; ++q) o[q] = pk4_fp8(s[(4 * q) * 33] * scale, s[(4 * q + 1) * 33] * scale, s[(4 * q + 2) * 33] * scale, s[(4 * q + 3) * 33] * scale);
    GAS v4u* dst = (GAS v4u*)(WT + (size_t)(n0 + n) * K + k0 + 32 * hf);
    dst[0] = (v4u){o[0], o[1], o[2], o[3]}; dst[1] = (v4u){o[4], o[5], o[6], o[7]};
    LDS_WAIT(); asm volatile("" ::: "memory");
}
__device__ __forceinline__ int up_dstrow(int sc) { const int n = sc & 1, a = sc >> 1, p = a >> 7, al = a & 127, wc = al >> 5, fq = (al >> 3) & 3, bj = (al >> 2) & 1, j = al & 3;
    return 256 * p + 128 * bj + 32 * wc + 16 * n + 4 * fq + j; }
__device__ __forceinline__ int down_dstrow(int sc) { const int c = sc & 255, wc = c >> 6, fq = (c >> 4) & 3, bj = (c >> 3) & 1, n = (c >> 2) & 1, rg = c & 3; return (sc & ~255) + 128 * bj + 32 * wc + 16 * n + 4 * fq + rg; }
constexpr int CV_UP1 = (D / 128) * (DFF / 16), CV_DN1 = (D / 128) * (D / 16), CV_NUP = NE * CV_UP1, CV_NITEMS = CV_NUP + NE * CV_DN1;
__device__ __forceinline__ void cv_load(const Frame& F, int it, f32x4 (&v)[8]) {
    static_assert(CV_UP1 == 1024 && CV_DN1 == 512 && DFF == 2048 && D == 1024, "shift decomposition below");
    const bool up = it < CV_NUP; const int r = up ? it : it - CV_NUP, sh = up ? 10 : 9, N = up ? DFF : D, e = r >> sh, item = r & ((1 << sh) - 1);
    const float* W = (up ? FIN(F, 12) : FIN(F, 14)) + (size_t)e * D * N;
    const int kb0 = item >> (sh - 3), nb = item & ((1 << (sh - 3)) - 1), k0 = 128 * kb0 + 8 * (F.lane >> 2), n0 = 16 * nb + 4 * (F.lane & 3);
#pragma unroll
    for (int i = 0; i < 8; ++i) v[i] = *(const GAS f32x4*)(W + (size_t)(k0 + i) * N + n0);
}
__device__ __forceinline__ void cv_store(const Frame& F, int it, const f32x4 (&v)[8]) {
    const bool up = it < CV_NUP; const int r = up ? it : it - CV_NUP, sh = up ? 10 : 9, N = up ? DFF : D, e = r >> sh, item = r & ((1 << sh) - 1);
    unsigned char* WT = F.ws + (up ? WS_WUP : WS_WD) + (size_t)e * N * D; const float scale = up ? F8_SWU : F8_SWD;
    const int kb0 = item >> (sh - 3), nb = item & ((1 << (sh - 3)) - 1), k0 = 128 * kb0 + 8 * (F.lane >> 2), n0 = 16 * nb + 4 * (F.lane & 3);
#pragma unroll
    for (int j = 0; j < 4; ++j) { const int dn = up ? up_dstrow(n0 + j) : down_dstrow(n0 + j);
        u32x2 o; o.x = pk4_fp8(v[0][j] * scale, v[1][j] * scale, v[2][j] * scale, v[3][j] * scale); o.y = pk4_fp8(v[4][j] * scale, v[5][j] * scale, v[6][j] * scale, v[7][j] * scale);
        *(GAS u32x2*)(WT + (size_t)dn * D + k0) = o; }
}
__device__ __forceinline__ void p0_prologue(Frame& F) {
    LAS float* scr = (LAS float*)(F.lds + RING_OFF + F.wave * 16384);
    const int gw = F.vcu * NWAVES + F.wave, NGW = F.G * NWAVES;
    constexpr int I_IN = (D / 64) * (NIN / 32), I_OUT = (D / 64) * (D / 32);
    bf16* WinT = (bf16*)(F.ws + WS_WIN); bf16* WoutT = (bf16*)(F.ws + WS_WOUT); unsigned char* WupT = (unsigned char*)(F.ws + WS_WUP); unsigned char* WdT = (unsigned char*)(F.ws + WS_WD);
    for (int it = gw; it < I_IN + I_OUT; it += NGW) {
        if (it < I_IN) p0_transpose_item<false>(FIN(F, 3), D, NIN, WinT, scr, it, F.lane); else p0_transpose_item<false>(FIN(F, 7), D, D, WoutT, scr, it - I_IN, F.lane);
    }
    (void)WupT; (void)WdT;
    const float* x = FIN(F, 0); bf16* H0 = (bf16*)(F.ws + WS_H0);
    f32x4 gg[4], bb[4];
#pragma unroll
    for (int j = 0; j < 4; ++j) { gg[j] = ((const f32x4*)FIN(F, 1))[F.lane + 64 * j]; bb[j] = ((const f32x4*)FIN(F, 2))[F.lane + 64 * j]; }
    for (int m = gw; m < T; m += NGW) {
        const GAS f32x4* xr = (const GAS f32x4*)(x + (size_t)m * D) + F.lane;
        f32x4 v[4]; float s = 0.f;
#pragma unroll
        for (int j = 0; j < 4; ++j) { v[j] = xr[64 * j]; s += (v[j].x + v[j].y) + (v[j].z + v[j].w); }
        const float mean = wave_sum(s) * (1.f / D); float s2 = 0.f;
#pragma unroll
        for (int j = 0; j < 4; ++j) { v[j] = v[j] - mean; s2 += (v[j].x * v[j].x + v[j].y * v[j].y) + (v[j].z * v[j].z + v[j].w * v[j].w); }
        const float rstd = 1.f / sqrtf(wave_sum(s2) * (1.f / D) + LN_EPS);
        GAS u32x2* o8 = (GAS u32x2*)(H0 + (size_t)m * D) + F.lane;
#pragma unroll
        for (int j = 0; j < 4; ++j) { const f32x4 y = v[j] * rstd * gg[j] + bb[j]; u32x2 w; w.x = pg8::cvt_pk_bf16(y[0], y[1]); w.y = pg8::cvt_pk_bf16(y[2], y[3]); o8[64 * j] = w; }
    }
}

typedef float f32x16 __attribute__((ext_vector_type(16)));
typedef short s16x4 __attribute__((ext_vector_type(4)));
__device__ __forceinline__ unsigned cvtpk_s(float lo, float hi) { f32x2_t v = {lo, hi}; bf16x2_t b = __builtin_convertvector(v, bf16x2_t); return __builtin_bit_cast(unsigned, b); }
#define MFMA32(a, b, c) __builtin_amdgcn_mfma_f32_32x32x16_bf16((a), (b), (c), 0, 0, 0)
constexpr int AK_PITCH = 144, AV_PITCH = 776, AV_OFF = 384 * AK_PITCH;
static_assert(AV_OFF + 64 * AV_PITCH <= RING_BYTES, "attention LDS");
__device__ __forceinline__ void p2_attn(Frame& F) {
    const bf16* QA = (const bf16*)(F.ws + WS_QA); const bf16* KA = (const bf16*)(F.ws + WS_KA); const bf16* VA = (const bf16*)(F.ws + WS_VA); bf16* MIX = (bf16*)(F.ws + WS_MIX);
    const float* sink = FIN(F, 4);
    LAS unsigned char* Ks = F.lds + RING_OFF; LAS unsigned char* Vt = Ks + AV_OFF;
    const int r = F.lane & 31, h = F.lane >> 5;
    constexpr float LOG2E = 1.4426950408889634f;
    v4u kreg[6], vreg[6];
#define AT_LOADKV(unit_) do { const int n_ = (unit_) & 15, g_ = ((unit_) >> 4) & 1, b_ = (unit_) >> 5, kb_ = n_ * 128 - 128; \
        _Pragma("unroll") for (int i = 0; i < 6; ++i) { const int c = F.tid + 512 * i, row = c >> 3, ch = c & 7; int pos = kb_ + row; pos = pos < 0 ? 0 : (pos >= SEQ ? SEQ - 1 : pos); \
            kreg[i] = *(const v4u*)(KA + ((size_t)b_ * SEQ + pos) * 128 + g_ * 64 + ch * 8); } \
        _Pragma("unroll") for (int i = 0; i < 3; ++i) { const int it = F.tid + 512 * i, kp = it % 192, ch = it / 192; int pos = kb_ + 2 * kp; pos = pos < 0 ? 0 : (pos >= SEQ ? SEQ - 2 : pos); \
            const bf16* vp = VA + ((size_t)b_ * SEQ + pos) * 128 + g_ * 64 + ch * 8; vreg[2 * i] = *(const v4u*)vp; vreg[2 * i + 1] = *(const v4u*)(vp + 128); } } while (0)
    if (F.vcu < NB * 2 * 16) AT_LOADKV(F.vcu);
    for (int unit = F.vcu; unit < NB * 2 * 16; unit += F.G) {
        const int n = unit & 15, g = (unit >> 4) & 1, b = unit >> 5, kbase = n * 128 - 128;
        const int head = g * 4 + (F.wave >> 1), qw0 = n * 128 + (F.wave & 1) * 64;
        pg8::bf16x8 qf[2][4];
#pragma unroll
        for (int qb = 0; qb < 2; ++qb) { const bf16* qp = QA + ((size_t)b * SEQ + qw0 + qb * 32 + r) * 512 + head * 64 + 8 * h;
#pragma unroll
            for (int ds = 0; ds < 4; ++ds) qf[qb][ds] = *(const pg8::bf16x8*)(qp + 16 * ds); }
        __syncthreads();
#pragma unroll
        for (int i = 0; i < 6; ++i) { const int c = F.tid + 512 * i, row = c >> 3, ch = c & 7; *(LAS v4u*)(Ks + row * AK_PITCH + ch * 16) = kreg[i]; }
#pragma unroll
        for (int i = 0; i < 3; ++i) { const int it = F.tid + 512 * i, kp = it % 192, ch = it / 192; const v4u w0 = vreg[2 * i], w1 = vreg[2 * i + 1];
            LAS unsigned char* dst = Vt + (ch * 8) * AV_PITCH + kp * 4;
            *(LAS unsigned*)(dst + 0 * AV_PITCH) = (w0.x & 0xffffu) | (w1.x << 16); *(LAS unsigned*)(dst + 1 * AV_PITCH) = (w0.x >> 16) | (w1.x & 0xffff0000u);
            *(LAS unsigned*)(dst + 2 * AV_PITCH) = (w0.y & 0xffffu) | (w1.y << 16); *(LAS unsigned*)(dst + 3 * AV_PITCH) = (w0.y >> 16) | (w1.y & 0xffff0000u);
            *(LAS unsigned*)(dst + 4 * AV_PITCH) = (w0.z & 0xffffu) | (w1.z << 16); *(LAS unsigned*)(dst + 5 * AV_PITCH) = (w0.z >> 16) | (w1.z & 0xffff0000u);
            *(LAS unsigned*)(dst + 6 * AV_PITCH) = (w0.w & 0xffffu) | (w1.w << 16); *(LAS unsigned*)(dst + 7 * AV_PITCH) = (w0.w >> 16) | (w1.w & 0xffff0000u); }
        if (unit + F.G < NB * 2 * 16) AT_LOADKV(unit + F.G);
        __syncthreads();
        const float slope2 = __builtin_amdgcn_exp2f(-(float)(head + 1)) * LOG2E, sink2 = sink[head] * LOG2E;
#pragma unroll
        for (int qb = 0; qb < 2; ++qb) {
            const int q0 = qw0 + qb * 32;
            f32x16 o0, o1;
#pragma unroll
            for (int i = 0; i < 16; ++i) { o0[i] = 0.f; o1[i] = 0.f; }
            float m = sink2, l = (h == 0) ? 1.0f : 0.0f;
            const int kt_lo = (q0 - 128) < 0 ? 0 : q0 - 128, kt_hi = (q0 + 128) > SEQ - 32 ? SEQ - 32 : q0 + 128;
            f32x16 sn;
#define AT_QK(dst, k0_) do { _Pragma("unroll") for (int i = 0; i < 16; ++i) dst[i] = 0.f; \
                _Pragma("unroll") for (int ds = 0; ds < 4; ++ds) { const pg8::bf16x8 kf = *(const LAS pg8::bf16x8*)(Ks + ((k0_) - kbase + r) * AK_PITCH + ds * 32 + h * 16); dst = MFMA32(kf, qf[qb][ds], dst); } } while (0)
            AT_QK(sn, kt_lo);
            for (int k0 = kt_lo; k0 <= kt_hi; k0 += 32) {
                const int kl = k0 - kbase;
                f32x16 s = sn;
                if (k0 + 32 <= kt_hi) AT_QK(sn, k0 + 32);
                const float base = (float)(q0 + r - k0 - 4 * h);
                const bool partial = (k0 < q0 + 31 - 128) || (k0 + 31 > q0 + 128);
                float mt = -INFINITY;
                if (partial) {
#pragma unroll
                    for (int i = 0; i < 16; ++i) { const float dist = fabsf(base - (float)((i & 3) + 8 * (i >> 2))); float sv = s[i] - slope2 * dist; sv = dist <= 128.0f ? sv : -INFINITY; s[i] = sv; mt = fmaxf(mt, sv); }
                } else {
#pragma unroll
                    for (int i = 0; i < 16; ++i) { const float dist = fabsf(base - (float)((i & 3) + 8 * (i >> 2))); const float sv = s[i] - slope2 * dist; s[i] = sv; mt = fmaxf(mt, sv); }
                }
                mt = fmaxf(mt, __shfl_xor(mt, 32));
                if (__any(mt > m)) {
                    const float mn = fmaxf(m, mt), alpha = __builtin_amdgcn_exp2f(m - mn); m = mn; l *= alpha;
#pragma unroll
                    for (int i = 0; i < 16; ++i) { o0[i] *= alpha; o1[i] *= alpha; }
                }
                float ps = 0.f;
#pragma unroll
                for (int i = 0; i < 16; ++i) { s[i] = __builtin_amdgcn_exp2f(s[i] - m); ps += s[i]; }
                l += ps;
#pragma unroll
                for (int sp = 0; sp < 2; ++sp) {
                    v4u pw; pw.x = cvtpk_s(s[8 * sp], s[8 * sp + 1]); pw.y = cvtpk_s(s[8 * sp + 2], s[8 * sp + 3]); pw.z = cvtpk_s(s[8 * sp + 4], s[8 * sp + 5]); pw.w = cvtpk_s(s[8 * sp + 6], s[8 * sp + 7]);
                    const pg8::bf16x8 pf = __builtin_bit_cast(pg8::bf16x8, pw);
                    const LAS unsigned char* vp = Vt + r * AV_PITCH + (kl + 16 * sp + 4 * h) * 2;
                    { const s16x4 lo = *(const LAS s16x4*)vp, hi = *(const LAS s16x4*)(vp + 16); o0 = MFMA32(__builtin_shufflevector(lo, hi, 0, 1, 2, 3, 4, 5, 6, 7), pf, o0); }
                    { const s16x4 lo = *(const LAS s16x4*)(vp + 32 * AV_PITCH), hi = *(const LAS s16x4*)(vp + 32 * AV_PITCH + 16); o1 = MFMA32(__builtin_shufflevector(lo, hi, 0, 1, 2, 3, 4, 5, 6, 7), pf, o1); }
                }
            }
            l += __shfl_xor(l, 32); const float inv = 1.0f / l;
            bf16* op = MIX + ((size_t)b * SEQ + q0 + r) * D + head * 64 + 4 * h;
#pragma unroll
            for (int gi = 0; gi < 4; ++gi) {
                u32x2 w0; w0.x = cvtpk_s(o0[4 * gi] * inv, o0[4 * gi + 1] * inv); w0.y = cvtpk_s(o0[4 * gi + 2] * inv, o0[4 * gi + 3] * inv); *(u32x2*)(op + 8 * gi) = w0;
                u32x2 w1; w1.x = cvtpk_s(o1[4 * gi] * inv, o1[4 * gi + 1] * inv); w1.y = cvtpk_s(o1[4 * gi + 2] * inv, o1[4 * gi + 3] * inv); *(u32x2*)(op + 32 + 8 * gi) = w1; }
        }
    }
#undef AT_LOADKV
#undef AT_QK
}
#define MFMA16(a, b, c) __builtin_amdgcn_mfma_f32_16x16x32_bf16((a), (b), (c), 0, 0, 0)
constexpr int HP = 272, HPS = 144;
constexpr int H_QR = 0, H_KR = 17408, H_KT = 34816, H_VT = 53248, H_AT = 62464, H_ST = 71680, H_QTOT = 89088, H_EREF = 91136, H_ELR = 91648;
static_assert(H_ELR + 512 <= RING_BYTES, "hgrn LDS");
__device__ __forceinline__ void p2_hgrn(Frame& F) {
    const bf16* QH = (const bf16*)(F.ws + WS_QH); const bf16* IH = (const bf16*)(F.ws + WS_IH);
    LAS unsigned char* L = F.lds + RING_OFF;
    const int tid = F.tid, w = F.wave, i16 = F.lane & 15, kg = F.lane >> 4;
    const int d0 = 2 * (tid & 63), t8 = tid >> 6, v0 = 2 * (tid & 31), s4 = tid >> 5;
    constexpr float LOG2E = 1.4426950408889634f;
    const int gw = F.vcu * NWAVES + F.wave, NGW = F.G * NWAVES; int cvk = 0;
    for (int unit = F.vcu; unit < NB * 4 * 2 * 2; unit += F.G) {
        const int vh = unit & 1, dir = (unit >> 1) & 1, h = (unit >> 2) & 3, b = unit >> 4;
        const bf16* LG = (const bf16*)(F.ws + (dir ? WS_LB : WS_LF)); bf16* OUT = (bf16*)(F.ws + (dir ? WS_OB : WS_OF));
        const size_t rowb = (size_t)b * SEQ;
        f32x4 S[4];
#pragma unroll
        for (int i = 0; i < 4; ++i) S[i] = (f32x4){0.f, 0.f, 0.f, 0.f};
        unsigned qA[8], vA[4], qB[8], vB[4], lA[8], lB[8];
#define HG_TIME(c, tau) (dir ? (SEQ - 1 - (64 * (c) + (tau))) : (64 * (c) + (tau)))
#define HG_LOAD(c, qr_, lr_, vr_) do { \
        _Pragma("unroll") for (int j = 0; j < 8; ++j) { const size_t g = (rowb + HG_TIME(c, 8 * t8 + j)) * 512 + h * 128 + d0; qr_[j] = *(const unsigned*)(QH + g); lr_[j] = *(const unsigned*)(LG + g); } \
        _Pragma("unroll") for (int j = 0; j < 4; ++j) vr_[j] = *(const unsigned*)(IH + (rowb + HG_TIME(c, 4 * s4 + j)) * 512 + h * 128 + vh * 64 + v0); } while (0)
#define HG_CHUNK(c, qr_, lr_, vr_, itx) do { \
            asm volatile("s_waitcnt lgkmcnt(0)" ::: "memory"); __builtin_amdgcn_s_barrier(); asm volatile("" ::: "memory");                                                 \
            f32x2_t cs[8]; { f32x2_t run = {0.f, 0.f}; \
                _Pragma("unroll") for (int j = 0; j < 8; ++j) { run = run + (f32x2_t){bflo(lr_[j]), bfhi(lr_[j])} * LOG2E; cs[j] = run; } \
                *(LAS f32x2_t*)(L + H_QTOT + (t8 * 128 + d0) * 4) = run; } \
            asm volatile("s_waitcnt lgkmcnt(0)" ::: "memory"); __builtin_amdgcn_s_barrier(); asm volatile("" ::: "memory"); \
            f32x2_t pre = {0.f, 0.f}, ref = {0.f, 0.f}, last = {0.f, 0.f}; \
            _Pragma("unroll") for (int sgm = 0; sgm < 8; ++sgm) { const f32x2_t tq_ = *(const LAS f32x2_t*)(L + H_QTOT + (sgm * 128 + d0) * 4); if (sgm < t8) pre = pre + tq_; if (sgm < 4) ref = ref + tq_; last = last + tq_; } \
            if (t8 == 0) { f32x2_t er_, el_; er_[0] = __builtin_amdgcn_exp2f(ref[0]); er_[1] = __builtin_amdgcn_exp2f(ref[1]); el_[0] = __builtin_amdgcn_exp2f(last[0] - ref[0]); el_[1] = __builtin_amdgcn_exp2f(last[1] - ref[1]); \
                *(LAS f32x2_t*)(L + H_EREF + d0 * 4) = er_; *(LAS f32x2_t*)(L + H_ELR + d0 * 4) = el_; } \
            { float kr0[8], kr1[8]; \
              _Pragma("unroll") for (int j = 0; j < 8; ++j) { \
                  const float c0 = pre[0] + cs[j][0] - ref[0], c1 = pre[1] + cs[j][1] - ref[1]; \
                  const float q0 = bflo(qr_[j]), q1 = bfhi(qr_[j]); \
                  const float k0 = 1.0f - __builtin_amdgcn_exp2f(bflo(lr_[j]) * LOG2E), k1 = 1.0f - __builtin_amdgcn_exp2f(bfhi(lr_[j]) * LOG2E); \
                  kr0[j] = k0 * __builtin_amdgcn_exp2f(-c0); kr1[j] = k1 * __builtin_amdgcn_exp2f(-c1); \
                  *(LAS unsigned*)(L + H_QR + (8 * t8 + j) * HP + d0 * 2) = cvtpk_s(q0 * __builtin_amdgcn_exp2f(c0), q1 * __builtin_amdgcn_exp2f(c1)); \
                  *(LAS unsigned*)(L + H_KR + (8 * t8 + j) * HP + d0 * 2) = cvtpk_s(kr0[j], kr1[j]); } \
              *(LAS v4u*)(L + H_KT + d0 * HPS + t8 * 16) = (v4u){cvtpk_s(kr0[0], kr0[1]), cvtpk_s(kr0[2], kr0[3]), cvtpk_s(kr0[4], kr0[5]), cvtpk_s(kr0[6], kr0[7])}; \
              *(LAS v4u*)(L + H_KT + (d0 + 1) * HPS + t8 * 16) = (v4u){cvtpk_s(kr1[0], kr1[1]), cvtpk_s(kr1[2], kr1[3]), cvtpk_s(kr1[4], kr1[5]), cvtpk_s(kr1[6], kr1[7])}; } \
            { u32x2 a_, b_; a_.x = (vr_[0] & 0xffffu) | (vr_[1] << 16); a_.y = (vr_[2] & 0xffffu) | (vr_[3] << 16); b_.x = (vr_[0] >> 16) | (vr_[1] & 0xffff0000u); b_.y = (vr_[2] >> 16) | (vr_[3] & 0xffff0000u); \
              *(LAS u32x2*)(L + H_VT + v0 * HPS + s4 * 8) = a_; *(LAS u32x2*)(L + H_VT + (v0 + 1) * HPS + s4 * 8) = b_; } \
            if ((c) + 2 < SEQ / 64) HG_LOAD((c) + 2, qr_, lr_, vr_); \
            if (cvprev < CV_NITEMS) cv_store(F, cvprev, cvv);                \
            if ((itx) < CV_NITEMS) cv_load(F, (itx), cvv); cvprev = (itx); \
            asm volatile("s_waitcnt lgkmcnt(0)" ::: "memory"); __builtin_amdgcn_s_barrier(); asm volatile("" ::: "memory"); \
            {     \
                const f32x4 er = *(const LAS f32x4*)(L + H_EREF + (16 * w + 4 * kg) * 4); \
                _Pragma("unroll") for (int vt = 0; vt < 4; ++vt) { S[vt] = S[vt] * er; u32x2 pk; pk.x = cvtpk_s(S[vt][0], S[vt][1]); pk.y = cvtpk_s(S[vt][2], S[vt][3]); \
                    *(LAS u32x2*)(L + H_ST + (16 * vt + i16) * HP + (16 * w + 4 * kg) * 2) = pk; } \
                const int tt = w >> 1; \
                _Pragma("unroll") for (int q2 = 0; q2 < 2; ++q2) { const int st = 2 * (w & 1) + q2; LAS unsigned char* ap = L + H_AT + (16 * tt + i16) * HPS + (16 * st + 4 * kg) * 2; \
                    if (st > tt) { *(LAS u32x2*)ap = (u32x2){0u, 0u}; } \
                    else { f32x4 a = (f32x4){0.f, 0.f, 0.f, 0.f}; \
                        _Pragma("unroll") for (int ks = 0; ks < 4; ++ks) { const pg8::bf16x8 kf = *(const LAS pg8::bf16x8*)(L + H_KR + (16 * st + i16) * HP + (32 * ks + 8 * kg) * 2), qf = *(const LAS pg8::bf16x8*)(L + H_QR + (16 * tt + i16) * HP + (32 * ks + 8 * kg) * 2); \
                            a = MFMA16(kf, qf, a); } \
                        if (st == tt) { _Pragma("unroll") for (int i = 0; i < 4; ++i) a[i] = (4 * kg + i <= i16) ? a[i] : 0.f; } \
                        u32x2 pk; pk.x = cvtpk_s(a[0], a[1]); pk.y = cvtpk_s(a[2], a[3]); *(LAS u32x2*)ap = pk; } } \
                _Pragma("unroll") for (int ks = 0; ks < 2; ++ks) { const pg8::bf16x8 af = *(const LAS pg8::bf16x8*)(L + H_KT + (16 * w + i16) * HPS + (32 * ks + 8 * kg) * 2); \
                    _Pragma("unroll") for (int vt = 0; vt < 4; ++vt) { const pg8::bf16x8 bfv = *(const LAS pg8::bf16x8*)(L + H_VT + (16 * vt + i16) * HPS + (32 * ks + 8 * kg) * 2); S[vt] = MFMA16(af, bfv, S[vt]); } } \
                const f32x4 el = *(const LAS f32x4*)(L + H_ELR + (16 * w + 4 * kg) * 4); \
                _Pragma("unroll") for (int vt = 0; vt < 4; ++vt) S[vt] = S[vt] * el; \
            } \
            asm volatile("s_waitcnt lgkmcnt(0)" ::: "memory"); __builtin_amdgcn_s_barrier(); asm volatile("" ::: "memory"); \
            {     \
                const int vt = w & 3, tp = w >> 2; \
                f32x4 oa[2]; oa[0] = (f32x4){0.f, 0.f, 0.f, 0.f}; oa[1] = oa[0]; \
                _Pragma("unroll") for (int ks = 0; ks < 4; ++ks) { const pg8::bf16x8 sf = *(const LAS pg8::bf16x8*)(L + H_ST + (16 * vt + i16) * HP + (32 * ks + 8 * kg) * 2); \
                    _Pragma("unroll") for (int q2 = 0; q2 < 2; ++q2) { const pg8::bf16x8 qf = *(const LAS pg8::bf16x8*)(L + H_QR + (16 * (2 * tp + q2) + i16) * HP + (32 * ks + 8 * kg) * 2); oa[q2] = MFMA16(sf, qf, oa[q2]); } } \
                _Pragma("unroll") for (int ks = 0; ks < 2; ++ks) if (ks <= tp) { const pg8::bf16x8 vf = *(const LAS pg8::bf16x8*)(L + H_VT + (16 * vt + i16) * HPS + (32 * ks + 8 * kg) * 2); \
                    _Pragma("unroll") for (int q2 = 0; q2 < 2; ++q2) { const pg8::bf16x8 af = *(const LAS pg8::bf16x8*)(L + H_AT + (16 * (2 * tp + q2) + i16) * HPS + (32 * ks + 8 * kg) * 2); oa[q2] = MFMA16(vf, af, oa[q2]); } } \
                _Pragma("unroll") for (int q2 = 0; q2 < 2; ++q2) { const int tm = HG_TIME(c, 16 * (2 * tp + q2) + i16); u32x2 ow; ow.x = cvtpk_s(oa[q2][0], oa[q2][1]); ow.y = cvtpk_s(oa[q2][2], oa[q2][3]); \
                    *(u32x2*)(OUT + (rowb + tm) * 512 + h * 128 + vh * 64 + 16 * vt + 4 * kg) = ow; } \
            } } while (0)
        HG_LOAD(0, qA, lA, vA); HG_LOAD(1, qB, lB, vB);
        f32x4 cvv[8]; int cvprev = CV_NITEMS;
        for (int c = 0; c < SEQ / 64; c += 2) {
            const int it0 = gw + cvk * NGW, it1 = it0 + NGW; cvk += 2;
            HG_CHUNK(c, qA, lA, vA, it0);
            HG_CHUNK(c + 1, qB, lB, vB, it1);
        }
        if (cvprev < CV_NITEMS) cv_store(F, cvprev, cvv);
#undef HG_CHUNK
#undef HG_LOAD
#undef HG_TIME
    }
    for (int it = gw + cvk * NGW; it < CV_NITEMS; it += NGW) { f32x4 cvv[8]; cv_load(F, it, cvv); cv_store(F, it, cvv); }
}

constexpr int G_BUF = 63488, G_QR = 0, G_KR = 17408, G_KT = 34816, G_VT = 53248, G_EREF = 62464, G_ELR = 62976;
constexpr int G_AT = 2 * G_BUF, G_ST = G_AT + 9216, G_QTOT = G_ST + 17408, G_END = G_QTOT + 2048;
static_assert(G_END <= LDSCTL_OFF, "hgrn2 LDS");
__device__ __forceinline__ void p2_hgrn2(Frame& F) {
    const bf16* QH = (const bf16*)(F.ws + WS_QH); const bf16* IH = (const bf16*)(F.ws + WS_IH);
    LAS unsigned char* L = F.lds;
    const int tid = F.tid, w = F.wave, i16 = F.lane & 15, kg = F.lane >> 4; const bool isA = w < 4; const int wb = w & 3;
    const int d0 = 2 * (tid & 63), tsg = (tid >> 6) & 3, v0 = 2 * (tid & 31), s8 = (tid >> 5) & 7;
    constexpr float LOG2E = 1.4426950408889634f;
    const int gwb = F.vcu * 4 + wb, NGWB = F.G * 4; int cvk = 0;
#define G2_BAR() do { asm volatile("s_waitcnt lgkmcnt(0)" ::: "memory"); __builtin_amdgcn_s_barrier(); asm volatile("" ::: "memory"); } while (0)
#define G2_SEL(n, bo) ((bo) ? n##1 : n##0)
    LAS unsigned char* const pQT = L + G_QTOT + d0 * 4;
    LAS unsigned char* const pER0 = L + G_EREF + d0 * 4, * const pER1 = pER0 + G_BUF;
    LAS unsigned char* const pQK0 = L + (16 * tsg) * HP + d0 * 2, * const pQK1 = pQK0 + G_BUF;
    LAS unsigned char* const pKT0 = L + G_KT + d0 * HPS + tsg * 32, * const pKT1 = pKT0 + G_BUF;
    LAS unsigned char* const pVT0 = L + G_VT + v0 * HPS + s8 * 16, * const pVT1 = pVT0 + G_BUF;
    LAS unsigned char* const bP0 = L + i16 * HP + kg * 16, * const bP1 = bP0 + G_BUF;
    LAS unsigned char* const bPw0 = bP0 + wb * 16 * HP, * const bPw1 = bPw0 + G_BUF;
    LAS unsigned char* const bS0 = L + i16 * HPS + kg * 16, * const bS1 = bS0 + G_BUF;
    LAS unsigned char* const bSw0 = bS0 + wb * 16 * HPS, * const bSw1 = bSw0 + G_BUF;
    LAS unsigned char* const bKT0 = L + G_KT + (32 * wb + i16) * HPS + kg * 16, * const bKT1 = bKT0 + G_BUF;
    LAS unsigned char* const bER0 = L + G_EREF + (32 * wb + 4 * kg) * 4, * const bER1 = bER0 + G_BUF;
    LAS unsigned char* const bSTr = L + G_ST + (16 * wb + i16) * HP + kg * 16;
    LAS unsigned char* const bATr = L + G_AT + i16 * HPS + kg * 16;
    LAS unsigned char* const bSTw = L + G_ST + i16 * HP + (32 * wb + 4 * kg) * 2;
    LAS unsigned char* const bATw = L + G_AT + (16 * wb + i16) * HPS + kg * 8;
    for (int unit = F.vcu; unit < NB * 4 * 2 * 2; unit += F.G) {
        const int vh = unit & 1, dir = (unit >> 1) & 1, h = (unit >> 2) & 3, b = unit >> 4;
        const bf16* LG = (const bf16*)(F.ws + (dir ? WS_LB : WS_LF)); bf16* OUT = (bf16*)(F.ws + (dir ? WS_OB : WS_OF));
        const size_t rowb = (size_t)b * SEQ; const long tstep = dir ? -512 : 512;
#define G2_TIME(c, tau) (dir ? (SEQ - 1 - (64 * (c) + (tau))) : (64 * (c) + (tau)))
#define G2_LOAD(c, qr_, lr_, vr_) do {   \
        const size_t g0_ = (rowb + G2_TIME(c, 16 * tsg)) * 512 + h * 128 + d0; const bf16* qp_ = QH + g0_; const bf16* lp_ = LG + g0_; \
        const bf16* vp_ = IH + (rowb + G2_TIME(c, 8 * s8)) * 512 + h * 128 + vh * 64 + v0; \
        _Pragma("unroll") for (int j = 0; j < 16; ++j) { qr_[j] = *(const unsigned*)(qp_ + j * tstep); lr_[j] = *(const unsigned*)(lp_ + j * tstep); } \
        _Pragma("unroll") for (int j = 0; j < 8; ++j) vr_[j] = *(const unsigned*)(vp_ + j * tstep); } while (0)
#define G2_SCAN(lr_) do { f32x2_t run = {0.f, 0.f}; \
        _Pragma("unroll") for (int j = 0; j < 16; ++j) { run = run + (f32x2_t){bflo(lr_[j]), bfhi(lr_[j])} * LOG2E; cs[j] = run; } \
        *(LAS f32x2_t*)(pQT + tsg * 512) = run; } while (0)
#define G2_ELEM(qr_, lr_, vr_, bo) do { \
        f32x2_t pre = {0.f, 0.f}, ref = {0.f, 0.f}, last = {0.f, 0.f}; \
        _Pragma("unroll") for (int sgm = 0; sgm < 4; ++sgm) { const f32x2_t tq_ = *(const LAS f32x2_t*)(pQT + sgm * 512); if (sgm < tsg) pre = pre + tq_; if (sgm < 2) ref = ref + tq_; last = last + tq_; } \
        if (tsg == 0) { f32x2_t er_, el_; er_[0] = __builtin_amdgcn_exp2f(ref[0]); er_[1] = __builtin_amdgcn_exp2f(ref[1]); el_[0] = __builtin_amdgcn_exp2f(last[0] - ref[0]); el_[1] = __builtin_amdgcn_exp2f(last[1] - ref[1]); \
            *(LAS f32x2_t*)(G2_SEL(pER, bo)) = er_; *(LAS f32x2_t*)(G2_SEL(pER, bo) + (G_ELR - G_EREF)) = el_; } \
        { unsigned kt0[8], kt1[8]; float kp0 = 0.f, kp1 = 0.f; \
          _Pragma("unroll") for (int j = 0; j < 16; ++j) { \
              const float c0 = pre[0] + cs[j][0] - ref[0], c1 = pre[1] + cs[j][1] - ref[1]; \
              const float k0 = 1.0f - __builtin_amdgcn_exp2f(bflo(lr_[j]) * LOG2E), k1 = 1.0f - __builtin_amdgcn_exp2f(bfhi(lr_[j]) * LOG2E); \
              const float kr0 = k0 * __builtin_amdgcn_exp2f(-c0), kr1 = k1 * __builtin_amdgcn_exp2f(-c1); \
              *(LAS unsigned*)(G2_SEL(pQK, bo) + G_QR + j * HP) = cvtpk_s(bflo(qr_[j]) * __builtin_amdgcn_exp2f(c0), bfhi(qr_[j]) * __builtin_amdgcn_exp2f(c1)); \
              *(LAS unsigned*)(G2_SEL(pQK, bo) + G_KR + j * HP) = cvtpk_s(kr0, kr1); \
              if (j & 1) { kt0[j >> 1] = cvtpk_s(kp0, kr0); kt1[j >> 1] = cvtpk_s(kp1, kr1); } else { kp0 = kr0; kp1 = kr1; } } \
          *(LAS v4u*)(G2_SEL(pKT, bo)) = (v4u){kt0[0], kt0[1], kt0[2], kt0[3]}; *(LAS v4u*)(G2_SEL(pKT, bo) + 16) = (v4u){kt0[4], kt0[5], kt0[6], kt0[7]}; \
          *(LAS v4u*)(G2_SEL(pKT, bo) + HPS) = (v4u){kt1[0], kt1[1], kt1[2], kt1[3]}; *(LAS v4u*)(G2_SEL(pKT, bo) + HPS + 16) = (v4u){kt1[4], kt1[5], kt1[6], kt1[7]}; } \
        { v4u a_, b_; a_.x = (vr_[0] & 0xffffu) | (vr_[1] << 16); a_.y = (vr_[2] & 0xffffu) | (vr_[3] << 16); a_.z = (vr_[4] & 0xffffu) | (vr_[5] << 16); a_.w = (vr_[6] & 0xffffu) | (vr_[7] << 16); \
          b_.x = (vr_[0] >> 16) | (vr_[1] & 0xffff0000u); b_.y = (vr_[2] >> 16) | (vr_[3] & 0xffff0000u); b_.z = (vr_[4] >> 16) | (vr_[5] & 0xffff0000u); b_.w = (vr_[6] >> 16) | (vr_[7] & 0xffff0000u); \
          *(LAS v4u*)(G2_SEL(pVT, bo)) = a_; *(LAS v4u*)(G2_SEL(pVT, bo) + HPS) = b_; } } while (0)
#define G2_B1(bo) do { \
        _Pragma("unroll") for (int dt = 0; dt < 2; ++dt) { const f32x4 er = *(const LAS f32x4*)(G2_SEL(bER, bo) + dt * 64); \
            _Pragma("unroll") for (int vt = 0; vt < 4; ++vt) { S[dt][vt] = S[dt][vt] * er; u32x2 pk; pk.x = cvtpk_s(S[dt][vt][0], S[dt][vt][1]); pk.y = cvtpk_s(S[dt][vt][2], S[dt][vt][3]); \
                *(LAS u32x2*)(bSTw + vt * 16 * HP + dt * 32) = pk; } } \
        _Pragma("unroll") for (int st = 0; st < 4; ++st) { \
            if (st > wb) { *(LAS u32x2*)(bATw + st * 32) = (u32x2){0u, 0u}; } \
            else { f32x4 a = (f32x4){0.f, 0.f, 0.f, 0.f}; \
                _Pragma("unroll") for (int ks = 0; ks < 4; ++ks) { const pg8::bf16x8 kf = *(const LAS pg8::bf16x8*)(G2_SEL(bP, bo) + G_KR + st * 16 * HP + ks * 64), qf = *(const LAS pg8::bf16x8*)(G2_SEL(bPw, bo) + G_QR + ks * 64); \
                    a = MFMA16(kf, qf, a); } \
                if (st == wb) { _Pragma("unroll") for (int i = 0; i < 4; ++i) a[i] = (4 * kg + i <= i16) ? a[i] : 0.f; } \
                u32x2 pk; pk.x = cvtpk_s(a[0], a[1]); pk.y = cvtpk_s(a[2], a[3]); *(LAS u32x2*)(bATw + st * 32) = pk; } } \
        _Pragma("unroll") for (int dt = 0; dt < 2; ++dt) { \
            _Pragma("unroll") for (int ks = 0; ks < 2; ++ks) { const pg8::bf16x8 af = *(const LAS pg8::bf16x8*)(G2_SEL(bKT, bo) + dt * 16 * HPS + ks * 64); \
                _Pragma("unroll") for (int vt = 0; vt < 4; ++vt) { const pg8::bf16x8 bfv = *(const LAS pg8::bf16x8*)(G2_SEL(bS, bo) + G_VT + vt * 16 * HPS + ks * 64); S[dt][vt] = MFMA16(af, bfv, S[dt][vt]); } } \
            const f32x4 el = *(const LAS f32x4*)(G2_SEL(bER, bo) + (G_ELR - G_EREF) + dt * 64); \
            _Pragma("unroll") for (int vt = 0; vt < 4; ++vt) S[dt][vt] = S[dt][vt] * el; } } while (0)
#define G2_B2(bo, c) do { \
        f32x4 oa[4]; _Pragma("unroll") for (int tt = 0; tt < 4; ++tt) oa[tt] = (f32x4){0.f, 0.f, 0.f, 0.f}; \
        _Pragma("unroll") for (int ks = 0; ks < 4; ++ks) { const pg8::bf16x8 sf = *(const LAS pg8::bf16x8*)(bSTr + ks * 64); \
            _Pragma("unroll") for (int tt = 0; tt < 4; ++tt) { const pg8::bf16x8 qf = *(const LAS pg8::bf16x8*)(G2_SEL(bP, bo) + G_QR + tt * 16 * HP + ks * 64); oa[tt] = MFMA16(sf, qf, oa[tt]); } } \
        _Pragma("unroll") for (int ks = 0; ks < 2; ++ks) { const pg8::bf16x8 vf = *(const LAS pg8::bf16x8*)(G2_SEL(bSw, bo) + G_VT + ks * 64); \
            _Pragma("unroll") for (int tt = 2 * ks; tt < 4; ++tt) { const pg8::bf16x8 af = *(const LAS pg8::bf16x8*)(bATr + tt * 16 * HPS + ks * 64); oa[tt] = MFMA16(vf, af, oa[tt]); } } \
        _Pragma("unroll") for (int tt = 0; tt < 4; ++tt) { const int tm = G2_TIME(c, 16 * tt + i16); u32x2 ow; ow.x = cvtpk_s(oa[tt][0], oa[tt][1]); ow.y = cvtpk_s(oa[tt][2], oa[tt][3]); \
            *(u32x2*)(OUT + (rowb + tm) * 512 + h * 128 + vh * 64 + 16 * wb + 4 * kg) = ow; } } while (0)
        if (isA) {
            unsigned q0r[16], l0r[16], v0r[8], q1r[16], l1r[16], v1r[8]; f32x2_t cs[16];
            G2_LOAD(0, q0r, l0r, v0r); G2_LOAD(1, q1r, l1r, v1r);
            G2_BAR();
            G2_SCAN(l0r);
            G2_BAR();
            G2_ELEM(q0r, l0r, v0r, 0); G2_LOAD(2, q0r, l0r, v0r);
            G2_BAR();
            for (int c = 0; c < SEQ / 64; c += 2) {
                G2_SCAN(l1r);
                G2_BAR();
                G2_ELEM(q1r, l1r, v1r, G_BUF); if (c + 3 < SEQ / 64) G2_LOAD(c + 3, q1r, l1r, v1r);
                G2_BAR();
                if (c + 2 < SEQ / 64) G2_SCAN(l0r);
                G2_BAR();
                if (c + 2 < SEQ / 64) { G2_ELEM(q0r, l0r, v0r, 0); if (c + 4 < SEQ / 64) G2_LOAD(c + 4, q0r, l0r, v0r); }
                G2_BAR();
            }
        } else {
            f32x4 S[2][4];
#pragma unroll
            for (int i = 0; i < 2; ++i)
#pragma unroll
                for (int j = 0; j < 4; ++j) S[i][j] = (f32x4){0.f, 0.f, 0.f, 0.f};
            G2_BAR(); G2_BAR(); G2_BAR();
            for (int c = 0; c < SEQ / 64; c += 2) {
#define G2_BSTEP(cc, bc) do { f32x4 cva[8], cvb[8]; const int ita = gwb + cvk * NGWB, itb = ita + NGWB; cvk += 2; \
                cv_load(F, ita < CV_NITEMS ? ita : CV_NITEMS - 1, cva); cv_load(F, itb < CV_NITEMS ? itb : CV_NITEMS - 1, cvb);     \
                G2_B1(bc); G2_BAR(); G2_B2(bc, cc); \
                if (ita < CV_NITEMS) cv_store(F, ita, cva); if (itb < CV_NITEMS) cv_store(F, itb, cvb); G2_BAR(); } while (0)
                G2_BSTEP(c, 0); G2_BSTEP(c + 1, G_BUF);
#undef G2_BSTEP
            }
        }
#undef G2_B2
#undef G2_B1
#undef G2_ELEM
#undef G2_SCAN
#undef G2_LOAD
#undef G2_TIME
    }
#undef G2_BAR
#undef G2_SEL
    if (!isA) for (int it = gwb + cvk * NGWB; it < CV_NITEMS; it += NGWB) { f32x4 cvv[8]; cv_load(F, it, cvv); cv_store(F, it, cvv); }
}
__device__ __forceinline__ void p3_finalize(Frame& F) {
    const bf16* OFp = (const bf16*)(F.ws + WS_OF); const bf16* OBp = (const bf16*)(F.ws + WS_OB); const bf16* ZG = (const bf16*)(F.ws + WS_ZG); bf16* MIX = (bf16*)(F.ws + WS_MIX);
    const int gw = F.vcu * NWAVES + F.wave, NGW = F.G * NWAVES, sub = F.lane >> 4, l16 = F.lane & 15;
    for (int it = gw; it < T; it += NGW) {
        const size_t g = (size_t)it * 512 + sub * 128 + 8 * l16;
        const v4u a = *(const v4u*)(OFp + g), c = *(const v4u*)(OBp + g), z = *(const v4u*)(ZG + g);
        float o[8]; o[0] = bflo(a.x) + bflo(c.x); o[1] = bfhi(a.x) + bfhi(c.x); o[2] = bflo(a.y) + bflo(c.y); o[3] = bfhi(a.y) + bfhi(c.y);
        o[4] = bflo(a.z) + bflo(c.z); o[5] = bfhi(a.z) + bfhi(c.z); o[6] = bflo(a.w) + bflo(c.w); o[7] = bfhi(a.w) + bfhi(c.w);
        float ss = (o[0] * o[0] + o[1] * o[1]) + (o[2] * o[2] + o[3] * o[3]) + (o[4] * o[4] + o[5] * o[5]) + (o[6] * o[6] + o[7] * o[7]);
        ss += __shfl_xor(ss, 1); ss += __shfl_xor(ss, 2); ss += __shfl_xor(ss, 4); ss += __shfl_xor(ss, 8);
        const float r = 1.0f / sqrtf(ss * (1.0f / 128.0f) + RMS_EPS);
        v4u w; w.x = cvtpk_s(o[0] * r * bflo(z.x), o[1] * r * bfhi(z.x)); w.y = cvtpk_s(o[2] * r * bflo(z.y), o[3] * r * bfhi(z.y));
        w.z = cvtpk_s(o[4] * r * bflo(z.z), o[5] * r * bfhi(z.z)); w.w = cvtpk_s(o[6] * r * bflo(z.w), o[7] * r * bfhi(z.w));
        *(v4u*)(MIX + (size_t)it * D + 512 + sub * 128 + 8 * l16) = w;
    }
}

__device__ __forceinline__ void p5_router(Frame& F) {
    const bf16* U = (const bf16*)(F.ws + WS_U); bf16* H1 = (bf16*)(F.ws + WS_H1); unsigned char* H1F8 = F.ws + WS_H1F8; int* TOPI = (int*)(F.ws + WS_TOPI); float* TOPG = (float*)(F.ws + WS_TOPG); int* cntTab = (int*)(F.ws + WS_TAB);
    const float* Wr = FIN(F, 10); const float* br = FIN(F, 11); const float* lg = FIN(F, 8); const float* lb = FIN(F, 9);
    LAS float* part = (LAS float*)(F.lds + RING_OFF);
    LAS float* LGs = (LAS float*)(F.lds + RING_OFF + 1024);
    LAS int* hist = (LAS int*)(F.lds + HIST_OFF);
    const int w = F.wave, i16 = F.lane & 15, kg = F.lane >> 4, kcol = 128 * w + 8 * kg;
    pg8::bf16x8 bhi[4][2], blo[4][2];
#pragma unroll
    for (int ks = 0; ks < 4; ++ks)
#pragma unroll
        for (int nt = 0; nt < 2; ++nt) { v4u ph, pl; unsigned* phh = (unsigned*)&ph; unsigned* pll = (unsigned*)&pl;
#pragma unroll
            for (int j = 0; j < 8; j += 2) { const float x0 = Wr[(size_t)(kcol + 32 * ks + j) * NE + 16 * nt + i16], x1 = Wr[(size_t)(kcol + 32 * ks + j + 1) * NE + 16 * nt + i16];
                const unsigned hh = cvtpk_s(x0, x1); phh[j >> 1] = hh; pll[j >> 1] = cvtpk_s(x0 - bflo(hh), x1 - bfhi(hh)); }
            bhi[ks][nt] = __builtin_bit_cast(pg8::bf16x8, ph); blo[ks][nt] = __builtin_bit_cast(pg8::bf16x8, pl); }
    const float mybias = br[F.lane & 31];
    for (int chunk = F.vcu; chunk < NCHUNK; chunk += F.G) {
        __syncthreads();
        if (F.tid < NE) hist[F.tid] = 0;
        v4u ub[4];
#pragma unroll
        for (int ks = 0; ks < 4; ++ks) ub[ks] = *(const GAS v4u*)(U + (size_t)(chunk * CHUNK_TOK + i16) * D + kcol + 32 * ks);
        for (int it = 0; it < CHUNK_TOK / 16; ++it) {
            const int tok0 = chunk * CHUNK_TOK + it * 16, tok = tok0 + i16;
            f32x4 u[4][2]; float s1 = 0.f, s2 = 0.f;
#pragma unroll
            for (int ks = 0; ks < 4; ++ks) { u[ks][0] = (f32x4){bflo(ub[ks].x), bfhi(ub[ks].x), bflo(ub[ks].y), bfhi(ub[ks].y)}; u[ks][1] = (f32x4){bflo(ub[ks].z), bfhi(ub[ks].z), bflo(ub[ks].w), bfhi(ub[ks].w)};
#pragma unroll
                for (int q = 0; q < 2; ++q) { s1 += (u[ks][q][0] + u[ks][q][1]) + (u[ks][q][2] + u[ks][q][3]); s2 += (u[ks][q][0] * u[ks][q][0] + u[ks][q][1] * u[ks][q][1]) + (u[ks][q][2] * u[ks][q][2] + u[ks][q][3] * u[ks][q][3]); } }
            if (it + 1 < CHUNK_TOK / 16) {
#pragma unroll
                for (int ks = 0; ks < 4; ++ks) ub[ks] = *(const GAS v4u*)(U + (size_t)(tok + 16) * D + kcol + 32 * ks); }
            s1 += __shfl_xor(s1, 16); s1 += __shfl_xor(s1, 32); s2 += __shfl_xor(s2, 16); s2 += __shfl_xor(s2, 32);
            if (kg == 0) { part[(w * 16 + i16) * 2] = s1; part[(w * 16 + i16) * 2 + 1] = s2; }
            __syncthreads();
            float t1 = 0.f, t2 = 0.f;
#pragma unroll
            for (int ww = 0; ww < 8; ++ww) { t1 += part[(ww * 16 + i16) * 2]; t2 += part[(ww * 16 + i16) * 2 + 1]; }
            const float mean = t1 * (1.0f / D), rstd = 1.0f / sqrtf(fmaxf(t2 * (1.0f / D) - mean * mean, 0.f) + LN_EPS);
            f32x4 acc[2]; acc[0] = (f32x4){0.f, 0.f, 0.f, 0.f}; acc[1] = acc[0];
#pragma unroll
            for (int ks = 0; ks < 4; ++ks) { v4u ph, pl; unsigned* phh = (unsigned*)&ph; unsigned* pll = (unsigned*)&pl;
#pragma unroll
                for (int q = 0; q < 2; ++q) { const f32x4 gq = *(const f32x4*)(lg + kcol + 32 * ks + 4 * q), bq = *(const f32x4*)(lb + kcol + 32 * ks + 4 * q); const f32x4 y = (u[ks][q] - mean) * rstd * gq + bq;
                    const unsigned h0 = cvtpk_s(y[0], y[1]), h1 = cvtpk_s(y[2], y[3]); phh[2 * q] = h0; phh[2 * q + 1] = h1;
                    pll[2 * q] = cvtpk_s(y[0] - bflo(h0), y[1] - bfhi(h0)); pll[2 * q + 1] = cvtpk_s(y[2] - bflo(h1), y[3] - bfhi(h1)); }
                *(GAS v4u*)(H1 + (size_t)tok * D + kcol + 32 * ks) = ph;
                { u32x2 f8; f8.x = pk4_fp8(bflo(ph.x) * F8_SA, bfhi(ph.x) * F8_SA, bflo(ph.y) * F8_SA, bfhi(ph.y) * F8_SA); f8.y = pk4_fp8(bflo(ph.z) * F8_SA, bfhi(ph.z) * F8_SA, bflo(ph.w) * F8_SA, bfhi(ph.w) * F8_SA);
                  *(GAS u32x2*)(H1F8 + (size_t)tok * D + kcol + 32 * ks) = f8; }
                const pg8::bf16x8 ahi = __builtin_bit_cast(pg8::bf16x8, ph), alo = __builtin_bit_cast(pg8::bf16x8, pl);
#pragma unroll
                for (int nt = 0; nt < 2; ++nt) { acc[nt] = MFMA16(ahi, bhi[ks][nt], acc[nt]); acc[nt] = MFMA16(alo, bhi[ks][nt], acc[nt]); acc[nt] = MFMA16(ahi, blo[ks][nt], acc[nt]); } }
#pragma unroll
            for (int nt = 0; nt < 2; ++nt)
#pragma unroll
                for (int i = 0; i < 4; ++i) LGs[(w * 16 + 4 * kg + i) * 32 + 16 * nt + i16] = acc[nt][i];
            __syncthreads();
            {
                const int tl = 2 * w + (F.lane >> 5), e = F.lane & 31; float v = mybias;
#pragma unroll
                for (int ww = 0; ww < 8; ++ww) v += LGs[(ww * 16 + tl) * 32 + e];
                float tv[4]; int tix[4];
                const unsigned fb = __float_as_uint(v); unsigned key = (((fb & 0x80000000u) ? ~fb : (fb | 0x80000000u)) & ~31u) | (unsigned)(31 - e);
#pragma unroll
                for (int k = 0; k < 4; ++k) { unsigned x = key; unsigned y;
                    y = (unsigned)__builtin_amdgcn_update_dpp(0, (int)x, 0xB1, 0xF, 0xF, false); x = x > y ? x : y;
                    y = (unsigned)__builtin_amdgcn_update_dpp(0, (int)x, 0x4E, 0xF, 0xF, false); x = x > y ? x : y;
                    y = (unsigned)__builtin_amdgcn_update_dpp(0, (int)x, 0x141, 0xF, 0xF, false); x = x > y ? x : y;
                    y = (unsigned)__builtin_amdgcn_update_dpp(0, (int)x, 0x140, 0xF, 0xF, false); x = x > y ? x : y;
                    y = (unsigned)__shfl_xor((int)x, 16); x = x > y ? x : y;
                    tix[k] = 31 - (int)(x & 31u); const unsigned ob = x & ~31u; tv[k] = __uint_as_float((ob & 0x80000000u) ? (ob & 0x7fffffffu) : ~ob);
                    if (e == tix[k]) key = 0u; }
                const float e1 = __expf(tv[1] - tv[0]), e2 = __expf(tv[2] - tv[0]), e3 = __expf(tv[3] - tv[0]); const float inv = 1.0f / (1.0f + e1 + e2 + e3);
                if (e == 0) { const size_t tk = (size_t)(tok0 + tl);
                    *(int4*)(TOPI + tk * 4) = make_int4(tix[0], tix[1], tix[2], tix[3]); *(float4*)(TOPG + tk * 4) = make_float4(inv, e1 * inv, e2 * inv, e3 * inv);
                    atomicAdd((int*)&hist[tix[0]], 1); atomicAdd((int*)&hist[tix[1]], 1); atomicAdd((int*)&hist[tix[2]], 1); atomicAdd((int*)&hist[tix[3]], 1); }
            }
        }
        __syncthreads();
        if (F.tid < NE) cntTab[chunk * NE + F.tid] = hist[F.tid];
    }
}

__device__ __forceinline__ void p6_dispatch(Frame& F) {
    const int* cntTab = (const int*)(F.ws + WS_TAB); int* tileExpertG = (int*)(F.ws + WS_TAB + 65536); int* ntilesG = (int*)(F.ws + WS_TAB + 98304);
    const int* TOPI = (const int*)(F.ws + WS_TOPI); const float* TOPG = (const float*)(F.ws + WS_TOPG); int* ROWTOK = (int*)(F.ws + WS_ROWTOK); float* GATES = (float*)(F.ws + WS_GATES);
    LAS int* ptot = (LAS int*)(F.lds + RING_OFF);
    LAS int* ppre = ptot + 512;
    LAS int* tot = ppre + 512;
    LAS int* base = tot + 32;
    LAS int* myoff = base + 36;
    LAS int* wcnt = myoff + 32;
    for (int chunk = F.vcu; chunk < NCHUNK; chunk += F.G) {
        __syncthreads();
        { const int e = F.tid & 31, part = F.tid >> 5; int st = 0, sp = 0;
#pragma unroll
          for (int i = 0; i < 16; ++i) { const int w = part * 16 + i; const int c = cntTab[w * NE + e]; st += c; sp += (w < chunk) ? c : 0; }
          ptot[part * 32 + e] = st; ppre[part * 32 + e] = sp; }
        const size_t ge = (size_t)chunk * CHUNK_TOK * 4 + F.tid; const int me = TOPI[ge]; const float mg = TOPG[ge];
        int rank = 0, cntw = 0; const unsigned long long lt = (1ull << F.lane) - 1ull;
#pragma unroll 8
        for (int ee = 0; ee < NE; ++ee) { const unsigned long long m = __ballot(me == ee); if (me == ee) rank = __popcll(m & lt); if (F.lane == ee) cntw = __popcll(m); }
        if (F.lane < NE) wcnt[F.wave * 32 + F.lane] = cntw;
        __syncthreads();
        if (F.tid < NE) { int st = 0, sp = 0;
#pragma unroll
            for (int p = 0; p < 16; ++p) { st += ptot[p * 32 + F.tid]; sp += ppre[p * 32 + F.tid]; }
            tot[F.tid] = st; myoff[F.tid] = sp;
            int incl = (st + 255) & ~255;
#pragma unroll
            for (int o = 1; o < 32; o <<= 1) { const int t = __shfl_up(incl, o); if (F.tid >= o) incl += t; }
            base[F.tid + 1] = incl; if (F.tid == 0) base[0] = 0; }
        __syncthreads();
        { int pos = base[me] + myoff[me] + rank;
          for (int w = 0; w < F.wave; ++w) pos += wcnt[w * 32 + me];
          ROWTOK[pos] = (int)ge; GATES[pos] = mg; }
        if (chunk == 0) {
            for (int tl = F.tid; tl < MAXTILES; tl += NWAVES * 64) { int e = 0;
#pragma unroll 8
                for (int k = 1; k < NE; ++k) e += (tl * 256 >= base[k]) ? 1 : 0;
                tileExpertG[tl] = e; }
            if (F.tid < 256) for (int e = 0; e < NE; ++e) { const int s = base[e] + tot[e] + F.tid; if (s < base[e + 1]) { ROWTOK[s] = -1; GATES[s] = 0.f; } }
            if (F.tid == 0) ntilesG[0] = base[NE] >> 8;
        }
    }
}

typedef float f32x2v __attribute__((ext_vector_type(2)));
__device__ __forceinline__ void p9_combine(Frame& F) {
    const bf16* H1 = (const bf16*)(F.ws + WS_H1); const unsigned char* Y = F.ws + WS_Y;
    const int gw = F.vcu * NWAVES + F.wave, NGW = F.G * NWAVES;
    f32x4 gg[4], bb[4];
#pragma unroll
    for (int j = 0; j < 4; ++j) { gg[j] = ((const f32x4*)FIN(F, 16))[F.lane + 64 * j]; bb[j] = ((const f32x4*)FIN(F, 17))[F.lane + 64 * j]; }
    for (int tok = gw; tok < T; tok += NGW) {
        f32x4 v[4]; float s = 0.f;
#pragma unroll
        for (int j = 0; j < 4; ++j) { const u32x2 hb = ((const u32x2*)(H1 + (size_t)tok * D))[F.lane + 64 * j];
            f32x4 y = (f32x4){0.f, 0.f, 0.f, 0.f};
#pragma unroll
            for (int k = 0; k < 4; ++k) { const unsigned yb = ((const unsigned*)(Y + ((size_t)tok * 4 + k) * D))[F.lane + 64 * j];
                const f32x2v lo = __builtin_amdgcn_cvt_pk_f32_fp8((int)yb, false), hi = __builtin_amdgcn_cvt_pk_f32_fp8((int)yb, true); y[0] += lo[0]; y[1] += lo[1]; y[2] += hi[0]; y[3] += hi[1]; }
            v[j][0] = DN_ALPHA * bflo(hb.x) + y[0] * (1.0f / F8_SY); v[j][1] = DN_ALPHA * bfhi(hb.x) + y[1] * (1.0f / F8_SY); v[j][2] = DN_ALPHA * bflo(hb.y) + y[2] * (1.0f / F8_SY); v[j][3] = DN_ALPHA * bfhi(hb.y) + y[3] * (1.0f / F8_SY);
            s += (v[j].x + v[j].y) + (v[j].z + v[j].w); }
        const float mean = wave_sum(s) * (1.f / D); float s2 = 0.f;
#pragma unroll
        for (int j = 0; j < 4; ++j) { v[j] = v[j] - mean; s2 += (v[j].x * v[j].x + v[j].y * v[j].y) + (v[j].z * v[j].z + v[j].w * v[j].w); }
        const float rstd = 1.f / sqrtf(wave_sum(s2) * (1.f / D) + LN_EPS);
        GAS f32x4* o = (GAS f32x4*)(F.out + (size_t)tok * D) + F.lane;
#pragma unroll
        for (int j = 0; j < 4; ++j) o[64 * j] = v[j] * rstd * gg[j] + bb[j];
    }
}

struct Args { const float* in[18]; float* out; unsigned char* ws; int ph_lo, ph_hi, sub, pad; };
__global__ void __launch_bounds__(NWAVES * 64, 2) hymba_fwd(Args args) {
    extern __shared__ __attribute__((aligned(16))) unsigned char lds[];
    Frame F;
    F.lds = (LAS unsigned char*)lds;
    F.MISC = (volatile LAS unsigned*)(F.lds + MISC_OFF);
    F.tid = threadIdx.x; F.lane = F.tid & 63; F.wave = __builtin_amdgcn_readfirstlane(F.tid >> 6);
    F.G = gridDim.x; { const int bx = blockIdx.x; F.vcu = (F.G % 8 == 0) ? (bx % 8) * (F.G / 8) + bx / 8 : bx; }
    F.ws = args.ws; F.out = args.out; F.ctl = (gu32*)(args.ws + WS_CTL);
    F.ka = (const __attribute__((address_space(4))) unsigned char*)__builtin_amdgcn_kernarg_segment_ptr();
    static_assert(offsetof(Args, in) == 0, "the input pointers lead the kernarg segment");
    for (int u = F.tid; u < (LDS_BYTES - LDSCTL_OFF) / 4; u += NWAVES * 64) ((LAS unsigned*)(F.lds + LDSCTL_OFF))[u] = 0u;
    __syncthreads();
    XcdBarrier bar; bar.bar = (unsigned*)(F.ctl + CW_BAR); bar.x = 0; bar.st = nullptr;
    if (N_LAUNCHES == 1) bar = xcd_barrier_post((unsigned*)(F.ctl + CW_BAR), F.MISC + 8);
#define GRID_BAR() do { if (N_LAUNCHES == 1) xcd_barrier(bar); } while (0)
    const int lo = args.ph_lo, hi = args.ph_hi;
#define IN(k) (lo <= (k) && (k) < hi)
#define BOTH(k) (IN(k) && IN((k) + 1))
    unsigned char* ws = args.ws;

#ifndef PROBE_DBL
#define PROBE_DBL 0
#endif
#define DBL(k) ((PROBE_DBL >> (k)) & 1)
    if (IN(0)) { p0_prologue(F); if (DBL(0)) { __syncthreads(); p0_prologue(F); } if (BOTH(0)) GRID_BAR(); }

    if (IN(1)) {
        pg8::Gemm g{(const bf16*)(ws + WS_H0), (const bf16*)(ws + WS_WIN), T, NIN, D}; pg8::StaticOrder S; S.init(T, NIN, F.G, (int)blockIdx.x);
        EpiInProj E{(bf16*)(ws + WS_QA), (bf16*)(ws + WS_KA), (bf16*)(ws + WS_VA), (bf16*)(ws + WS_QH), (bf16*)(ws + WS_IH), (bf16*)(ws + WS_ZG), (bf16*)(ws + WS_LF), (bf16*)(ws + WS_LB), FIN(F, 5), FIN(F, 6)};
        pg8::gemm_phase<EpiInProj, pg8::StaticOrder, true, true>(F.lds + RING_OFF, g, S, E);
        if (DBL(1)) pg8::gemm_phase<EpiInProj, pg8::StaticOrder, true, true>(F.lds + RING_OFF, g, S, E);
        if (DBL(14)) { EpiNull EN{(int*)(ws + WS_TAB + 131072)}; pg8::gemm_phase<EpiNull, pg8::StaticOrder, true, true>(F.lds + RING_OFF, g, S, EN); }
        if (BOTH(1)) GRID_BAR();
    }
    if (IN(2)) { if (args.sub != 2) p2_attn(F); __syncthreads(); if (args.sub != 1) p2_hgrn2(F); if (DBL(2)) { __syncthreads(); p2_attn(F); __syncthreads(); p2_hgrn(F); } if (DBL(10)) { __syncthreads(); p2_attn(F); } if (DBL(11)) { __syncthreads(); p2_hgrn(F); } if (BOTH(2)) GRID_BAR(); }
    if (IN(3)) { p3_finalize(F); if (DBL(3)) p3_finalize(F); if (BOTH(3)) GRID_BAR(); }
    if (IN(4)) {
        pg8::Gemm g{(const bf16*)(ws + WS_MIX), (const bf16*)(ws + WS_WOUT), T, D, D}; pg8::StaticOrder S; S.init(T, D, F.G, (int)blockIdx.x);
        EpiOutProj E{(const bf16*)(ws + WS_H0), (bf16*)(ws + WS_U)};
        pg8::gemm_phase<EpiOutProj, pg8::StaticOrder, true, true>(F.lds + RING_OFF, g, S, E);
        if (DBL(4)) pg8::gemm_phase<EpiOutProj, pg8::StaticOrder, true, true>(F.lds + RING_OFF, g, S, E);
        if (BOTH(4)) GRID_BAR();
    }
    if (IN(5)) { p5_router(F); if (DBL(5)) { __syncthreads(); p5_router(F); } if (BOTH(5)) GRID_BAR(); }
    if (IN(6)) { p6_dispatch(F); if (DBL(6)) { __syncthreads(); p6_dispatch(F); } if (BOTH(6)) GRID_BAR(); }
    const int ntiles = (IN(7) || IN(8)) ? *(const int*)(ws + WS_TAB + 98304) : 0;
    if (IN(7) || IN(8)) {
        const int* tileExpertG = (const int*)(ws + WS_TAB + 65536); const int* ROWTOK = (const int*)(ws + WS_ROWTOK);
        __syncthreads();
        for (int i = F.tid; i < MAXTILES; i += NWAVES * 64) ((LAS int*)(F.lds + TAB_OFF))[i] = tileExpertG[i] & 31;
        if (IN(7)) for (int i = 0; i < MAXUNITS_WG; ++i) { const int tile = F.G == 256 ? moe_tile(i, (int)blockIdx.x, 8) : (i * F.G + (int)blockIdx.x) >> 3; if (tile >= ntiles) break;
            if (F.tid < 256) { const int rt = ROWTOK[tile * 256 + F.tid]; ((LAS unsigned short*)(F.lds + ROWL_OFF))[i * 256 + F.tid] = (unsigned short)((rt < 0 ? 0 : rt) >> 2); } }
        if (IN(8)) { const float* GATES = (const float*)(ws + WS_GATES);
            for (int i = 0; i < MAXDOWN_WG; ++i) { const int tile = F.G == 256 ? moe_tile(i, (int)blockIdx.x, 4) : (i * F.G + (int)blockIdx.x) >> 2; if (tile >= ntiles) break;
                if (F.tid < 256) { u32x2 t; t.x = (unsigned)ROWTOK[tile * 256 + F.tid]; t.y = __float_as_uint(GATES[tile * 256 + F.tid] * F8_SY); ((LAS u32x2*)(F.lds + DG_OFF))[i * 256 + F.tid] = t; } } }
        __syncthreads();
    }
    if (IN(7)) {
        pg8::Gemm g{(const bf16*)(ws + WS_H1F8), (const bf16*)(ws + WS_WUP), T, NE * DFF, D / 2}; MoeOrder S{(const LAS int*)(F.lds + TAB_OFF), ntiles, 8, F.G, (int)blockIdx.x};
        EpiUp E{ws + WS_ACT, FIN(F, 13)};
        pg8::gemm_phase<EpiUp, MoeOrder, true, true, true, true>(F.lds + RING_OFF, g, S, E, (const LAS unsigned short*)(F.lds + ROWL_OFF));
        if (DBL(7)) pg8::gemm_phase<EpiUp, MoeOrder, true, true, true, true>(F.lds + RING_OFF, g, S, E, (const LAS unsigned short*)(F.lds + ROWL_OFF));
        if (DBL(12)) { EpiNull EN{(int*)(ws + WS_TAB + 131072)}; pg8::gemm_phase<EpiNull, MoeOrder, true, true, true, true>(F.lds + RING_OFF, g, S, EN, (const LAS unsigned short*)(F.lds + ROWL_OFF)); }
        if (BOTH(7)) GRID_BAR();
    }
    if (IN(8)) {
        pg8::Gemm g{(const bf16*)(ws + WS_ACT), (const bf16*)(ws + WS_WD), MAXSLOTS, NE * D, D / 2}; MoeOrder S{(const LAS int*)(F.lds + TAB_OFF), ntiles, 4, F.G, (int)blockIdx.x};
        EpiDown E{ws + WS_Y, (const LAS u32x2*)(F.lds + DG_OFF), FIN(F, 15)};
        pg8::gemm_phase<EpiDown, MoeOrder, true, true, false, true>(F.lds + RING_OFF, g, S, E);
        if (DBL(8)) pg8::gemm_phase<EpiDown, MoeOrder, true, true, false, true>(F.lds + RING_OFF, g, S, E);
        if (DBL(13)) { EpiNull EN{(int*)(ws + WS_TAB + 131072)}; pg8::gemm_phase<EpiNull, MoeOrder, true, true, false, true>(F.lds + RING_OFF, g, S, EN); }
        if (BOTH(8)) GRID_BAR();
    }
    if (IN(9)) { p9_combine(F); if (DBL(9)) p9_combine(F); }
#undef IN
#undef BOTH
}

extern "C" void kernel_launch(void* const* d_in, const int* in_sizes, int n_in, void* d_out, int out_size, void* d_ws, size_t ws_size, hipStream_t stream) {
    static int grid = 0;
    if (grid == 0) {
        if (n_in != 18 || in_sizes[0] != T * D || out_size != T * D || ws_size < WS_END) { fprintf(stderr, "kernel_launch: unexpected shapes (n_in %d, in0 %d, out %d, ws %zu); nothing launched\n", n_in, n_in > 0 ? in_sizes[0] : -1, out_size, ws_size); grid = -1; return; }
        int dev = 0, cus = 0, per_cu = 0;
        if (hipGetDevice(&dev) != hipSuccess || hipDeviceGetAttribute(&cus, hipDeviceAttributeMultiprocessorCount, dev) != hipSuccess) { grid = -1; return; }
        if (hipFuncSetAttribute((const void*)hymba_fwd, hipFuncAttributeMaxDynamicSharedMemorySize, LDS_BYTES) != hipSuccess) { fprintf(stderr, "kernel_launch: hipFuncSetAttribute failed\n"); grid = -1; return; }
        if (hipOccupancyMaxActiveBlocksPerMultiprocessor(&per_cu, (const void*)hymba_fwd, NWAVES * 64, LDS_BYTES) != hipSuccess || per_cu < 1) fprintf(stderr, "kernel_launch: occupancy query says %d\n", per_cu);
        (void)hipGetLastError();
        grid = cus;
    }
    if (grid < 0) return;
    if (hipMemsetAsync((char*)d_ws + WS_CTL, 0, CTL_ZERO_BYTES, stream) != hipSuccess) return;
    Args a{};
    for (int i = 0; i < 18; ++i) a.in[i] = (const float*)d_in[i];
    a.out = (float*)d_out; a.ws = (unsigned char*)d_ws;
    if (N_LAUNCHES == 1) { a.ph_lo = 0; a.ph_hi = PER_PHASE; hipLaunchKernelGGL(hymba_fwd, dim3(grid), dim3(NWAVES * 64), LDS_BYTES, stream, a); }
    else for (int li = 0; li < PER_PHASE; ++li) { a.ph_lo = li; a.ph_hi = li + 1; hipLaunchKernelGGL(hymba_fwd, dim3(grid), dim3(NWAVES * 64), LDS_BYTES, stream, a);
#ifdef HOST_DBL
        if ((HOST_DBL >> li) & 1) {
#ifdef HOST_SUB
            a.sub = HOST_SUB;
#endif
            hipLaunchKernelGGL(hymba_fwd, dim3(grid), dim3(NWAVES * 64), LDS_BYTES, stream, a); a.sub = 0; }
#endif
    }
}
```

```cpp
#include <hip/hip_runtime.h>
#include <cstdio>
#include <cstdint>
#include <cstddef>
#ifndef MK_N_LAUNCHES
#define MK_N_LAUNCHES 1
#endif
namespace pg8 {
#define PG8_LAS __attribute__((address_space(3)))
typedef unsigned short bf16_t;
typedef short bf16x8 __attribute__((ext_vector_type(8)));
typedef float f32x4 __attribute__((ext_vector_type(4)));
typedef unsigned u32x4 __attribute__((ext_vector_type(4)));
constexpr int BM = 256, BK = 64, HALF = 128, HTB = HALF * BK * 2  , STAGE_BYTES = 8 * HTB, NXCD = 8, WGM = 8;

__host__ __device__ __forceinline__ int lds_byte(int r, int c) { const int st = (r >> 4) * 2 + (c >> 5), rr = r & 15, cc = c & 31, ob = rr * 64 + cc * 2; return st * 1024 + (ob ^ (((ob >> 9) & 1) << 5)); }
__host__ __device__ __forceinline__ void stage_rc(int b, int& R, int& C) { const int st = b / 1024, sb = b % 1024, swz = sb ^ (((sb >> 9) & 1) << 5); R = (st >> 1) * 16 + swz / 64; C = (st & 1) * 32 + (swz % 64) / 2; }
__host__ __device__ __forceinline__ int perm32(int rho) { const int n = rho >> 4, i = rho & 15; return 8 * (i >> 2) + 4 * n + (i & 3); }

struct Unit { int pm, pn, ord; };
struct Gemm { const bf16_t* A; const bf16_t* Bt; int M, N, K; };

struct StaticOrder {
    int nM, nN, nwg, G, c;
    __host__ __device__ void init(int M, int N, int G_, int c_) { nM = M / BM; nN = N / BM; nwg = nM * nN; G = G_; c = c_; }
    __host__ __device__ bool next(int i, Unit& u) const {
        const long L = (long)i * G + c; if (L >= nwg) return false;
        int wgid = (int)L; { const int q = nwg / NXCD, r = nwg % NXCD, xcd = wgid % NXCD, off = wgid / NXCD; wgid = (xcd < r ? xcd * (q + 1) : r * (q + 1) + (xcd - r) * q) + off; }
        const int nig = WGM * nN, gid = wgid / nig, fm = gid * WGM, gsz = (nM - fm) < WGM ? (nM - fm) : WGM;
        u.pm = fm + ((wgid % nig) % gsz); u.pn = (wgid % nig) / gsz; return true;
    }
    __device__ __forceinline__ void a_ready(const Unit&) const {}
    __device__ __forceinline__ void done(const Unit&) const {}
};

__device__ __forceinline__ unsigned cvt_pk_bf16(float lo, float hi) { unsigned r; asm volatile("v_cvt_pk_bf16_f32 %0, %1, %2" : "=v"(r) : "v"(lo), "v"(hi)); return r; }
typedef float f32x2 __attribute__((ext_vector_type(2)));
__device__ __forceinline__ f32x2 gelu_pk(f32x2 v) {
    const f32x2 av = __builtin_elementwise_abs(v), d = av * 0.2316418882f + 1.0f;
    f32x2 t; t.x = __builtin_amdgcn_rcpf(d.x); t.y = __builtin_amdgcn_rcpf(d.y);
    f32x2 q = t * 0.5307027145f + (-0.7265760135f); q = q * t + 0.7107068705f; q = q * t + (-0.142248368f); q = q * t + 0.127414796f; q = q * t;
    const f32x2 s = (v * v) * (-0.72134752044f);
    f32x2 e; e.x = __builtin_amdgcn_exp2f(s.x); e.y = __builtin_amdgcn_exp2f(s.y);
    const f32x2 m = v * (q * e), r = v - m;
    f32x2 o; o.x = v.x < 0.f ? m.x : r.x; o.y = v.y < 0.f ? m.y : r.y; return o;
}

template <int ACT  > struct EpiBf16 {
    static constexpr bool PERM = true, AFTER_DRAIN = false; static_assert(ACT == 0 || ACT == 1, "EpiBf16: ACT is 0 (none) or 1 (gelu_pk)");
    bf16_t* O; int ldc; const float* bias; int split_cols; size_t split_stride; float scale0;
    __device__ __forceinline__ void operator()(const f32x4 (&acc)[2][2][4][2], const Unit& u, int wr, int wc, int fr, int fq) const {
        const int row0 = u.pm * BM + wr * 64 + fr; int colt = u.pn * BM; bf16_t* base = O;
        float sc = 1.f; if (split_cols) { const int t = colt / split_cols; base += (size_t)t * split_stride; colt -= t * split_cols; if (t == 0) sc = scale0; }
        const int col0 = colt + wc * 32 + 8 * fq, bcol0 = u.pn * BM + wc * 32 + 8 * fq;
        f32x4 bv[2][2];
#pragma unroll
        for (int bj = 0; bj < 2; ++bj)
#pragma unroll
            for (int n = 0; n < 2; ++n) bv[bj][n] = bias ? *(const f32x4*)(bias + bcol0 + bj * HALF + 4 * n) : (f32x4){0.f, 0.f, 0.f, 0.f};
#pragma unroll
        for (int ai = 0; ai < 2; ++ai)
#pragma unroll
            for (int m = 0; m < 4; ++m) { bf16_t* rowp = base + (size_t)(row0 + ai * HALF + m * 16) * ldc + col0;
#pragma unroll
                for (int bj = 0; bj < 2; ++bj) { f32x4 v0 = acc[ai][bj][m][0] + bv[bj][0], v1 = acc[ai][bj][m][1] + bv[bj][1];
                    if (ACT == 1) { f32x2 a = gelu_pk((f32x2){v0[0], v0[1]}), b = gelu_pk((f32x2){v0[2], v0[3]}), c = gelu_pk((f32x2){v1[0], v1[1]}), d = gelu_pk((f32x2){v1[2], v1[3]});
                        v0 = (f32x4){a.x, a.y, b.x, b.y}; v1 = (f32x4){c.x, c.y, d.x, d.y}; }
                    v0 = v0 * sc; v1 = v1 * sc; u32x4 w; w.x = cvt_pk_bf16(v0[0], v0[1]); w.y = cvt_pk_bf16(v0[2], v0[3]); w.z = cvt_pk_bf16(v1[0], v1[1]); w.w = cvt_pk_bf16(v1[2], v1[3]);
                    *(u32x4*)(rowp + bj * HALF) = w; } }
    }
};
typedef int i32x8 __attribute__((ext_vector_type(8)));
template <class Epi, class Sched, bool ALIGN_EPI = false, bool SP2 = false, bool GATHER = false, bool FP8 = false>
__device__ __forceinline__ void gemm_phase(PG8_LAS unsigned char* lds, const Gemm g, const Sched& S, const Epi& E, const PG8_LAS unsigned short* rowl = nullptr) {
    static_assert(!GATHER || SP2, "GATHER is implemented for the SP2 loop only");
    const int tid = threadIdx.x, wid = __builtin_amdgcn_readfirstlane(tid >> 6), lane = tid & 63, wr = wid >> 2, wc = wid & 3, fr = lane & 15, fq = lane >> 4;
    const int K = g.K, nt = K / BK;
    unsigned voffA[2], voffB[2];
#pragma unroll
    for (int i = 0; i < 2; ++i) { int R, C; stage_rc(tid * 16 + i * 8192, R, C); const int Rb = Epi::PERM ? ((R & ~31) + perm32(R & 31)) : R;
        voffA[i] = (unsigned)(R * K + C) * 2u; voffB[i] = (unsigned)(Rb * K + C) * 2u; }
    const size_t kstep = (size_t)(BK * 2);
    const size_t hstep = (size_t)HALF * K * 2;
    const size_t tstep = 2 * hstep;
    const unsigned ldsw = (unsigned)wid * 1024u;
    const int aoff = lds_byte(wr * 64 + fr, fq * 8), boff = lds_byte(wc * 32 + fr, fq * 8);
#define PG8_SA(b, h) (((b) * 2 + (h)) * HTB)
#define PG8_SB(b, h) ((4 + (b) * 2 + (h)) * HTB)
#define PG8_STAGE(bufoff, gbase, voff) do { _Pragma("unroll") for (int _i = 0; _i < 2; ++_i) \
        __builtin_amdgcn_global_load_lds((const unsigned*)((const char*)(gbase) + (voff)[_i]), (PG8_LAS unsigned*)(lds + (bufoff) + ldsw + _i * 8192), 16, 0, 0); } while (0)
#define PG8_STAGE_AG(bufoff, kb, rw, h) do { _Pragma("unroll") for (int _i = 0; _i < 2; ++_i) \
        __builtin_amdgcn_global_load_lds((const unsigned*)((const char*)g.A + (kb) + (rw)[h][_i]), (PG8_LAS unsigned*)(lds + (bufoff) + ldsw + _i * 8192), 16, 0, 0); } while (0)
#define PG8_ROWS(rw, uidx) do { _Pragma("unroll") for (int _h = 0; _h < 2; ++_h) _Pragma("unroll") for (int _i = 0; _i < 2; ++_i) { int R_, C_; stage_rc(tid * 16 + _i * 8192, R_, C_); \
        (rw)[_h][_i] = (unsigned)rowl[(uidx) * 256 + _h * 128 + R_] * (unsigned)(K * 2) + (unsigned)(C_ * 2); } } while (0)
#define PG8_RD16(off) (*(const PG8_LAS bf16x8*)(lds + (off)))
#define PG8_CAT2(x, y) __builtin_bit_cast(i32x8, __builtin_shufflevector((x), (y), 0, 1, 2, 3, 4, 5, 6, 7, 8, 9, 10, 11, 12, 13, 14, 15))
#define PG8_LDA(dst, b, h) do { if constexpr (FP8) { _Pragma("unroll") for (int m = 0; m < 4; ++m) dst##8[m] = PG8_CAT2(PG8_RD16(PG8_SA(b, h) + aoff + m * 2048), PG8_RD16(PG8_SA(b, h) + aoff + m * 2048 + 1024)); } \
        else { _Pragma("unroll") for (int m = 0; m < 4; ++m) _Pragma("unroll") for (int k = 0; k < 2; ++k) dst[m][k] = PG8_RD16(PG8_SA(b, h) + aoff + m * 2048 + k * 1024); } } while (0)
#define PG8_LDB(dst, b, h) do { if constexpr (FP8) { _Pragma("unroll") for (int n = 0; n < 2; ++n) dst##8[n] = PG8_CAT2(PG8_RD16(PG8_SB(b, h) + boff + n * 2048), PG8_RD16(PG8_SB(b, h) + boff + n * 2048 + 1024)); } \
        else { _Pragma("unroll") for (int n = 0; n < 2; ++n) _Pragma("unroll") for (int k = 0; k < 2; ++k) dst[n][k] = PG8_RD16(PG8_SB(b, h) + boff + n * 2048 + k * 1024); } } while (0)
#define PG8_MMA(ai, bj, At, Bt) do { __builtin_amdgcn_s_setprio(1); if constexpr (FP8) { _Pragma("unroll") for (int m = 0; m < 4; ++m) _Pragma("unroll") for (int n = 0; n < 2; ++n) \
        asm volatile("v_mfma_scale_f32_16x16x128_f8f6f4 %0, %1, %2, %0, %3, %3 op_sel_hi:[0,0,0]" : "+v"(acc[ai][bj][m][n]) : "v"(Bt##8[n]), "v"(At##8[m]), "v"(f8scale)); } else { \
        _Pragma("unroll") for (int m = 0; m < 4; ++m) _Pragma("unroll") for (int n = 0; n < 2; ++n) _Pragma("unroll") for (int k = 0; k < 2; ++k) \
        acc[ai][bj][m][n] = __builtin_amdgcn_mfma_f32_16x16x32_bf16(Bt[n][k], At[m][k], acc[ai][bj][m][n], 0, 0, 0); } __builtin_amdgcn_s_setprio(0); } while (0)
#define PG8_WAIT_V(n) asm volatile("s_waitcnt vmcnt(" #n ")" ::: "memory")
#define PG8_WAIT_L(n) asm volatile("s_waitcnt lgkmcnt(" #n ")" ::: "memory")
#define PG8_BAR __builtin_amdgcn_s_barrier()
#define PG8_SCHED __builtin_amdgcn_sched_barrier(0)
    Unit cur, nxt; int ui = 0;
    if (!S.next(0, cur)) return;
    f32x4 acc[2][2][4][2];
#pragma unroll
    for (int a = 0; a < 2; ++a)
#pragma unroll
        for (int b = 0; b < 2; ++b)
#pragma unroll
            for (int m = 0; m < 4; ++m)
#pragma unroll
                for (int n = 0; n < 2; ++n) acc[a][b][m][n] = (f32x4){0.f, 0.f, 0.f, 0.f};
    const int f8scale = 0x7f7f7f7f;
    bf16x8 At[4][2], B0[2][2], B1[2][2]; i32x8 At8[4], B08[2], B18[2];
    const char* cA = (const char*)g.A + (size_t)cur.pm * tstep; const char* cB = (const char*)g.Bt + (size_t)cur.pn * tstep;
    S.a_ready(cur);
    unsigned rowC[2][2], rowN[2][2];
    if constexpr (GATHER) { PG8_ROWS(rowC, 0); _Pragma("unroll") for (int h_ = 0; h_ < 2; ++h_) _Pragma("unroll") for (int i_ = 0; i_ < 2; ++i_) rowN[h_][i_] = rowC[h_][i_]; }
    if constexpr (SP2) {
        PG8_STAGE(PG8_SB(0, 0), cB, voffB); PG8_STAGE(PG8_SB(0, 1), cB + hstep, voffB);
        if constexpr (GATHER) { PG8_STAGE_AG(PG8_SA(0, 0), (size_t)0, rowC, 0); PG8_STAGE_AG(PG8_SA(0, 1), (size_t)0, rowC, 1); } else { PG8_STAGE(PG8_SA(0, 0), cA, voffA); PG8_STAGE(PG8_SA(0, 1), cA + hstep, voffA); }
        if (wr == 1) PG8_BAR;
        PG8_WAIT_V(2); PG8_BAR;
        PG8_STAGE(PG8_SB(1, 0), cB + kstep, voffB); if constexpr (GATHER) PG8_STAGE_AG(PG8_SA(1, 0), kstep, rowC, 0); else PG8_STAGE(PG8_SA(1, 0), cA + kstep, voffA); PG8_STAGE(PG8_SB(1, 1), cB + hstep + kstep, voffB);
        PG8_WAIT_V(6); PG8_BAR;
    } else {
        PG8_STAGE(PG8_SB(0, 0), cB, voffB); PG8_STAGE(PG8_SA(0, 0), cA, voffA); PG8_STAGE(PG8_SB(0, 1), cB + hstep, voffB); PG8_STAGE(PG8_SA(0, 1), cA + hstep, voffA);
        if (wr == 1) PG8_BAR;
        PG8_WAIT_V(4); PG8_BAR;
        PG8_STAGE(PG8_SB(1, 0), cB + kstep, voffB); PG8_STAGE(PG8_SA(1, 0), cA + kstep, voffA); PG8_STAGE(PG8_SB(1, 1), cB + hstep + kstep, voffB);
        PG8_WAIT_V(6); PG8_BAR;
    }
    for (;;) {
        const bool has_next = S.next(ui + 1, nxt);
        if constexpr (GATHER) { if (has_next) PG8_ROWS(rowN, ui + 1); }
        const char* nA = has_next ? (const char*)g.A + (size_t)nxt.pm * tstep : cA; const char* nB = has_next ? (const char*)g.Bt + (size_t)nxt.pn * tstep : cB;
#pragma unroll 1
        for (int t = 0; t < nt; t += 2) {
            const bool last = (t == nt - 2);
            const char* a1 = cA + (size_t)(t + 1) * kstep;
            const char* a2 = last ? nA : cA + (size_t)(t + 2) * kstep; const char* b2 = last ? nB : cB + (size_t)(t + 2) * kstep;
            const char* a3 = a2 + kstep; const char* b3 = b2 + kstep;
            if (last && has_next) S.a_ready(nxt);
            if constexpr (SP2) {
            unsigned rs[2][2]; size_t k2 = 0;
            if constexpr (GATHER) { k2 = last ? (size_t)0 : (size_t)(t + 2) * kstep; _Pragma("unroll") for (int h_ = 0; h_ < 2; ++h_) _Pragma("unroll") for (int i_ = 0; i_ < 2; ++i_) rs[h_][i_] = last ? rowN[h_][i_] : rowC[h_][i_]; }
            PG8_LDB(B0, 0, 0); PG8_LDB(B1, 0, 1); PG8_SCHED; PG8_LDA(At, 0, 0); if constexpr (GATHER) PG8_STAGE_AG(PG8_SA(1, 1), (size_t)(t + 1) * kstep, rowC, 1); else PG8_STAGE(PG8_SA(1, 1), a1 + hstep, voffA);
            PG8_WAIT_V(8); PG8_WAIT_L(0); PG8_BAR; PG8_MMA(0, 0, At, B0); PG8_MMA(0, 1, At, B1); PG8_BAR; PG8_SCHED;
            PG8_LDA(At, 0, 1); PG8_STAGE(PG8_SB(0, 0), b2, voffB); PG8_STAGE(PG8_SB(0, 1), b2 + hstep, voffB); if constexpr (GATHER) PG8_STAGE_AG(PG8_SA(0, 0), k2, rs, 0); else PG8_STAGE(PG8_SA(0, 0), a2, voffA);
            PG8_WAIT_V(8); PG8_WAIT_L(0); PG8_BAR; PG8_MMA(1, 0, At, B0); PG8_MMA(1, 1, At, B1); PG8_BAR; PG8_SCHED;
            PG8_LDB(B0, 1, 0); PG8_LDB(B1, 1, 1); PG8_SCHED; PG8_LDA(At, 1, 0); if constexpr (GATHER) PG8_STAGE_AG(PG8_SA(0, 1), k2, rs, 1); else PG8_STAGE(PG8_SA(0, 1), a2 + hstep, voffA);
            PG8_WAIT_V(8); PG8_WAIT_L(0); PG8_BAR; PG8_MMA(0, 0, At, B0); PG8_MMA(0, 1, At, B1); PG8_BAR; PG8_SCHED;
            PG8_LDA(At, 1, 1); PG8_STAGE(PG8_SB(1, 0), b3, voffB); PG8_STAGE(PG8_SB(1, 1), b3 + hstep, voffB); if constexpr (GATHER) PG8_STAGE_AG(PG8_SA(1, 0), k2 + kstep, rs, 0); else PG8_STAGE(PG8_SA(1, 0), a3, voffA);
            PG8_WAIT_V(8); PG8_WAIT_L(0); PG8_BAR; PG8_MMA(1, 0, At, B0); PG8_MMA(1, 1, At, B1); PG8_BAR; PG8_SCHED;
            } else {
            PG8_LDB(B0, 0, 0); PG8_SCHED; PG8_LDA(At, 0, 0); PG8_STAGE(PG8_SA(1, 1), a1 + hstep, voffA);
            PG8_WAIT_L(8); PG8_BAR; PG8_WAIT_L(0); PG8_MMA(0, 0, At, B0); PG8_BAR; PG8_SCHED;
            PG8_LDB(B1, 0, 1); PG8_STAGE(PG8_SB(0, 0), b2, voffB);
            PG8_BAR; PG8_WAIT_L(0); PG8_MMA(0, 1, At, B1); PG8_BAR;
            PG8_LDA(At, 0, 1); PG8_STAGE(PG8_SA(0, 0), a2, voffA);
            PG8_BAR; PG8_WAIT_L(0); PG8_MMA(1, 0, At, B0); PG8_BAR; PG8_SCHED;
            PG8_STAGE(PG8_SB(0, 1), b2 + hstep, voffB);
            PG8_WAIT_V(6); PG8_BAR; PG8_MMA(1, 1, At, B1); PG8_BAR;
            PG8_LDB(B0, 1, 0); PG8_SCHED; PG8_LDA(At, 1, 0); PG8_STAGE(PG8_SA(0, 1), a2 + hstep, voffA);
            PG8_WAIT_L(8); PG8_BAR; PG8_WAIT_L(0); PG8_MMA(0, 0, At, B0); PG8_BAR; PG8_SCHED;
            PG8_LDB(B1, 1, 1); PG8_STAGE(PG8_SB(1, 0), b3, voffB);
            PG8_BAR; PG8_WAIT_L(0); PG8_MMA(0, 1, At, B1); PG8_BAR;
            PG8_LDA(At, 1, 1); PG8_STAGE(PG8_SA(1, 0), a3, voffA);
            PG8_BAR; PG8_WAIT_L(0); PG8_MMA(1, 0, At, B0); PG8_BAR; PG8_SCHED;
            PG8_STAGE(PG8_SB(1, 1), b3 + hstep, voffB);
            PG8_WAIT_V(6); PG8_BAR; PG8_MMA(1, 1, At, B1); PG8_BAR;
            }
        }
        if constexpr (ALIGN_EPI) { if (wr == 0) PG8_BAR; }
        if constexpr (!Epi::AFTER_DRAIN) { E(acc, cur, wr, wc, fr, fq); S.done(cur); }
        if (!has_next) break;
#pragma unroll
        for (int a = 0; a < 2; ++a)
#pragma unroll
            for (int b = 0; b < 2; ++b)
#pragma unroll
                for (int m = 0; m < 4; ++m)
#pragma unroll
                    for (int n = 0; n < 2; ++n) acc[a][b][m][n] = (f32x4){0.f, 0.f, 0.f, 0.f};
        cur = nxt; cA = nA; cB = nB; ++ui;
        if constexpr (GATHER) { _Pragma("unroll") for (int h_ = 0; h_ < 2; ++h_) _Pragma("unroll") for (int i_ = 0; i_ < 2; ++i_) rowC[h_][i_] = rowN[h_][i_]; }
        if constexpr (ALIGN_EPI) { if (wr == 1) PG8_BAR; }
    }
    PG8_WAIT_V(0);
    if constexpr (!ALIGN_EPI) { if (wr == 0) PG8_BAR; }
    PG8_BAR;
    if constexpr (Epi::AFTER_DRAIN) { E.fused(acc, cur, wr, wc, fr, fq, lds, wid, lane); S.done(cur); }
#undef PG8_SA
#undef PG8_SB
#undef PG8_STAGE
#undef PG8_STAGE_AG
#undef PG8_ROWS
#undef PG8_CAT2
#undef PG8_RD16
#undef PG8_LDA
#undef PG8_LDB
#undef PG8_MMA
#undef PG8_WAIT_V
#undef PG8_WAIT_L
#undef PG8_BAR
#undef PG8_SCHED
}
}

constexpr int NWAVES = 8;
#ifndef MK_N_LAUNCHES
#define MK_N_LAUNCHES 1
#endif
constexpr int PER_PHASE = 10;
constexpr int N_LAUNCHES = MK_N_LAUNCHES;

constexpr int NB = 16, SEQ = 2048, T = NB * SEQ, D = 1024, NIN = 3328, NE = 32, TOPK = 4, DFF = 2048;
constexpr int MAXTILES = T * TOPK / 256 + NE;
constexpr int MAXSLOTS = MAXTILES * 256;
constexpr int NCHUNK = 256, CHUNK_TOK = T / NCHUNK;
constexpr float LN_EPS = 1e-5f, RMS_EPS = 1e-6f, DN_ALPHA = 1.18920711500272f, SWIGLU_LIMIT = 7.0f, SWIGLU_ALPHA = 1.702f;

constexpr size_t MiB = 1u << 20;
constexpr size_t WS_CTL = 0, CTL_ZERO_BYTES = 1 * MiB;
constexpr size_t WS_TAB = 1 * MiB;
constexpr size_t WS_WIN = 2 * MiB, WS_WOUT = 9 * MiB, WS_WUP = 11 * MiB, WS_WD = 139 * MiB;
constexpr size_t WS_H1 = 203 * MiB;
constexpr size_t WS_TOPI = 267 * MiB, WS_TOPG = 268 * MiB, WS_SLOT = 269 * MiB, WS_ROWTOK = 270 * MiB, WS_GATES = 271 * MiB;
constexpr size_t WS_H0 = 272 * MiB, WS_QA = 336 * MiB, WS_KA = 368 * MiB, WS_VA = 376 * MiB, WS_QH = 384 * MiB, WS_IH = 416 * MiB, WS_LF = 448 * MiB, WS_LB = 512 * MiB,
                 WS_ZG = 576 * MiB, WS_OF = 608 * MiB, WS_OB = 672 * MiB, WS_MIX = 736 * MiB, WS_U = 800 * MiB;
constexpr size_t WS_XG = 272 * MiB, WS_ACT = 544 * MiB, WS_Y = 272 * MiB, WS_H1F8 = 680 * MiB, WS_END = 928 * MiB;
constexpr float F8_SA = 16.0f, F8_SWU = 64.0f, F8_SACT = 4.0f, F8_SWD = 64.0f, F8_SY = 64.0f;
constexpr int CW_TMO = 0, CW_CODE = 1, CW_BAR = 4096;

constexpr int RING_OFF = 0, RING_BYTES = 131072;
constexpr int TAB_OFF = 131072;
constexpr int HIST_OFF = 133248;
constexpr int ROWL_OFF = 133376, MAXUNITS_WG = 17;
constexpr int DG_OFF = 142080, MAXDOWN_WG = 9;
constexpr int LDSCTL_OFF = 160512, MISC_OFF = LDSCTL_OFF + 320;
constexpr int LDS_BYTES = 163840;
static_assert(TAB_OFF + MAXTILES * 4 <= HIST_OFF && HIST_OFF + 128 <= ROWL_OFF && ROWL_OFF + MAXUNITS_WG * 512 <= DG_OFF && DG_OFF + MAXDOWN_WG * 2048 <= LDSCTL_OFF && MISC_OFF + 128 <= LDS_BYTES, "LDS map");
#define GAS __attribute__((address_space(1)))
#define LAS __attribute__((address_space(3)))
typedef unsigned short bf16;
typedef unsigned v4u __attribute__((ext_vector_type(4)));
typedef float f32x4 __attribute__((ext_vector_type(4)));
typedef short bf16x8 __attribute__((ext_vector_type(8)));
typedef GAS unsigned gu32;
typedef GAS unsigned long long gu64;
#define RLX_AGENT __ATOMIC_RELAXED, __HIP_MEMORY_SCOPE_AGENT
#define LDS_WAIT() asm volatile("s_waitcnt lgkmcnt(0)" ::: "memory")
#define VM_WAIT() asm volatile("s_waitcnt vmcnt(0)" ::: "memory")
__device__ __forceinline__ unsigned long long rt() { return __builtin_amdgcn_s_memrealtime(); }
__device__ __forceinline__ unsigned f2bf(float f) { unsigned u = __builtin_bit_cast(unsigned, f); return (u + 0x7fffu + ((u >> 16) & 1u)) >> 16; }
__device__ __forceinline__ unsigned pk2(float lo, float hi) { return f2bf(lo) | (f2bf(hi) << 16); }
#define XB_TMO      128
#define XB_XCNT(j)  (256  + 64 * (j))
#define XB_XSUB(j)  (1280 + 64 * (j))
#define XB_XGEN(j)  (2304 + 64 * (j))
#define XB_TOP      3328
#define XB_TOPGEN   3392
#define XCD_BAR_WORDS 3456
#define XB_SPIN_CAP (1u << 18)

__device__ __forceinline__ unsigned xb_ld(unsigned* p)              { return __hip_atomic_load(p, __ATOMIC_RELAXED, __HIP_MEMORY_SCOPE_AGENT); }
__device__ __forceinline__ unsigned xb_add(unsigned* p, unsigned v) { return __hip_atomic_fetch_add(p, v, __ATOMIC_RELAXED, __HIP_MEMORY_SCOPE_AGENT); }
__device__ __forceinline__ unsigned xb_xcc_id() { return (unsigned)__builtin_amdgcn_s_getreg((3 << 11) | 20) & 0xFu; }
#define XB_SPIN(cond, bar) do { unsigned _sp = 0; while (cond) { __builtin_amdgcn_s_sleep(1); \
    if ((++_sp & 255u) == 0u) { if (xb_ld(&(bar)[XB_TMO])) break; if (_sp > XB_SPIN_CAP) { atomicAdd(&(bar)[XB_TMO], 1u); break; } } } } while (0)

struct XcdBarrier {
    unsigned* bar; unsigned x;
    volatile LAS unsigned* st;
};

__device__ __forceinline__ XcdBarrier xcd_barrier_post(unsigned* bar, volatile LAS unsigned* st) {
    XcdBarrier b; b.bar = bar; b.x = xb_xcc_id(); b.st = st;
    if (threadIdx.x == 0) (void)xb_add(&bar[XB_XCNT(b.x)], 1u);
    return b;
}
__device__ __forceinline__ void xcd_barrier_complete(unsigned* bar, unsigned x, unsigned& nloc, unsigned& nx) {
    const unsigned G = gridDim.x * gridDim.y * gridDim.z;
    unsigned sum, cnt, mine, sp = 0u;
    for (;;) {
        sum = 0u; cnt = 0u; mine = 0u;
#pragma unroll
        for (unsigned j = 0; j < 16; ++j) { const unsigned c = xb_ld(&bar[XB_XCNT(j)]); sum += c; cnt += (c > 0u) ? 1u : 0u; mine = (j == x) ? c : mine; }
        if (sum == G) break;
        __builtin_amdgcn_s_sleep(1);
        if ((++sp & 255u) == 0u) { if (xb_ld(&bar[XB_TMO])) break; if (sp > XB_SPIN_CAP) { atomicAdd(&bar[XB_TMO], 1u); break; } }
    }
    nloc = mine > 0u ? mine : 1u; nx = cnt > 0u ? cnt : 1u;
}

__device__ __forceinline__ void xcd_barrier(const XcdBarrier& b) {
    asm volatile("s_waitcnt vmcnt(0)" ::: "memory");
    __syncthreads();
    if (threadIdx.x == 0) {
        unsigned* bar = b.bar;
        __builtin_amdgcn_s_waitcnt(0);
        unsigned nloc = b.st[0], nx = b.st[1];
        if (nloc == 0u) { xcd_barrier_complete(bar, b.x, nloc, nx); b.st[0] = nloc; b.st[1] = nx; }
        const unsigned old = xb_add(&bar[XB_XSUB(b.x)], 1u);
        const unsigned gen = old / nloc;
        if (old + 1u == (gen + 1u) * nloc) {
            __builtin_amdgcn_fence(__ATOMIC_RELEASE, "agent");
            asm volatile("s_waitcnt vmcnt(0)" ::: "memory");
            const unsigned og = xb_add(&bar[XB_TOP], 1u);
            const unsigned tg = og / nx;
            if (og + 1u == (tg + 1u) * nx) xb_add(&bar[XB_TOPGEN], 1u);
            else XB_SPIN(xb_ld(&bar[XB_TOPGEN]) == tg, bar);
            __builtin_amdgcn_fence(__ATOMIC_ACQUIRE, "agent");
            xb_add(&bar[XB_XGEN(b.x)], 1u);
            asm volatile("s_waitcnt vmcnt(0)" ::: "memory");
        } else {
            XB_SPIN(xb_ld(&bar[XB_XGEN(b.x)]) == gen, bar);
            __builtin_amdgcn_fence(__ATOMIC_ACQUIRE, "agent");
            asm volatile("s_waitcnt vmcnt(0)" ::: "memory");
        }
    }
    __syncthreads();
}

typedef unsigned u32x2 __attribute__((ext_vector_type(2)));
typedef float f32x2_t __attribute__((ext_vector_type(2)));
typedef __bf16 bf16x2_t __attribute__((ext_vector_type(2)));
__device__ __forceinline__ float bflo(unsigned w) { return __uint_as_float(w << 16); }
__device__ __forceinline__ float bfhi(unsigned w) { return __uint_as_float(w & 0xffff0000u); }
__device__ __forceinline__ float fsigmoid(float z) { return __builtin_amdgcn_rcpf(1.0f + __expf(-z)); }
__device__ __forceinline__ v4u pack8(const f32x4 a, const f32x4 b) { v4u w; w.x = pg8::cvt_pk_bf16(a[0], a[1]); w.y = pg8::cvt_pk_bf16(a[2], a[3]); w.z = pg8::cvt_pk_bf16(b[0], b[1]); w.w = pg8::cvt_pk_bf16(b[2], b[3]); return w; }
__device__ __forceinline__ float clamp448(float x) { return __builtin_amdgcn_fmed3f(x, -448.0f, 448.0f); }
__device__ __forceinline__ unsigned pk4_fp8(float a, float b, float c, float d) { int w = __builtin_amdgcn_cvt_pk_fp8_f32(clamp448(a), clamp448(b), 0, false); w = __builtin_amdgcn_cvt_pk_fp8_f32(clamp448(c), clamp448(d), w, true); return (unsigned)w; }
__device__ __forceinline__ unsigned pk4_fp8_nc(float a, float b, float c, float d) { int w = __builtin_amdgcn_cvt_pk_fp8_f32(a, b, 0, false); w = __builtin_amdgcn_cvt_pk_fp8_f32(c, d, w, true); return (unsigned)w; }
__device__ __forceinline__ float wave_sum(float v) {
#pragma unroll
    for (int o = 1; o < 64; o <<= 1) v += __shfl_xor(v, o);
    return v;
}

struct EpiInProj {
    static constexpr bool PERM = true, AFTER_DRAIN = false;
    bf16 *QA, *KA, *VA, *QH, *IH, *ZG, *LF, *LB; const float *lbl, *normg;
    __device__ __forceinline__ void operator()(const f32x4 (&acc)[2][2][4][2], const pg8::Unit& u, int wr, int wc, int fr, int fq) const {
        const int row0 = u.pm * 256 + wr * 64 + fr, cl = wc * 32 + 8 * fq, pn = u.pn;
        if (pn == 2) {
#pragma unroll
            for (int ai = 0; ai < 2; ++ai)
#pragma unroll
                for (int m = 0; m < 4; ++m) { const size_t r = (size_t)(row0 + ai * 128 + m * 16);
                    *(v4u*)(KA + r * 128 + cl) = pack8(acc[ai][0][m][0], acc[ai][0][m][1]);
                    *(v4u*)(VA + r * 128 + cl) = pack8(acc[ai][1][m][0], acc[ai][1][m][1]); }
        } else if (pn < 7) {
            bf16* base = pn < 2 ? QA + pn * 256 : (pn < 5 ? QH + (pn - 3) * 256 : IH + (pn - 5) * 256);
            const float qs = pn < 2 ? 0.125f * 1.4426950408889634f : 1.0f;
#pragma unroll
            for (int ai = 0; ai < 2; ++ai)
#pragma unroll
                for (int m = 0; m < 4; ++m) { bf16* rowp = base + (size_t)(row0 + ai * 128 + m * 16) * 512 + cl;
#pragma unroll
                    for (int bj = 0; bj < 2; ++bj) *(v4u*)(rowp + bj * 128) = pack8(acc[ai][bj][m][0] * qs, acc[ai][bj][m][1] * qs); }
        } else if (pn < 11) {
            const int dir = pn >= 9 ? 1 : 0, cb = (pn - (dir ? 9 : 7)) * 256; bf16* base = (dir ? LB : LF) + cb;
#pragma unroll
            for (int bj = 0; bj < 2; ++bj) {
                float lb[8];
#pragma unroll
                for (int j = 0; j < 8; ++j) { const int col = cb + bj * 128 + cl + j; const float a0 = lbl[dir * 1024 + col], a1 = lbl[dir * 1024 + 512 + col]; lb[j] = 1.0f / (1.0f + __expf(a1 - a0)); }
#pragma unroll
                for (int ai = 0; ai < 2; ++ai)
#pragma unroll
                    for (int m = 0; m < 4; ++m) { bf16* rowp = base + (size_t)(row0 + ai * 128 + m * 16) * 512 + bj * 128 + cl;
                        f32x4 o0, o1, z0 = acc[ai][bj][m][0], z1 = acc[ai][bj][m][1];
                        asm volatile("" : "+v"(z0), "+v"(z1) :: "memory");
#pragma unroll
                        for (int j = 0; j < 4; ++j) { o0[j] = __logf(lb[j] + (1.0f - lb[j]) * fsigmoid(z0[j])); o1[j] = __logf(lb[4 + j] + (1.0f - lb[4 + j]) * fsigmoid(z1[j])); }
                        *(v4u*)rowp = pack8(o0, o1); }
            }
        } else {
            const int cb = (pn - 11) * 256;
#pragma unroll
            for (int bj = 0; bj < 2; ++bj) {
                const f32x4 g0 = *(const f32x4*)(normg + cb + bj * 128 + cl), g1 = *(const f32x4*)(normg + cb + bj * 128 + cl + 4);
#pragma unroll
                for (int ai = 0; ai < 2; ++ai)
#pragma unroll
                    for (int m = 0; m < 4; ++m) { bf16* rowp = ZG + (size_t)(row0 + ai * 128 + m * 16) * 512 + cb + bj * 128 + cl;
                        f32x4 o0, o1, y0 = acc[ai][bj][m][0], y1 = acc[ai][bj][m][1];
                        asm volatile("" : "+v"(y0), "+v"(y1) :: "memory");
#pragma unroll
                        for (int j = 0; j < 4; ++j) { const float z0 = y0[j], z1 = y1[j]; o0[j] = g0[j] * z0 * fsigmoid(z0); o1[j] = g1[j] * z1 * fsigmoid(z1); }
                        *(v4u*)rowp = pack8(o0, o1); }
            }
        }
    }
};
struct EpiOutProj {
    static constexpr bool PERM = true, AFTER_DRAIN = false;
    const bf16* H0; bf16* U;
    __device__ __forceinline__ void operator()(const f32x4 (&acc)[2][2][4][2], const pg8::Unit& u, int wr, int wc, int fr, int fq) const {
        const int row0 = u.pm * 256 + wr * 64 + fr, col0 = u.pn * 256 + wc * 32 + 8 * fq;
#pragma unroll
        for (int ai = 0; ai < 2; ++ai)
#pragma unroll
            for (int m = 0; m < 4; ++m) { const size_t off = (size_t)(row0 + ai * 128 + m * 16) * D + col0;
#pragma unroll
                for (int bj = 0; bj < 2; ++bj) { const v4u hb = *(const v4u*)(H0 + off + bj * 128);
                    f32x4 h0, h1; h0[0] = bflo(hb.x); h0[1] = bfhi(hb.x); h0[2] = bflo(hb.y); h0[3] = bfhi(hb.y); h1[0] = bflo(hb.z); h1[1] = bfhi(hb.z); h1[2] = bflo(hb.w); h1[3] = bfhi(hb.w);
                    *(v4u*)(U + off + bj * 128) = pack8(acc[ai][bj][m][0] + DN_ALPHA * h0, acc[ai][bj][m][1] + DN_ALPHA * h1); } }
    }
};
struct EpiUp {
    static constexpr bool PERM = false, AFTER_DRAIN = false;
    unsigned char* ACT; const float* b_up;
    __device__ __forceinline__ void operator()(const f32x4 (&acc)[2][2][4][2], const pg8::Unit& u, int wr, int wc, int fr, int fq) const {
        const int e = u.pn >> 3, p = u.pn & 7, row0 = u.pm * 256 + wr * 64 + fr, a0 = 128 * p + 32 * wc + 8 * fq;
        f32x4 bg[2], bl[2];
#pragma unroll
        for (int bj = 0; bj < 2; ++bj) { const f32x4 x = *(const f32x4*)(b_up + e * DFF + 2 * (a0 + 4 * bj)), y = *(const f32x4*)(b_up + e * DFF + 2 * (a0 + 4 * bj) + 4);
            bg[bj] = (f32x4){x[0], x[2], y[0], y[2]}; bl[bj] = (f32x4){x[1], x[3], y[1], y[3]}; }
#pragma unroll
        for (int ai = 0; ai < 2; ++ai)
#pragma unroll
            for (int m = 0; m < 4; ++m) { f32x4 o[2], zg[2] = {acc[ai][0][m][0], acc[ai][1][m][0]}, zl[2] = {acc[ai][0][m][1], acc[ai][1][m][1]};
                asm volatile("" : "+v"(zg[0]), "+v"(zg[1]), "+v"(zl[0]), "+v"(zl[1]) :: "memory");
#pragma unroll
                for (int bj = 0; bj < 2; ++bj)
#pragma unroll
                    for (int j = 0; j < 4; j += 2) {
                        constexpr float SC = 1.0f / (F8_SA * F8_SWU), NE2 = -SWIGLU_ALPHA * 1.4426950408889634f;
                        f32x2_t g2 = (f32x2_t){zg[bj][j], zg[bj][j + 1]} * SC + (f32x2_t){bg[bj][j], bg[bj][j + 1]}; g2[0] = fminf(g2[0], SWIGLU_LIMIT); g2[1] = fminf(g2[1], SWIGLU_LIMIT);
                        f32x2_t l2 = (f32x2_t){zl[bj][j], zl[bj][j + 1]} * SC + (f32x2_t){bl[bj][j], bl[bj][j + 1]}; l2[0] = __builtin_amdgcn_fmed3f(l2[0], -SWIGLU_LIMIT, SWIGLU_LIMIT); l2[1] = __builtin_amdgcn_fmed3f(l2[1], -SWIGLU_LIMIT, SWIGLU_LIMIT);
                        f32x2_t e2 = g2 * NE2; e2[0] = __builtin_amdgcn_exp2f(e2[0]); e2[1] = __builtin_amdgcn_exp2f(e2[1]); e2 = e2 + 1.0f;
                        f32x2_t r2; r2[0] = __builtin_amdgcn_rcpf(e2[0]); r2[1] = __builtin_amdgcn_rcpf(e2[1]);
                        const f32x2_t o2 = (g2 * r2) * (l2 * F8_SACT + F8_SACT);
                        o[bj][j] = o2[0]; o[bj][j + 1] = o2[1]; }
                u32x2 pw; pw.x = pk4_fp8_nc(o[0][0], o[0][1], o[0][2], o[0][3]); pw.y = pk4_fp8_nc(o[1][0], o[1][1], o[1][2], o[1][3]);
                *(u32x2*)(ACT + (size_t)(row0 + ai * 128 + m * 16) * D + a0) = pw; }
    }
};
struct EpiDown {
    static constexpr bool PERM = false, AFTER_DRAIN = false;
    unsigned char* Y; const LAS u32x2* dg; const float* b_down;
    __device__ __forceinline__ void operator()(const f32x4 (&acc)[2][2][4][2], const pg8::Unit& u, int wr, int wc, int fr, int fq) const {
        const int e = u.pn >> 2, colt = (u.pn & 3) * 256 + wc * 64 + 16 * fq, r0 = u.ord * 256 + wr * 64 + fr;
        int dest[2][4]; float gt[2][4];
#pragma unroll
        for (int ai = 0; ai < 2; ++ai)
#pragma unroll
            for (int m = 0; m < 4; ++m) { const u32x2 t = dg[r0 + ai * 128 + m * 16]; dest[ai][m] = (int)t.x; gt[ai][m] = __uint_as_float(t.y); }
        f32x4 bv[2][2];
#pragma unroll
        for (int bj = 0; bj < 2; ++bj)
#pragma unroll
            for (int n = 0; n < 2; ++n) bv[bj][n] = *(const f32x4*)(b_down + e * D + colt + 8 * bj + 4 * n);
#pragma unroll
        for (int ai = 0; ai < 2; ++ai)
#pragma unroll
            for (int m = 0; m < 4; ++m) { const float g = gt[ai][m];
                if (dest[ai][m] >= 0) { v4u pw; unsigned pq[4];
#pragma unroll
                    for (int bj = 0; bj < 2; ++bj)
#pragma unroll
                        for (int n = 0; n < 2; ++n) { const f32x4 y = (acc[ai][bj][m][n] * (1.0f / (F8_SACT * F8_SWD)) + bv[bj][n]) * g; pq[2 * bj + n] = pk4_fp8(y[0], y[1], y[2], y[3]); }
                    pw.x = pq[0]; pw.y = pq[1]; pw.z = pq[2]; pw.w = pq[3];
                    *(v4u*)(Y + (size_t)dest[ai][m] * D + colt) = pw; } }
    }
};
struct EpiNull { static constexpr bool PERM = false, AFTER_DRAIN = false; int* sink;
    __device__ __forceinline__ void operator()(const f32x4 (&acc)[2][2][4][2], const pg8::Unit& u, int wr, int wc, int fr, int fq) const { if (acc[0][0][0][0][0] == 1.2345e-33f) sink[0] = 1; } };
__device__ __forceinline__ int moe_tile(int i, int c, int nN) { const int slot = c >> 3, g = i * 8 + (c & 7); return nN == 8 ? g * 4 + (slot >> 3) : g * 8 + (slot >> 2); }
struct MoeOrder {
    const LAS int* tileExpert; int ntiles, nN, G, c;
    __device__ __forceinline__ bool next(int i, pg8::Unit& u) const {
        int tile, n;
        if (G == 256) { tile = moe_tile(i, c, nN); n = (c >> 3) & (nN - 1); }
        else { const int L = i * G + c; tile = L / nN; n = L - tile * nN; }
        if (tile >= ntiles) return false;
        u.pm = tile; u.pn = tileExpert[tile] * nN + n; u.ord = i; return true;
    }
    __device__ __forceinline__ void a_ready(const pg8::Unit&) const {}
    __device__ __forceinline__ void done(const pg8::Unit&) const {}
};

struct Frame {
    LAS unsigned char* lds;
    volatile LAS unsigned* MISC;
    gu32* ctl;
    int tid, lane, wave;
    int vcu, G;
    const __attribute__((address_space(4))) unsigned char* ka;
    float* out; unsigned char* ws;
};
#define FIN(F_, k_) (*(const float* const __attribute__((address_space(4)))*)((F_).ka + 8 * (k_)))

__device__ __forceinline__ int up_srccol(int dn) { const int p = dn >> 8, rho = dn & 255, bj = rho >> 7, wc = (rho >> 5) & 3, n = (rho >> 4) & 1, fq = (rho >> 2) & 3, j = rho & 3;
    return 2 * (128 * p + 32 * wc + 8 * fq + 4 * bj + j) + n; }
template <bool UPPERM>
__device__ __forceinline__ void p0_transpose_item(const float* W, int K, int N, bf16* WT, LAS float* scr, int item, int lane) {
    const int nblk = N / 32, kb = item / nblk, nb = item % nblk, k0 = 64 * kb, n0 = 32 * nb;
    const int sc = UPPERM ? up_srccol(n0 + (lane & 31)) : n0 + (lane & 31);
#pragma unroll 8
    for (int i = 0; i < 32; ++i) { const int kk = 2 * i + (lane >> 5); scr[kk * 33 + (lane & 31)] = W[(size_t)(k0 + kk) * N + sc]; }
    LDS_WAIT(); asm volatile("" ::: "memory");
    const int c = lane & 7;
#pragma unroll
    for (int j = 0; j < 4; ++j) { const int n = (lane >> 3) + 8 * j; const LAS float* s = scr + (8 * c) * 33 + n;
        v4u o; o.x = pk2(s[0 * 33], s[1 * 33]); o.y = pk2(s[2 * 33], s[3 * 33]); o.z = pk2(s[4 * 33], s[5 * 33]); o.w = pk2(s[6 * 33], s[7 * 33]);
        *(GAS v4u*)(WT + (size_t)(n0 + n) * K + k0 + 8 * c) = o; }
    LDS_WAIT(); asm volatile("" ::: "memory");
}
template <bool UPPERM>
__device__ __forceinline__ void p0_transpose_item_f8(const float* W, int K, int N, unsigned char* WT, LAS float* scr, int item, int lane, float scale) {
    const int nblk = N / 32, kb = item / nblk, nb = item % nblk, k0 = 64 * kb, n0 = 32 * nb;
    const int sc = UPPERM ? up_srccol(n0 + (lane & 31)) : n0 + (lane & 31);
#pragma unroll 8
    for (int i = 0; i < 32; ++i) { const int kk = 2 * i + (lane >> 5); scr[kk * 33 + (lane & 31)] = W[(size_t)(k0 + kk) * N + sc]; }
    LDS_WAIT(); asm volatile("" ::: "memory");
    const int n = lane >> 1, hf = lane & 1; const LAS float* s = scr + (32 * hf) * 33 + n;
    unsigned o[8];
#pragma unroll
    for (int q = 0; q < 8; ++q) o[q] = pk4_fp8(s[(4 * q) * 33] * scale, s[(4 * q + 1) * 33] * scale, s[(4 * q + 2) * 33] * scale, s[(4 * q + 3) * 33] * scale);
    GAS v4u* dst = (GAS v4u*)(WT + (size_t)(n0 + n) * K + k0 + 32 * hf);
    dst[0] = (v4u){o[0], o[1], o[2], o[3]}; dst[1] = (v4u){o[4], o[5], o[6], o[7]};
    LDS_WAIT(); asm volatile("" ::: "memory");
}
__device__ __forceinline__ int up_dstrow(int sc) { const int n = sc & 1, a = sc >> 1, p = a >> 7, al = a & 127, wc = al >> 5, fq = (al >> 3) & 3, bj = (al >> 2) & 1, j = al & 3;
    return 256 * p + 128 * bj + 32 * wc + 16 * n + 4 * fq + j; }
__device__ __forceinline__ int down_dstrow(int sc) { const int c = sc & 255, wc = c >> 6, fq = (c >> 4) & 3, bj = (c >> 3) & 1, n = (c >> 2) & 1, rg = c & 3; return (sc & ~255) + 128 * bj + 32 * wc + 16 * n + 4 * fq + rg; }
constexpr int CV_UP1 = (D / 128) * (DFF / 16), CV_DN1 = (D / 128) * (D / 16), CV_NUP = NE * CV_UP1, CV_NITEMS = CV_NUP + NE * CV_DN1;
__device__ __forceinline__ void cv_load(const Frame& F, int it, f32x4 (&v)[8]) {
    static_assert(CV_UP1 == 1024 && CV_DN1 == 512 && DFF == 2048 && D == 1024, "shift decomposition below");
    const bool up = it < CV_NUP; const int r = up ? it : it - CV_NUP, sh = up ? 10 : 9, N = up ? DFF : D, e = r >> sh, item = r & ((1 << sh) - 1);
    const float* W = (up ? FIN(F, 12) : FIN(F, 14)) + (size_t)e * D * N;
    const int kb0 = item >> (sh - 3), nb = item & ((1 << (sh - 3)) - 1), k0 = 128 * kb0 + 8 * (F.lane >> 2), n0 = 16 * nb + 4 * (F.lane & 3);
#pragma unroll
    for (int i = 0; i < 8; ++i) v[i] = *(const GAS f32x4*)(W + (size_t)(k0 + i) * N + n0);
}
__device__ __forceinline__ void cv_store(const Frame& F, int it, const f32x4 (&v)[8]) {
    const bool up = it < CV_NUP; const int r = up ? it : it - CV_NUP, sh = up ? 10 : 9, N = up ? DFF : D, e = r >> sh, item = r & ((1 << sh) - 1);
    unsigned char* WT = F.ws + (up ? WS_WUP : WS_WD) + (size_t)e * N * D; const float scale = up ? F8_SWU : F8_SWD;
    const int kb0 = item >> (sh - 3), nb = item & ((1 << (sh - 3)) - 1), k0 = 128 * kb0 + 8 * (F.lane >> 2), n0 = 16 * nb + 4 * (F.lane & 3);
#pragma unroll
    for (int j = 0; j < 4; ++j) { const int dn = up ? up_dstrow(n0 + j) : down_dstrow(n0 + j);
        u32x2 o; o.x = pk4_fp8(v[0][j] * scale, v[1][j] * scale, v[2][j] * scale, v[3][j] * scale); o.y = pk4_fp8(v[4][j] * scale, v[5][j] * scale, v[6][j] * scale, v[7][j] * scale);
        *(GAS u32x2*)(WT + (size_t)dn * D + k0) = o; }
}
__device__ __forceinline__ void p0_prologue(Frame& F) {
    LAS float* scr = (LAS float*)(F.lds + RING_OFF + F.wave * 16384);
    const int gw = F.vcu * NWAVES + F.wave, NGW = F.G * NWAVES;
    constexpr int I_IN = (D / 64) * (NIN / 32), I_OUT = (D / 64) * (D / 32);
    bf16* WinT = (bf16*)(F.ws + WS_WIN); bf16* WoutT = (bf16*)(F.ws + WS_WOUT); unsigned char* WupT = (unsigned char*)(F.ws + WS_WUP); unsigned char* WdT = (unsigned char*)(F.ws + WS_WD);
    for (int it = gw; it < I_IN + I_OUT; it += NGW) {
        if (it < I_IN) p0_transpose_item<false>(FIN(F, 3), D, NIN, WinT, scr, it, F.lane); else p0_transpose_item<false>(FIN(F, 7), D, D, WoutT, scr, it - I_IN, F.lane);
    }
    (void)WupT; (void)WdT;
    const float* x = FIN(F, 0); bf16* H0 = (bf16*)(F.ws + WS_H0);
    f32x4 gg[4], bb[4];
#pragma unroll
    for (int j = 0; j < 4; ++j) { gg[j] = ((const f32x4*)FIN(F, 1))[F.lane + 64 * j]; bb[j] = ((const f32x4*)FIN(F, 2))[F.lane + 64 * j]; }
    for (int m = gw; m < T; m += NGW) {
        const GAS f32x4* xr = (const GAS f32x4*)(x + (size_t)m * D) + F.lane;
        f32x4 v[4]; float s = 0.f;
#pragma unroll
        for (int j = 0; j < 4; ++j) { v[j] = xr[64 * j]; s += (v[j].x + v[j].y) + (v[j].z + v[j].w); }
        const float mean = wave_sum(s) * (1.f / D); float s2 = 0.f;
#pragma unroll
        for (int j = 0; j < 4; ++j) { v[j] = v[j] - mean; s2 += (v[j].x * v[j].x + v[j].y * v[j].y) + (v[j].z * v[j].z + v[j].w * v[j].w); }
        const float rstd = 1.f / sqrtf(wave_sum(s2) * (1.f / D) + LN_EPS);
        GAS u32x2* o8 = (GAS u32x2*)(H0 + (size_t)m * D) + F.lane;
#pragma unroll
        for (int j = 0; j < 4; ++j) { const f32x4 y = v[j] * rstd * gg[j] + bb[j]; u32x2 w; w.x = pg8::cvt_pk_bf16(y[0], y[1]); w.y = pg8::cvt_pk_bf16(y[2], y[3]); o8[64 * j] = w; }
    }
}

typedef float f32x16 __attribute__((ext_vector_type(16)));
typedef short s16x4 __attribute__((ext_vector_type(4)));
__device__ __forceinline__ unsigned cvtpk_s(float lo, float hi) { f32x2_t v = {lo, hi}; bf16x2_t b = __builtin_convertvector(v, bf16x2_t); return __builtin_bit_cast(unsigned, b); }
#define MFMA32(a, b, c) __builtin_amdgcn_mfma_f32_32x32x16_bf16((a), (b), (c), 0, 0, 0)
constexpr int AK_PITCH = 144, AV_PITCH = 776, AV_OFF = 384 * AK_PITCH;
static_assert(AV_OFF + 64 * AV_PITCH <= RING_BYTES, "attention LDS");
__device__ __forceinline__ void p2_attn(Frame& F) {
    const bf16* QA = (const bf16*)(F.ws + WS_QA); const bf16* KA = (const bf16*)(F.ws + WS_KA); const bf16* VA = (const bf16*)(F.ws + WS_VA); bf16* MIX = (bf16*)(F.ws + WS_MIX);
    const float* sink = FIN(F, 4);
    LAS unsigned char* Ks = F.lds + RING_OFF; LAS unsigned char* Vt = Ks + AV_OFF;
    const int r = F.lane & 31, h = F.lane >> 5;
    constexpr float LOG2E = 1.4426950408889634f;
    v4u kreg[6], vreg[6];
#define AT_LOADKV(unit_) do { const int n_ = (unit_) & 15, g_ = ((unit_) >> 4) & 1, b_ = (unit_) >> 5, kb_ = n_ * 128 - 128; \
        _Pragma("unroll") for (int i = 0; i < 6; ++i) { const int c = F.tid + 512 * i, row = c >> 3, ch = c & 7; int pos = kb_ + row; pos = pos < 0 ? 0 : (pos >= SEQ ? SEQ - 1 : pos); \
            kreg[i] = *(const v4u*)(KA + ((size_t)b_ * SEQ + pos) * 128 + g_ * 64 + ch * 8); } \
        _Pragma("unroll") for (int i = 0; i < 3; ++i) { const int it = F.tid + 512 * i, kp = it % 192, ch = it / 192; int pos = kb_ + 2 * kp; pos = pos < 0 ? 0 : (pos >= SEQ ? SEQ - 2 : pos); \
            const bf16* vp = VA + ((size_t)b_ * SEQ + pos) * 128 + g_ * 64 + ch * 8; vreg[2 * i] = *(const v4u*)vp; vreg[2 * i + 1] = *(const v4u*)(vp + 128); } } while (0)
    if (F.vcu < NB * 2 * 16) AT_LOADKV(F.vcu);
    for (int unit = F.vcu; unit < NB * 2 * 16; unit += F.G) {
        const int n = unit & 15, g = (unit >> 4) & 1, b = unit >> 5, kbase = n * 128 - 128;
        const int head = g * 4 + (F.wave >> 1), qw0 = n * 128 + (F.wave & 1) * 64;
        pg8::bf16x8 qf[2][4];
#pragma unroll
        for (int qb = 0; qb < 2; ++qb) { const bf16* qp = QA + ((size_t)b * SEQ + qw0 + qb * 32 + r) * 512 + head * 64 + 8 * h;
#pragma unroll
            for (int ds = 0; ds < 4; ++ds) qf[qb][ds] = *(const pg8::bf16x8*)(qp + 16 * ds); }
        __syncthreads();
#pragma unroll
        for (int i = 0; i < 6; ++i) { const int c = F.tid + 512 * i, row = c >> 3, ch = c & 7; *(LAS v4u*)(Ks + row * AK_PITCH + ch * 16) = kreg[i]; }
#pragma unroll
        for (int i = 0; i < 3; ++i) { const int it = F.tid + 512 * i, kp = it % 192, ch = it / 192; const v4u w0 = vreg[2 * i], w1 = vreg[2 * i + 1];
            LAS unsigned char* dst = Vt + (ch * 8) * AV_PITCH + kp * 4;
            *(LAS unsigned*)(dst + 0 * AV_PITCH) = (w0.x & 0xffffu) | (w1.x << 16); *(LAS unsigned*)(dst + 1 * AV_PITCH) = (w0.x >> 16) | (w1.x & 0xffff0000u);
            *(LAS unsigned*)(dst + 2 * AV_PITCH) = (w0.y & 0xffffu) | (w1.y << 16); *(LAS unsigned*)(dst + 3 * AV_PITCH) = (w0.y >> 16) | (w1.y & 0xffff0000u);
            *(LAS unsigned*)(dst + 4 * AV_PITCH) = (w0.z & 0xffffu) | (w1.z << 16); *(LAS unsigned*)(dst + 5 * AV_PITCH) = (w0.z >> 16) | (w1.z & 0xffff0000u);
            *(LAS unsigned*)(dst + 6 * AV_PITCH) = (w0.w & 0xffffu) | (w1.w << 16); *(LAS unsigned*)(dst + 7 * AV_PITCH) = (w0.w >> 16) | (w1.w & 0xffff0000u); }
        if (unit + F.G < NB * 2 * 16) AT_LOADKV(unit + F.G);
        __syncthreads();
        const float slope2 = __builtin_amdgcn_exp2f(-(float)(head + 1)) * LOG2E, sink2 = sink[head] * LOG2E;
#pragma unroll
        for (int qb = 0; qb < 2; ++qb) {
            const int q0 = qw0 + qb * 32;
            f32x16 o0, o1;
#pragma unroll
            for (int i = 0; i < 16; ++i) { o0[i] = 0.f; o1[i] = 0.f; }
            float m = sink2, l = (h == 0) ? 1.0f : 0.0f;
            const int kt_lo = (q0 - 128) < 0 ? 0 : q0 - 128, kt_hi = (q0 + 128) > SEQ - 32 ? SEQ - 32 : q0 + 128;
            f32x16 sn;
#define AT_QK(dst, k0_) do { _Pragma("unroll") for (int i = 0; i < 16; ++i) dst[i] = 0.f; \
                _Pragma("unroll") for (int ds = 0; ds < 4; ++ds) { const pg8::bf16x8 kf = *(const LAS pg8::bf16x8*)(Ks + ((k0_) - kbase + r) * AK_PITCH + ds * 32 + h * 16); dst = MFMA32(kf, qf[qb][ds], dst); } } while (0)
            AT_QK(sn, kt_lo);
            for (int k0 = kt_lo; k0 <= kt_hi; k0 += 32) {
                const int kl = k0 - kbase;
                f32x16 s = sn;
                if (k0 + 32 <= kt_hi) AT_QK(sn, k0 + 32);
                const float base = (float)(q0 + r - k0 - 4 * h);
                const bool partial = (k0 < q0 + 31 - 128) || (k0 + 31 > q0 + 128);
                float mt = -INFINITY;
                if (partial) {
#pragma unroll
                    for (int i = 0; i < 16; ++i) { const float dist = fabsf(base - (float)((i & 3) + 8 * (i >> 2))); float sv = s[i] - slope2 * dist; sv = dist <= 128.0f ? sv : -INFINITY; s[i] = sv; mt = fmaxf(mt, sv); }
                } else {
#pragma unroll
                    for (int i = 0; i < 16; ++i) { const float dist = fabsf(base - (float)((i & 3) + 8 * (i >> 2))); const float sv = s[i] - slope2 * dist; s[i] = sv; mt = fmaxf(mt, sv); }
                }
                mt = fmaxf(mt, __shfl_xor(mt, 32));
                if (__any(mt > m)) {
                    const float mn = fmaxf(m, mt), alpha = __builtin_amdgcn_exp2f(m - mn); m = mn; l *= alpha;
#pragma unroll
                    for (int i = 0; i < 16; ++i) { o0[i] *= alpha; o1[i] *= alpha; }
                }
                float ps = 0.f;
#pragma unroll
                for (int i = 0; i < 16; ++i) { s[i] = __builtin_amdgcn_exp2f(s[i] - m); ps += s[i]; }
                l += ps;
#pragma unroll
                for (int sp = 0; sp < 2; ++sp) {
                    v4u pw; pw.x = cvtpk_s(s[8 * sp], s[8 * sp + 1]); pw.y = cvtpk_s(s[8 * sp + 2], s[8 * sp + 3]); pw.z = cvtpk_s(s[8 * sp + 4], s[8 * sp + 5]); pw.w = cvtpk_s(s[8 * sp + 6], s[8 * sp + 7]);
                    const pg8::bf16x8 pf = __builtin_bit_cast(pg8::bf16x8, pw);
                    const LAS unsigned char* vp = Vt + r * AV_PITCH + (kl + 16 * sp + 4 * h) * 2;
                    { const s16x4 lo = *(const LAS s16x4*)vp, hi = *(const LAS s16x4*)(vp + 16); o0 = MFMA32(__builtin_shufflevector(lo, hi, 0, 1, 2, 3, 4, 5, 6, 7), pf, o0); }
                    { const s16x4 lo = *(const LAS s16x4*)(vp + 32 * AV_PITCH), hi = *(const LAS s16x4*)(vp + 32 * AV_PITCH + 16); o1 = MFMA32(__builtin_shufflevector(lo, hi, 0, 1, 2, 3, 4, 5, 6, 7), pf, o1); }
                }
            }
            l += __shfl_xor(l, 32); const float inv = 1.0f / l;
            bf16* op = MIX + ((size_t)b * SEQ + q0 + r) * D + head * 64 + 4 * h;
#pragma unroll
            for (int gi = 0; gi < 4; ++gi) {
                u32x2 w0; w0.x = cvtpk_s(o0[4 * gi] * inv, o0[4 * gi + 1] * inv); w0.y = cvtpk_s(o0[4 * gi + 2] * inv, o0[4 * gi + 3] * inv); *(u32x2*)(op + 8 * gi) = w0;
                u32x2 w1; w1.x = cvtpk_s(o1[4 * gi] * inv, o1[4 * gi + 1] * inv); w1.y = cvtpk_s(o1[4 * gi + 2] * inv, o1[4 * gi + 3] * inv); *(u32x2*)(op + 32 + 8 * gi) = w1; }
        }
    }
#undef AT_LOADKV
#undef AT_QK
}
#define MFMA16(a, b, c) __builtin_amdgcn_mfma_f32_16x16x32_bf16((a), (b), (c), 0, 0, 0)
constexpr int HP = 272, HPS = 144;
constexpr int G_BUF = 63488, G_QR = 0, G_KR = 17408, G_KT = 34816, G_VT = 53248, G_EREF = 62464, G_ELR = 62976;
constexpr int G_AT = 2 * G_BUF, G_ST = G_AT + 9216, G_QTOT = G_ST + 17408, G_END = G_QTOT + 2048;
static_assert(G_END <= LDSCTL_OFF, "hgrn2 LDS");
__device__ __forceinline__ void p2_hgrn2(Frame& F) {
    const bf16* QH = (const bf16*)(F.ws + WS_QH); const bf16* IH = (const bf16*)(F.ws + WS_IH);
    LAS unsigned char* L = F.lds;
    const int tid = F.tid, w = F.wave, i16 = F.lane & 15, kg = F.lane >> 4; const bool isA = w < 4; const int wb = w & 3;
    const int d0 = 2 * (tid & 63), tsg = (tid >> 6) & 3, v0 = 2 * (tid & 31), s8 = (tid >> 5) & 7;
    constexpr float LOG2E = 1.4426950408889634f;
    const int gwb = F.vcu * 4 + wb, NGWB = F.G * 4; int cvk = 0;
#define G2_BAR() do { asm volatile("s_waitcnt lgkmcnt(0)" ::: "memory"); __builtin_amdgcn_s_barrier(); asm volatile("" ::: "memory"); } while (0)
#define G2_SEL(n, bo) ((bo) ? n##1 : n##0)
    LAS unsigned char* const pQT = L + G_QTOT + d0 * 4;
    LAS unsigned char* const pER0 = L + G_EREF + d0 * 4, * const pER1 = pER0 + G_BUF;
    LAS unsigned char* const pQK0 = L + (16 * tsg) * HP + d0 * 2, * const pQK1 = pQK0 + G_BUF;
    LAS unsigned char* const pKT0 = L + G_KT + d0 * HPS + tsg * 32, * const pKT1 = pKT0 + G_BUF;
    LAS unsigned char* const pVT0 = L + G_VT + v0 * HPS + s8 * 16, * const pVT1 = pVT0 + G_BUF;
    LAS unsigned char* const bP0 = L + i16 * HP + kg * 16, * const bP1 = bP0 + G_BUF;
    LAS unsigned char* const bPw0 = bP0 + wb * 16 * HP, * const bPw1 = bPw0 + G_BUF;
    LAS unsigned char* const bS0 = L + i16 * HPS + kg * 16, * const bS1 = bS0 + G_BUF;
    LAS unsigned char* const bSw0 = bS0 + wb * 16 * HPS, * const bSw1 = bSw0 + G_BUF;
    LAS unsigned char* const bKT0 = L + G_KT + (32 * wb + i16) * HPS + kg * 16, * const bKT1 = bKT0 + G_BUF;
    LAS unsigned char* const bER0 = L + G_EREF + (32 * wb + 4 * kg) * 4, * const bER1 = bER0 + G_BUF;
    LAS unsigned char* const bSTr = L + G_ST + (16 * wb + i16) * HP + kg * 16;
    LAS unsigned char* const bATr = L + G_AT + i16 * HPS + kg * 16;
    LAS unsigned char* const bSTw = L + G_ST + i16 * HP + (32 * wb + 4 * kg) * 2;
    LAS unsigned char* const bATw = L + G_AT + (16 * wb + i16) * HPS + kg * 8;
    for (int unit = F.vcu; unit < NB * 4 * 2 * 2; unit += F.G) {
        const int vh = unit & 1, dir = (unit >> 1) & 1, h = (unit >> 2) & 3, b = unit >> 4;
        const bf16* LG = (const bf16*)(F.ws + (dir ? WS_LB : WS_LF)); bf16* OUT = (bf16*)(F.ws + (dir ? WS_OB : WS_OF));
        const size_t rowb = (size_t)b * SEQ; const long tstep = dir ? -512 : 512;
#define G2_TIME(c, tau) (dir ? (SEQ - 1 - (64 * (c) + (tau))) : (64 * (c) + (tau)))
#define G2_LOAD(c, qr_, lr_, vr_) do {   \
        const size_t g0_ = (rowb + G2_TIME(c, 16 * tsg)) * 512 + h * 128 + d0; const bf16* qp_ = QH + g0_; const bf16* lp_ = LG + g0_; \
        const bf16* vp_ = IH + (rowb + G2_TIME(c, 8 * s8)) * 512 + h * 128 + vh * 64 + v0; \
        _Pragma("unroll") for (int j = 0; j < 16; ++j) { qr_[j] = *(const unsigned*)(qp_ + j * tstep); lr_[j] = *(const unsigned*)(lp_ + j * tstep); } \
        _Pragma("unroll") for (int j = 0; j < 8; ++j) vr_[j] = *(const unsigned*)(vp_ + j * tstep); } while (0)
#define G2_SCAN(lr_) do { f32x2_t run = {0.f, 0.f}; \
        _Pragma("unroll") for (int j = 0; j < 16; ++j) { run = run + (f32x2_t){bflo(lr_[j]), bfhi(lr_[j])} * LOG2E; cs[j] = run; } \
        *(LAS f32x2_t*)(pQT + tsg * 512) = run; } while (0)
#define G2_ELEM(qr_, lr_, vr_, bo) do { \
        f32x2_t pre = {0.f, 0.f}, ref = {0.f, 0.f}, last = {0.f, 0.f}; \
        _Pragma("unroll") for (int sgm = 0; sgm < 4; ++sgm) { const f32x2_t tq_ = *(const LAS f32x2_t*)(pQT + sgm * 512); if (sgm < tsg) pre = pre + tq_; if (sgm < 2) ref = ref + tq_; last = last + tq_; } \
        if (tsg == 0) { f32x2_t er_, el_; er_[0] = __builtin_amdgcn_exp2f(ref[0]); er_[1] = __builtin_amdgcn_exp2f(ref[1]); el_[0] = __builtin_amdgcn_exp2f(last[0] - ref[0]); el_[1] = __builtin_amdgcn_exp2f(last[1] - ref[1]); \
            *(LAS f32x2_t*)(G2_SEL(pER, bo)) = er_; *(LAS f32x2_t*)(G2_SEL(pER, bo) + (G_ELR - G_EREF)) = el_; } \
        { unsigned kt0[8], kt1[8]; float kp0 = 0.f, kp1 = 0.f; \
          _Pragma("unroll") for (int j = 0; j < 16; ++j) { \
              const float c0 = pre[0] + cs[j][0] - ref[0], c1 = pre[1] + cs[j][1] - ref[1]; \
              const float k0 = 1.0f - __builtin_amdgcn_exp2f(bflo(lr_[j]) * LOG2E), k1 = 1.0f - __builtin_amdgcn_exp2f(bfhi(lr_[j]) * LOG2E); \
              const float kr0 = k0 * __builtin_amdgcn_exp2f(-c0), kr1 = k1 * __builtin_amdgcn_exp2f(-c1); \
              *(LAS unsigned*)(G2_SEL(pQK, bo) + G_QR + j * HP) = cvtpk_s(bflo(qr_[j]) * __builtin_amdgcn_exp2f(c0), bfhi(qr_[j]) * __builtin_amdgcn_exp2f(c1)); \
              *(LAS unsigned*)(G2_SEL(pQK, bo) + G_KR + j * HP) = cvtpk_s(kr0, kr1); \
              if (j & 1) { kt0[j >> 1] = cvtpk_s(kp0, kr0); kt1[j >> 1] = cvtpk_s(kp1, kr1); } else { kp0 = kr0; kp1 = kr1; } } \
          *(LAS v4u*)(G2_SEL(pKT, bo)) = (v4u){kt0[0], kt0[1], kt0[2], kt0[3]}; *(LAS v4u*)(G2_SEL(pKT, bo) + 16) = (v4u){kt0[4], kt0[5], kt0[6], kt0[7]}; \
          *(LAS v4u*)(G2_SEL(pKT, bo) + HPS) = (v4u){kt1[0], kt1[1], kt1[2], kt1[3]}; *(LAS v4u*)(G2_SEL(pKT, bo) + HPS + 16) = (v4u){kt1[4], kt1[5], kt1[6], kt1[7]}; } \
        { v4u a_, b_; a_.x = (vr_[0] & 0xffffu) | (vr_[1] << 16); a_.y = (vr_[2] & 0xffffu) | (vr_[3] << 16); a_.z = (vr_[4] & 0xffffu) | (vr_[5] << 16); a_.w = (vr_[6] & 0xffffu) | (vr_[7] << 16); \
          b_.x = (vr_[0] >> 16) | (vr_[1] & 0xffff0000u); b_.y = (vr_[2] >> 16) | (vr_[3] & 0xffff0000u); b_.z = (vr_[4] >> 16) | (vr_[5] & 0xffff0000u); b_.w = (vr_[6] >> 16) | (vr_[7] & 0xffff0000u); \
          *(LAS v4u*)(G2_SEL(pVT, bo)) = a_; *(LAS v4u*)(G2_SEL(pVT, bo) + HPS) = b_; } } while (0)
#define G2_B1(bo) do { \
        _Pragma("unroll") for (int dt = 0; dt < 2; ++dt) { const f32x4 er = *(const LAS f32x4*)(G2_SEL(bER, bo) + dt * 64); \
            _Pragma("unroll") for (int vt = 0; vt < 4; ++vt) { S[dt][vt] = S[dt][vt] * er; u32x2 pk; pk.x = cvtpk_s(S[dt][vt][0], S[dt][vt][1]); pk.y = cvtpk_s(S[dt][vt][2], S[dt][vt][3]); \
                *(LAS u32x2*)(bSTw + vt * 16 * HP + dt * 32) = pk; } } \
        _Pragma("unroll") for (int st = 0; st < 4; ++st) { \
            if (st > wb) { *(LAS u32x2*)(bATw + st * 32) = (u32x2){0u, 0u}; } \
            else { f32x4 a = (f32x4){0.f, 0.f, 0.f, 0.f}; \
                _Pragma("unroll") for (int ks = 0; ks < 4; ++ks) { const pg8::bf16x8 kf = *(const LAS pg8::bf16x8*)(G2_SEL(bP, bo) + G_KR + st * 16 * HP + ks * 64), qf = *(const LAS pg8::bf16x8*)(G2_SEL(bPw, bo) + G_QR + ks * 64); \
                    a = MFMA16(kf, qf, a); } \
                if (st == wb) { _Pragma("unroll") for (int i = 0; i < 4; ++i) a[i] = (4 * kg + i <= i16) ? a[i] : 0.f; } \
                u32x2 pk; pk.x = cvtpk_s(a[0], a[1]); pk.y = cvtpk_s(a[2], a[3]); *(LAS u32x2*)(bATw + st * 32) = pk; } } \
        _Pragma("unroll") for (int dt = 0; dt < 2; ++dt) { \
            _Pragma("unroll") for (int ks = 0; ks < 2; ++ks) { const pg8::bf16x8 af = *(const LAS pg8::bf16x8*)(G2_SEL(bKT, bo) + dt * 16 * HPS + ks * 64); \
                _Pragma("unroll") for (int vt = 0; vt < 4; ++vt) { const pg8::bf16x8 bfv = *(const LAS pg8::bf16x8*)(G2_SEL(bS, bo) + G_VT + vt * 16 * HPS + ks * 64); S[dt][vt] = MFMA16(af, bfv, S[dt][vt]); } } \
            const f32x4 el = *(const LAS f32x4*)(G2_SEL(bER, bo) + (G_ELR - G_EREF) + dt * 64); \
            _Pragma("unroll") for (int vt = 0; vt < 4; ++vt) S[dt][vt] = S[dt][vt] * el; } } while (0)
#define G2_B2(bo, c) do { \
        f32x4 oa[4]; _Pragma("unroll") for (int tt = 0; tt < 4; ++tt) oa[tt] = (f32x4){0.f, 0.f, 0.f, 0.f}; \
        _Pragma("unroll") for (int ks = 0; ks < 4; ++ks) { const pg8::bf16x8 sf = *(const LAS pg8::bf16x8*)(bSTr + ks * 64); \
            _Pragma("unroll") for (int tt = 0; tt < 4; ++tt) { const pg8::bf16x8 qf = *(const LAS pg8::bf16x8*)(G2_SEL(bP, bo) + G_QR + tt * 16 * HP + ks * 64); oa[tt] = MFMA16(sf, qf, oa[tt]); } } \
        _Pragma("unroll") for (int ks = 0; ks < 2; ++ks) { const pg8::bf16x8 vf = *(const LAS pg8::bf16x8*)(G2_SEL(bSw, bo) + G_VT + ks * 64); \
            _Pragma("unroll") for (int tt = 2 * ks; tt < 4; ++tt) { const pg8::bf16x8 af = *(const LAS pg8::bf16x8*)(bATr + tt * 16 * HPS + ks * 64); oa[tt] = MFMA16(vf, af, oa[tt]); } } \
        _Pragma("unroll") for (int tt = 0; tt < 4; ++tt) { const int tm = G2_TIME(c, 16 * tt + i16); u32x2 ow; ow.x = cvtpk_s(oa[tt][0], oa[tt][1]); ow.y = cvtpk_s(oa[tt][2], oa[tt][3]); \
            *(u32x2*)(OUT + (rowb + tm) * 512 + h * 128 + vh * 64 + 16 * wb + 4 * kg) = ow; } } while (0)
        if (isA) {
            unsigned q0r[16], l0r[16], v0r[8], q1r[16], l1r[16], v1r[8]; f32x2_t cs[16];
            G2_LOAD(0, q0r, l0r, v0r); G2_LOAD(1, q1r, l1r, v1r);
            G2_BAR();
            G2_SCAN(l0r);
            G2_BAR();
            G2_ELEM(q0r, l0r, v0r, 0); G2_LOAD(2, q0r, l0r, v0r);
            G2_BAR();
            for (int c = 0; c < SEQ / 64; c += 2) {
                G2_SCAN(l1r);
                G2_BAR();
                G2_ELEM(q1r, l1r, v1r, G_BUF); if (c + 3 < SEQ / 64) G2_LOAD(c + 3, q1r, l1r, v1r);
                G2_BAR();
                if (c + 2 < SEQ / 64) G2_SCAN(l0r);
                G2_BAR();
                if (c + 2 < SEQ / 64) { G2_ELEM(q0r, l0r, v0r, 0); if (c + 4 < SEQ / 64) G2_LOAD(c + 4, q0r, l0r, v0r); }
                G2_BAR();
            }
        } else {
            f32x4 S[2][4];
#pragma unroll
            for (int i = 0; i < 2; ++i)
#pragma unroll
                for (int j = 0; j < 4; ++j) S[i][j] = (f32x4){0.f, 0.f, 0.f, 0.f};
            G2_BAR(); G2_BAR(); G2_BAR();
            for (int c = 0; c < SEQ / 64; c += 2) {
#define G2_BSTEP(cc, bc) do { f32x4 cva[8], cvb[8]; const int ita = gwb + cvk * NGWB, itb = ita + NGWB; cvk += 2; \
                cv_load(F, ita < CV_NITEMS ? ita : CV_NITEMS - 1, cva); cv_load(F, itb < CV_NITEMS ? itb : CV_NITEMS - 1, cvb);     \
                G2_B1(bc); G2_BAR(); G2_B2(bc, cc); \
                if (ita < CV_NITEMS) cv_store(F, ita, cva); if (itb < CV_NITEMS) cv_store(F, itb, cvb); G2_BAR(); } while (0)
                G2_BSTEP(c, 0); G2_BSTEP(c + 1, G_BUF);
#undef G2_BSTEP
            }
        }
#undef G2_B2
#undef G2_B1
#undef G2_ELEM
#undef G2_SCAN
#undef G2_LOAD
#undef G2_TIME
    }
#undef G2_BAR
#undef G2_SEL
    if (!isA) for (int it = gwb + cvk * NGWB; it < CV_NITEMS; it += NGWB) { f32x4 cvv[8]; cv_load(F, it, cvv); cv_store(F, it, cvv); }
}
__device__ __forceinline__ void p3_finalize(Frame& F) {
    const bf16* OFp = (const bf16*)(F.ws + WS_OF); const bf16* OBp = (const bf16*)(F.ws + WS_OB); const bf16* ZG = (const bf16*)(F.ws + WS_ZG); bf16* MIX = (bf16*)(F.ws + WS_MIX);
    const int gw = F.vcu * NWAVES + F.wave, NGW = F.G * NWAVES, sub = F.lane >> 4, l16 = F.lane & 15;
    for (int it = gw; it < T; it += NGW) {
        const size_t g = (size_t)it * 512 + sub * 128 + 8 * l16;
        const v4u a = *(const v4u*)(OFp + g), c = *(const v4u*)(OBp + g), z = *(const v4u*)(ZG + g);
        float o[8]; o[0] = bflo(a.x) + bflo(c.x); o[1] = bfhi(a.x) + bfhi(c.x); o[2] = bflo(a.y) + bflo(c.y); o[3] = bfhi(a.y) + bfhi(c.y);
        o[4] = bflo(a.z) + bflo(c.z); o[5] = bfhi(a.z) + bfhi(c.z); o[6] = bflo(a.w) + bflo(c.w); o[7] = bfhi(a.w) + bfhi(c.w);
        float ss = (o[0] * o[0] + o[1] * o[1]) + (o[2] * o[2] + o[3] * o[3]) + (o[4] * o[4] + o[5] * o[5]) + (o[6] * o[6] + o[7] * o[7]);
        ss += __shfl_xor(ss, 1); ss += __shfl_xor(ss, 2); ss += __shfl_xor(ss, 4); ss += __shfl_xor(ss, 8);
        const float r = 1.0f / sqrtf(ss * (1.0f / 128.0f) + RMS_EPS);
        v4u w; w.x = cvtpk_s(o[0] * r * bflo(z.x), o[1] * r * bfhi(z.x)); w.y = cvtpk_s(o[2] * r * bflo(z.y), o[3] * r * bfhi(z.y));
        w.z = cvtpk_s(o[4] * r * bflo(z.z), o[5] * r * bfhi(z.z)); w.w = cvtpk_s(o[6] * r * bflo(z.w), o[7] * r * bfhi(z.w));
        *(v4u*)(MIX + (size_t)it * D + 512 + sub * 128 + 8 * l16) = w;
    }
}

__device__ __forceinline__ void p5_router(Frame& F) {
    const bf16* U = (const bf16*)(F.ws + WS_U); bf16* H1 = (bf16*)(F.ws + WS_H1); unsigned char* H1F8 = F.ws + WS_H1F8; int* TOPI = (int*)(F.ws + WS_TOPI); float* TOPG = (float*)(F.ws + WS_TOPG); int* cntTab = (int*)(F.ws + WS_TAB);
    const float* Wr = FIN(F, 10); const float* br = FIN(F, 11); const float* lg = FIN(F, 8); const float* lb = FIN(F, 9);
    LAS float* part = (LAS float*)(F.lds + RING_OFF);
    LAS float* LGs = (LAS float*)(F.lds + RING_OFF + 1024);
    LAS int* hist = (LAS int*)(F.lds + HIST_OFF);
    const int w = F.wave, i16 = F.lane & 15, kg = F.lane >> 4, kcol = 128 * w + 8 * kg;
    pg8::bf16x8 bhi[4][2], blo[4][2];
#pragma unroll
    for (int ks = 0; ks < 4; ++ks)
#pragma unroll
        for (int nt = 0; nt < 2; ++nt) { v4u ph, pl; unsigned* phh = (unsigned*)&ph; unsigned* pll = (unsigned*)&pl;
#pragma unroll
            for (int j = 0; j < 8; j += 2) { const float x0 = Wr[(size_t)(kcol + 32 * ks + j) * NE + 16 * nt + i16], x1 = Wr[(size_t)(kcol + 32 * ks + j + 1) * NE + 16 * nt + i16];
                const unsigned hh = cvtpk_s(x0, x1); phh[j >> 1] = hh; pll[j >> 1] = cvtpk_s(x0 - bflo(hh), x1 - bfhi(hh)); }
            bhi[ks][nt] = __builtin_bit_cast(pg8::bf16x8, ph); blo[ks][nt] = __builtin_bit_cast(pg8::bf16x8, pl); }
    const float mybias = br[F.lane & 31];
    for (int chunk = F.vcu; chunk < NCHUNK; chunk += F.G) {
        __syncthreads();
        if (F.tid < NE) hist[F.tid] = 0;
        v4u ub[4];
#pragma unroll
        for (int ks = 0; ks < 4; ++ks) ub[ks] = *(const GAS v4u*)(U + (size_t)(chunk * CHUNK_TOK + i16) * D + kcol + 32 * ks);
        for (int it = 0; it < CHUNK_TOK / 16; ++it) {
            const int tok0 = chunk * CHUNK_TOK + it * 16, tok = tok0 + i16;
            f32x4 u[4][2]; float s1 = 0.f, s2 = 0.f;
#pragma unroll
            for (int ks = 0; ks < 4; ++ks) { u[ks][0] = (f32x4){bflo(ub[ks].x), bfhi(ub[ks].x), bflo(ub[ks].y), bfhi(ub[ks].y)}; u[ks][1] = (f32x4){bflo(ub[ks].z), bfhi(ub[ks].z), bflo(ub[ks].w), bfhi(ub[ks].w)};
#pragma unroll
                for (int q = 0; q < 2; ++q) { s1 += (u[ks][q][0] + u[ks][q][1]) + (u[ks][q][2] + u[ks][q][3]); s2 += (u[ks][q][0] * u[ks][q][0] + u[ks][q][1] * u[ks][q][1]) + (u[ks][q][2] * u[ks][q][2] + u[ks][q][3] * u[ks][q][3]); } }
            if (it + 1 < CHUNK_TOK / 16) {
#pragma unroll
                for (int ks = 0; ks < 4; ++ks) ub[ks] = *(const GAS v4u*)(U + (size_t)(tok + 16) * D + kcol + 32 * ks); }
            s1 += __shfl_xor(s1, 16); s1 += __shfl_xor(s1, 32); s2 += __shfl_xor(s2, 16); s2 += __shfl_xor(s2, 32);
            if (kg == 0) { part[(w * 16 + i16) * 2] = s1; part[(w * 16 + i16) * 2 + 1] = s2; }
            __syncthreads();
            float t1 = 0.f, t2 = 0.f;
#pragma unroll
            for (int ww = 0; ww < 8; ++ww) { t1 += part[(ww * 16 + i16) * 2]; t2 += part[(ww * 16 + i16) * 2 + 1]; }
            const float mean = t1 * (1.0f / D), rstd = 1.0f / sqrtf(fmaxf(t2 * (1.0f / D) - mean * mean, 0.f) + LN_EPS);
            f32x4 acc[2]; acc[0] = (f32x4){0.f, 0.f, 0.f, 0.f}; acc[1] = acc[0];
#pragma unroll
            for (int ks = 0; ks < 4; ++ks) { v4u ph, pl; unsigned* phh = (unsigned*)&ph; unsigned* pll = (unsigned*)&pl;
#pragma unroll
                for (int q = 0; q < 2; ++q) { const f32x4 gq = *(const f32x4*)(lg + kcol + 32 * ks + 4 * q), bq = *(const f32x4*)(lb + kcol + 32 * ks + 4 * q); const f32x4 y = (u[ks][q] - mean) * rstd * gq + bq;
                    const unsigned h0 = cvtpk_s(y[0], y[1]), h1 = cvtpk_s(y[2], y[3]); phh[2 * q] = h0; phh[2 * q + 1] = h1;
                    pll[2 * q] = cvtpk_s(y[0] - bflo(h0), y[1] - bfhi(h0)); pll[2 * q + 1] = cvtpk_s(y[2] - bflo(h1), y[3] - bfhi(h1)); }
                *(GAS v4u*)(H1 + (size_t)tok * D + kcol + 32 * ks) = ph;
                { u32x2 f8; f8.x = pk4_fp8(bflo(ph.x) * F8_SA, bfhi(ph.x) * F8_SA, bflo(ph.y) * F8_SA, bfhi(ph.y) * F8_SA); f8.y = pk4_fp8(bflo(ph.z) * F8_SA, bfhi(ph.z) * F8_SA, bflo(ph.w) * F8_SA, bfhi(ph.w) * F8_SA);
                  *(GAS u32x2*)(H1F8 + (size_t)tok * D + kcol + 32 * ks) = f8; }
                const pg8::bf16x8 ahi = __builtin_bit_cast(pg8::bf16x8, ph), alo = __builtin_bit_cast(pg8::bf16x8, pl);
#pragma unroll
                for (int nt = 0; nt < 2; ++nt) { acc[nt] = MFMA16(ahi, bhi[ks][nt], acc[nt]); acc[nt] = MFMA16(alo, bhi[ks][nt], acc[nt]); acc[nt] = MFMA16(ahi, blo[ks][nt], acc[nt]); } }
#pragma unroll
            for (int nt = 0; nt < 2; ++nt)
#pragma unroll
                for (int i = 0; i < 4; ++i) LGs[(w * 16 + 4 * kg + i) * 32 + 16 * nt + i16] = acc[nt][i];
            __syncthreads();
            {
                const int tl = 2 * w + (F.lane >> 5), e = F.lane & 31; float v = mybias;
#pragma unroll
                for (int ww = 0; ww < 8; ++ww) v += LGs[(ww * 16 + tl) * 32 + e];
                float tv[4]; int tix[4];
                const unsigned fb = __float_as_uint(v); unsigned key = (((fb & 0x80000000u) ? ~fb : (fb | 0x80000000u)) & ~31u) | (unsigned)(31 - e);
#pragma unroll
                for (int k = 0; k < 4; ++k) { unsigned x = key; unsigned y;
                    y = (unsigned)__builtin_amdgcn_update_dpp(0, (int)x, 0xB1, 0xF, 0xF, false); x = x > y ? x : y;
                    y = (unsigned)__builtin_amdgcn_update_dpp(0, (int)x, 0x4E, 0xF, 0xF, false); x = x > y ? x : y;
                    y = (unsigned)__builtin_amdgcn_update_dpp(0, (int)x, 0x141, 0xF, 0xF, false); x = x > y ? x : y;
                    y = (unsigned)__builtin_amdgcn_update_dpp(0, (int)x, 0x140, 0xF, 0xF, false); x = x > y ? x : y;
                    y = (unsigned)__shfl_xor((int)x, 16); x = x > y ? x : y;
                    tix[k] = 31 - (int)(x & 31u); const unsigned ob = x & ~31u; tv[k] = __uint_as_float((ob & 0x80000000u) ? (ob & 0x7fffffffu) : ~ob);
                    if (e == tix[k]) key = 0u; }
                const float e1 = __expf(tv[1] - tv[0]), e2 = __expf(tv[2] - tv[0]), e3 = __expf(tv[3] - tv[0]); const float inv = 1.0f / (1.0f + e1 + e2 + e3);
                if (e == 0) { const size_t tk = (size_t)(tok0 + tl);
                    *(int4*)(TOPI + tk * 4) = make_int4(tix[0], tix[1], tix[2], tix[3]); *(float4*)(TOPG + tk * 4) = make_float4(inv, e1 * inv, e2 * inv, e3 * inv);
                    atomicAdd((int*)&hist[tix[0]], 1); atomicAdd((int*)&hist[tix[1]], 1); atomicAdd((int*)&hist[tix[2]], 1); atomicAdd((int*)&hist[tix[3]], 1); }
            }
        }
        __syncthreads();
        if (F.tid < NE) cntTab[chunk * NE + F.tid] = hist[F.tid];
    }
}

__device__ __forceinline__ void p6_dispatch(Frame& F) {
    const int* cntTab = (const int*)(F.ws + WS_TAB); int* tileExpertG = (int*)(F.ws + WS_TAB + 65536); int* ntilesG = (int*)(F.ws + WS_TAB + 98304);
    const int* TOPI = (const int*)(F.ws + WS_TOPI); const float* TOPG = (const float*)(F.ws + WS_TOPG); int* ROWTOK = (int*)(F.ws + WS_ROWTOK); float* GATES = (float*)(F.ws + WS_GATES);
    LAS int* ptot = (LAS int*)(F.lds + RING_OFF);
    LAS int* ppre = ptot + 512;
    LAS int* tot = ppre + 512;
    LAS int* base = tot + 32;
    LAS int* myoff = base + 36;
    LAS int* wcnt = myoff + 32;
    for (int chunk = F.vcu; chunk < NCHUNK; chunk += F.G) {
        __syncthreads();
        { const int e = F.tid & 31, part = F.tid >> 5; int st = 0, sp = 0;
#pragma unroll
          for (int i = 0; i < 16; ++i) { const int w = part * 16 + i; const int c = cntTab[w * NE + e]; st += c; sp += (w < chunk) ? c : 0; }
          ptot[part * 32 + e] = st; ppre[part * 32 + e] = sp; }
        const size_t ge = (size_t)chunk * CHUNK_TOK * 4 + F.tid; const int me = TOPI[ge]; const float mg = TOPG[ge];
        int rank = 0, cntw = 0; const unsigned long long lt = (1ull << F.lane) - 1ull;
#pragma unroll 8
        for (int ee = 0; ee < NE; ++ee) { const unsigned long long m = __ballot(me == ee); if (me == ee) rank = __popcll(m & lt); if (F.lane == ee) cntw = __popcll(m); }
        if (F.lane < NE) wcnt[F.wave * 32 + F.lane] = cntw;
        __syncthreads();
        if (F.tid < NE) { int st = 0, sp = 0;
#pragma unroll
            for (int p = 0; p < 16; ++p) { st += ptot[p * 32 + F.tid]; sp += ppre[p * 32 + F.tid]; }
            tot[F.tid] = st; myoff[F.tid] = sp;
            int incl = (st + 255) & ~255;
#pragma unroll
            for (int o = 1; o < 32; o <<= 1) { const int t = __shfl_up(incl, o); if (F.tid >= o) incl += t; }
            base[F.tid + 1] = incl; if (F.tid == 0) base[0] = 0; }
        __syncthreads();
        { int pos = base[me] + myoff[me] + rank;
          for (int w = 0; w < F.wave; ++w) pos += wcnt[w * 32 + me];
          ROWTOK[pos] = (int)ge; GATES[pos] = mg; }
        if (chunk == 0) {
            for (int tl = F.tid; tl < MAXTILES; tl += NWAVES * 64) { int e = 0;
#pragma unroll 8
                for (int k = 1; k < NE; ++k) e += (tl * 256 >= base[k]) ? 1 : 0;
                tileExpertG[tl] = e; }
            if (F.tid < 256) for (int e = 0; e < NE; ++e) { const int s = base[e] + tot[e] + F.tid; if (s < base[e + 1]) { ROWTOK[s] = -1; GATES[s] = 0.f; } }
            if (F.tid == 0) ntilesG[0] = base[NE] >> 8;
        }
    }
}

typedef float f32x2v __attribute__((ext_vector_type(2)));
__device__ __forceinline__ void p9_combine(Frame& F) {
    const bf16* H1 = (const bf16*)(F.ws + WS_H1); const unsigned char* Y = F.ws + WS_Y;
    const int gw = F.vcu * NWAVES + F.wave, NGW = F.G * NWAVES;
    f32x4 gg[4], bb[4];
#pragma unroll
    for (int j = 0; j < 4; ++j) { gg[j] = ((const f32x4*)FIN(F, 16))[F.lane + 64 * j]; bb[j] = ((const f32x4*)FIN(F, 17))[F.lane + 64 * j]; }
    for (int tok = gw; tok < T; tok += NGW) {
        f32x4 v[4]; float s = 0.f;
#pragma unroll
        for (int j = 0; j < 4; ++j) { const u32x2 hb = ((const u32x2*)(H1 + (size_t)tok * D))[F.lane + 64 * j];
            f32x4 y = (f32x4){0.f, 0.f, 0.f, 0.f};
#pragma unroll
            for (int k = 0; k < 4; ++k) { const unsigned yb = ((const unsigned*)(Y + ((size_t)tok * 4 + k) * D))[F.lane + 64 * j];
                const f32x2v lo = __builtin_amdgcn_cvt_pk_f32_fp8((int)yb, false), hi = __builtin_amdgcn_cvt_pk_f32_fp8((int)yb, true); y[0] += lo[0]; y[1] += lo[1]; y[2] += hi[0]; y[3] += hi[1]; }
            v[j][0] = DN_ALPHA * bflo(hb.x) + y[0] * (1.0f / F8_SY); v[j][1] = DN_ALPHA * bfhi(hb.x) + y[1] * (1.0f / F8_SY); v[j][2] = DN_ALPHA * bflo(hb.y) + y[2] * (1.0f / F8_SY); v[j][3] = DN_ALPHA * bfhi(hb.y) + y[3] * (1.0f / F8_SY);
            s += (v[j].x + v[j].y) + (v[j].z + v[j].w); }
        const float mean = wave_sum(s) * (1.f / D); float s2 = 0.f;
#pragma unroll
        for (int j = 0; j < 4; ++j) { v[j] = v[j] - mean; s2 += (v[j].x * v[j].x + v[j].y * v[j].y) + (v[j].z * v[j].z + v[j].w * v[j].w); }
        const float rstd = 1.f / sqrtf(wave_sum(s2) * (1.f / D) + LN_EPS);
        GAS f32x4* o = (GAS f32x4*)(F.out + (size_t)tok * D) + F.lane;
#pragma unroll
        for (int j = 0; j < 4; ++j) o[64 * j] = v[j] * rstd * gg[j] + bb[j];
    }
}

struct Args { const float* in[18]; float* out; unsigned char* ws; int ph_lo, ph_hi, sub, pad; };
__global__ void __launch_bounds__(NWAVES * 64, 2) hymba_fwd(Args args) {
    extern __shared__ __attribute__((aligned(16))) unsigned char lds[];
    Frame F;
    F.lds = (LAS unsigned char*)lds;
    F.MISC = (volatile LAS unsigned*)(F.lds + MISC_OFF);
    F.tid = threadIdx.x; F.lane = F.tid & 63; F.wave = __builtin_amdgcn_readfirstlane(F.tid >> 6);
    F.G = gridDim.x; { const int bx = blockIdx.x; F.vcu = (F.G % 8 == 0) ? (bx % 8) * (F.G / 8) + bx / 8 : bx; }
    F.ws = args.ws; F.out = args.out; F.ctl = (gu32*)(args.ws + WS_CTL);
    F.ka = (const __attribute__((address_space(4))) unsigned char*)__builtin_amdgcn_kernarg_segment_ptr();
    static_assert(offsetof(Args, in) == 0, "the input pointers lead the kernarg segment");
    for (int u = F.tid; u < (LDS_BYTES - LDSCTL_OFF) / 4; u += NWAVES * 64) ((LAS unsigned*)(F.lds + LDSCTL_OFF))[u] = 0u;
    __syncthreads();
    XcdBarrier bar; bar.bar = (unsigned*)(F.ctl + CW_BAR); bar.x = 0; bar.st = nullptr;
    if (N_LAUNCHES == 1) bar = xcd_barrier_post((unsigned*)(F.ctl + CW_BAR), F.MISC + 8);
#define GRID_BAR() do { if (N_LAUNCHES == 1) xcd_barrier(bar); } while (0)
    const int lo = args.ph_lo, hi = args.ph_hi;
#define IN(k) (lo <= (k) && (k) < hi)
#define BOTH(k) (IN(k) && IN((k) + 1))
    unsigned char* ws = args.ws;

#ifndef PROBE_DBL
#define PROBE_DBL 0
#endif
#define DBL(k) ((PROBE_DBL >> (k)) & 1)
    if (IN(0)) { p0_prologue(F); if (DBL(0)) { __syncthreads(); p0_prologue(F); } if (BOTH(0)) GRID_BAR(); }

    if (IN(1)) {
        pg8::Gemm g{(const bf16*)(ws + WS_H0), (const bf16*)(ws + WS_WIN), T, NIN, D}; pg8::StaticOrder S; S.init(T, NIN, F.G, (int)blockIdx.x);
        EpiInProj E{(bf16*)(ws + WS_QA), (bf16*)(ws + WS_KA), (bf16*)(ws + WS_VA), (bf16*)(ws + WS_QH), (bf16*)(ws + WS_IH), (bf16*)(ws + WS_ZG), (bf16*)(ws + WS_LF), (bf16*)(ws + WS_LB), FIN(F, 5), FIN(F, 6)};
        pg8::gemm_phase<EpiInProj, pg8::StaticOrder, true, true>(F.lds + RING_OFF, g, S, E);
        if (DBL(1)) pg8::gemm_phase<EpiInProj, pg8::StaticOrder, true, true>(F.lds + RING_OFF, g, S, E);
        if (DBL(14)) { EpiNull EN{(int*)(ws + WS_TAB + 131072)}; pg8::gemm_phase<EpiNull, pg8::StaticOrder, true, true>(F.lds + RING_OFF, g, S, EN); }
        if (BOTH(1)) GRID_BAR();
    }
    if (IN(2)) { if (args.sub != 2) p2_attn(F); __syncthreads(); if (args.sub != 1) p2_hgrn2(F); if (BOTH(2)) GRID_BAR(); }
    if (IN(3)) { p3_finalize(F); if (DBL(3)) p3_finalize(F); if (BOTH(3)) GRID_BAR(); }
    if (IN(4)) {
        pg8::Gemm g{(const bf16*)(ws + WS_MIX), (const bf16*)(ws + WS_WOUT), T, D, D}; pg8::StaticOrder S; S.init(T, D, F.G, (int)blockIdx.x);
        EpiOutProj E{(const bf16*)(ws + WS_H0), (bf16*)(ws + WS_U)};
        pg8::gemm_phase<EpiOutProj, pg8::StaticOrder, true, true>(F.lds + RING_OFF, g, S, E);
        if (DBL(4)) pg8::gemm_phase<EpiOutProj, pg8::StaticOrder, true, true>(F.lds + RING_OFF, g, S, E);
        if (BOTH(4)) GRID_BAR();
    }
    if (IN(5)) { p5_router(F); if (DBL(5)) { __syncthreads(); p5_router(F); } if (BOTH(5)) GRID_BAR(); }
    if (IN(6)) { p6_dispatch(F); if (DBL(6)) { __syncthreads(); p6_dispatch(F); } if (BOTH(6)) GRID_BAR(); }
    const int ntiles = (IN(7) || IN(8)) ? *(const int*)(ws + WS_TAB + 98304) : 0;
    if (IN(7) || IN(8)) {
        const int* tileExpertG = (const int*)(ws + WS_TAB + 65536); const int* ROWTOK = (const int*)(ws + WS_ROWTOK);
        __syncthreads();
        for (int i = F.tid; i < MAXTILES; i += NWAVES * 64) ((LAS int*)(F.lds + TAB_OFF))[i] = tileExpertG[i] & 31;
        if (IN(7)) for (int i = 0; i < MAXUNITS_WG; ++i) { const int tile = F.G == 256 ? moe_tile(i, (int)blockIdx.x, 8) : (i * F.G + (int)blockIdx.x) >> 3; if (tile >= ntiles) break;
            if (F.tid < 256) { const int rt = ROWTOK[tile * 256 + F.tid]; ((LAS unsigned short*)(F.lds + ROWL_OFF))[i * 256 + F.tid] = (unsigned short)((rt < 0 ? 0 : rt) >> 2); } }
        if (IN(8)) { const float* GATES = (const float*)(ws + WS_GATES);
            for (int i = 0; i < MAXDOWN_WG; ++i) { const int tile = F.G == 256 ? moe_tile(i, (int)blockIdx.x, 4) : (i * F.G + (int)blockIdx.x) >> 2; if (tile >= ntiles) break;
                if (F.tid < 256) { u32x2 t; t.x = (unsigned)ROWTOK[tile * 256 + F.tid]; t.y = __float_as_uint(GATES[tile * 256 + F.tid] * F8_SY); ((LAS u32x2*)(F.lds + DG_OFF))[i * 256 + F.tid] = t; } } }
        __syncthreads();
    }
    if (IN(7)) {
        pg8::Gemm g{(const bf16*)(ws + WS_H1F8), (const bf16*)(ws + WS_WUP), T, NE * DFF, D / 2}; MoeOrder S{(const LAS int*)(F.lds + TAB_OFF), ntiles, 8, F.G, (int)blockIdx.x};
        EpiUp E{ws + WS_ACT, FIN(F, 13)};
        pg8::gemm_phase<EpiUp, MoeOrder, true, true, true, true>(F.lds + RING_OFF, g, S, E, (const LAS unsigned short*)(F.lds + ROWL_OFF));
        if (DBL(7)) pg8::gemm_phase<EpiUp, MoeOrder, true, true, true, true>(F.lds + RING_OFF, g, S, E, (const LAS unsigned short*)(F.lds + ROWL_OFF));
        if (DBL(12)) { EpiNull EN{(int*)(ws + WS_TAB + 131072)}; pg8::gemm_phase<EpiNull, MoeOrder, true, true, true, true>(F.lds + RING_OFF, g, S, EN, (const LAS unsigned short*)(F.lds + ROWL_OFF)); }
        if (BOTH(7)) GRID_BAR();
    }
    if (IN(8)) {
        pg8::Gemm g{(const bf16*)(ws + WS_ACT), (const bf16*)(ws + WS_WD), MAXSLOTS, NE * D, D / 2}; MoeOrder S{(const LAS int*)(F.lds + TAB_OFF), ntiles, 4, F.G, (int)blockIdx.x};
        EpiDown E{ws + WS_Y, (const LAS u32x2*)(F.lds + DG_OFF), FIN(F, 15)};
        pg8::gemm_phase<EpiDown, MoeOrder, true, true, false, true>(F.lds + RING_OFF, g, S, E);
        if (DBL(8)) pg8::gemm_phase<EpiDown, MoeOrder, true, true, false, true>(F.lds + RING_OFF, g, S, E);
        if (DBL(13)) { EpiNull EN{(int*)(ws + WS_TAB + 131072)}; pg8::gemm_phase<EpiNull, MoeOrder, true, true, false, true>(F.lds + RING_OFF, g, S, EN); }
        if (BOTH(8)) GRID_BAR();
    }
    if (IN(9)) { p9_combine(F); if (DBL(9)) p9_combine(F); }
#undef IN
#undef BOTH
}

extern "C" void kernel_launch(void* const* d_in, const int* in_sizes, int n_in, void* d_out, int out_size, void* d_ws, size_t ws_size, hipStream_t stream) {
    static int grid = 0;
    if (grid == 0) {
        if (n_in != 18 || in_sizes[0] != T * D || out_size != T * D || ws_size < WS_END) { fprintf(stderr, "kernel_launch: unexpected shapes (n_in %d, in0 %d, out %d, ws %zu); nothing launched\n", n_in, n_in > 0 ? in_sizes[0] : -1, out_size, ws_size); grid = -1; return; }
        int dev = 0, cus = 0, per_cu = 0;
        if (hipGetDevice(&dev) != hipSuccess || hipDeviceGetAttribute(&cus, hipDeviceAttributeMultiprocessorCount, dev) != hipSuccess) { grid = -1; return; }
        if (hipFuncSetAttribute((const void*)hymba_fwd, hipFuncAttributeMaxDynamicSharedMemorySize, LDS_BYTES) != hipSuccess) { fprintf(stderr, "kernel_launch: hipFuncSetAttribute failed\n"); grid = -1; return; }
        if (hipOccupancyMaxActiveBlocksPerMultiprocessor(&per_cu, (const void*)hymba_fwd, NWAVES * 64, LDS_BYTES) != hipSuccess || per_cu < 1) fprintf(stderr, "kernel_launch: occupancy query says %d\n", per_cu);
        (void)hipGetLastError();
        grid = cus;
    }
    if (grid < 0) return;
    if (hipMemsetAsync((char*)d_ws + WS_CTL, 0, CTL_ZERO_BYTES, stream) != hipSuccess) return;
    Args a{};
    for (int i = 0; i < 18; ++i) a.in[i] = (const float*)d_in[i];
    a.out = (float*)d_out; a.ws = (unsigned char*)d_ws;
    if (N_LAUNCHES == 1) { a.ph_lo = 0; a.ph_hi = PER_PHASE; hipLaunchKernelGGL(hymba_fwd, dim3(grid), dim3(NWAVES * 64), LDS_BYTES, stream, a); }
    else for (int li = 0; li < PER_PHASE; ++li) { a.ph_lo = li; a.ph_hi = li + 1; hipLaunchKernelGGL(hymba_fwd, dim3(grid), dim3(NWAVES * 64), LDS_BYTES, stream, a);
#ifdef HOST_DBL
        if ((HOST_DBL >> li) & 1) {
#ifdef HOST_SUB
            a.sub = HOST_SUB;
#endif
            hipLaunchKernelGGL(hymba_fwd, dim3(grid), dim3(NWAVES * 64), LDS_BYTES, stream, a); a.sub = 0; }
#endif
    }
}
```
